# Optimizing an MI355X kernel written in HIP

```python
import jax, jax.numpy as jnp
from jax import lax
import numpy as np

D_MODEL = 1024
BATCH = 2
SEQ = 8192
DEPTH = 4

CTX_LEN = 256
GRID_W = 64
N_HEADS = 8
N_KV_HEADS = 2
HEAD_DIM = 128
N_GROUPS = N_HEADS // N_KV_HEADS
WINDOW = 128
ATTN_BLOCK = 128
ROPE_THETA = 10000.0
ROPE_HALF = HEAD_DIM // 2
ROPE_FREQS = ROPE_HALF // 2
D_RNN = 1024
N_RNN_BLOCKS = 8
RNN_BLOCK = D_RNN // N_RNN_BLOCKS
CONV_W = 4
CONV_LEFT = 2
LRU_C = 8.0
D_FF = 2816
N_EXPERTS = 8
TOP_K = 2
D_FF_EXPERT = 3584
N_MOE_LAYERS = DEPTH // 2
N_DENSE_LAYERS = DEPTH - N_MOE_LAYERS
EPS = 1e-6
NEG_INF = -1e30
Q_COLS = N_HEADS * HEAD_DIM
KV_COLS = N_KV_HEADS * HEAD_DIM
IN_COLS = Q_COLS + 2 * KV_COLS + 2 * D_RNN + 2 * D_MODEL
SPLIT_IDX = (Q_COLS, Q_COLS + KV_COLS, Q_COLS + 2 * KV_COLS, Q_COLS + 2 * KV_COLS + D_RNN,
             Q_COLS + 2 * KV_COLS + 2 * D_RNN, Q_COLS + 2 * KV_COLS + 2 * D_RNN + D_MODEL)

kernel_name = "hybrid_dit_swa_rglru_moe"


def _rmsnorm(x, g):
    xf = x.astype(jnp.float32)
    y = xf * lax.rsqrt(jnp.mean(xf * xf, axis=-1, keepdims=True) + EPS)
    return (y * g.astype(jnp.float32)).astype(x.dtype)


def _modulate(h, shift, scale):
    return h * (1 + scale) + shift


def _axial_angles(row, col):
    inv = ROPE_THETA ** (-jnp.arange(ROPE_FREQS, dtype=jnp.float32) / ROPE_FREQS)
    return row.astype(jnp.float32)[:, None] * inv, col.astype(jnp.float32)[:, None] * inv


def _rot_half(xh, ang):
    x1, x2 = xh[..., :ROPE_FREQS], xh[..., ROPE_FREQS:]
    cos = jnp.cos(ang)[None, :, None, :]
    sin = jnp.sin(ang)[None, :, None, :]
    return jnp.concatenate([x1 * cos - x2 * sin, x2 * cos + x1 * sin], axis=-1)


def _rope_2d(x, ang_row, ang_col):
    xf = x.astype(jnp.float32)
    y = jnp.concatenate([_rot_half(xf[..., :ROPE_HALF], ang_row), _rot_half(xf[..., ROPE_HALF:], ang_col)], axis=-1)
    return y.astype(x.dtype)


def _windowed_attention(q, k, v, kc, vc, sink):
    B, S = q.shape[0], q.shape[1]
    nb = S // ATTN_BLOCK
    scale = HEAD_DIM ** -0.5
    qb = q.reshape(B, nb, ATTN_BLOCK, N_KV_HEADS, N_GROUPS, HEAD_DIM)
    pad = ((0, 0), (ATTN_BLOCK, ATTN_BLOCK), (0, 0), (0, 0))
    kp = jnp.pad(k, pad).reshape(B, nb + 2, ATTN_BLOCK, N_KV_HEADS, HEAD_DIM)
    vp = jnp.pad(v, pad).reshape(B, nb + 2, ATTN_BLOCK, N_KV_HEADS, HEAD_DIM)
    kband = jnp.concatenate([kp[:, :-2], kp[:, 1:-1], kp[:, 2:]], axis=2)
    vband = jnp.concatenate([vp[:, :-2], vp[:, 1:-1], vp[:, 2:]], axis=2)
    s_lat = jnp.einsum('bnqkgd,bnjkd->bnkgqj', qb, kband).astype(jnp.float32) * scale
    s_ctx = jnp.einsum('bnqkgd,bckd->bnkgqc', qb, kc).astype(jnp.float32) * scale
    qi = jnp.arange(ATTN_BLOCK)[:, None]
    kj = jnp.arange(3 * ATTN_BLOCK)[None, :]
    rel = kj - ATTN_BLOCK - qi
    kpos = jnp.arange(nb)[:, None, None] * ATTN_BLOCK + kj[None] - ATTN_BLOCK
    valid = (jnp.abs(rel) <= WINDOW)[None] & (kpos >= 0) & (kpos < S)
    s_lat = jnp.where(valid[None, :, None, None], s_lat, NEG_INF)
    sink_l = jnp.broadcast_to(sink.astype(jnp.float32).reshape(1, 1, N_KV_HEADS, N_GROUPS, 1, 1),
                              s_ctx.shape[:-1] + (1,))
    p = jax.nn.softmax(jnp.concatenate([s_lat, s_ctx, sink_l], axis=-1), axis=-1)
    n_lat = 3 * ATTN_BLOCK
    n_ctx = kc.shape[1]
    p_lat = p[..., :n_lat].astype(v.dtype)
    p_ctx = p[..., n_lat:n_lat + n_ctx].astype(v.dtype)
    o = jnp.einsum('bnkgqj,bnjkd->bnqkgd', p_lat, vband) + jnp.einsum('bnkgqc,bckd->bnqkgd', p_ctx, vc)
    return o.reshape(B, S, Q_COLS)


def _context_attention(qc, kc, vc, sink):
    B, C = qc.shape[0], qc.shape[1]
    qg = qc.reshape(B, C, N_KV_HEADS, N_GROUPS, HEAD_DIM)
    s = jnp.einsum('bqkgd,bckd->bkgqc', qg, kc).astype(jnp.float32) * (HEAD_DIM ** -0.5)
    sink_c = jnp.broadcast_to(sink.astype(jnp.float32).reshape(1, N_KV_HEADS, N_GROUPS, 1, 1), s.shape[:-1] + (1,))
    p = jax.nn.softmax(jnp.concatenate([s, sink_c], axis=-1), axis=-1)
    o = jnp.einsum('bkgqc,bckd->bqkgd', p[..., :C].astype(vc.dtype), vc)
    return o.reshape(B, C, Q_COLS)


def _conv_centred(x, w, b):
    L = x.shape[1]
    xp = jnp.pad(x, ((0, 0), (CONV_LEFT, CONV_W - 1 - CONV_LEFT), (0, 0)))
    y = xp[:, 0:L] * w[0]
    for j in range(1, CONV_W):
        y = y + xp[:, j:j + L] * w[j]
    return y + b


def _rglru_coeffs(x, wa, ba, wx, bx, lam):
    B, L = x.shape[0], x.shape[1]
    xb = x.reshape(B, L, N_RNN_BLOCKS, RNN_BLOCK)
    r = jax.nn.sigmoid(jnp.einsum('blhi,hij->blhj', xb, wa).reshape(B, L, D_RNN) + ba)
    i = jax.nn.sigmoid(jnp.einsum('blhi,hij->blhj', xb, wx).reshape(B, L, D_RNN) + bx)
    log_a = -LRU_C * r.astype(jnp.float32) * jax.nn.softplus(-lam.astype(jnp.float32))
    a = jnp.exp(log_a)
    bcoef = jnp.sqrt(-jnp.expm1(2.0 * log_a)) * (i * x).astype(jnp.float32)
    return a, bcoef


def _linear_scan(a, b, h0):
    b = b.at[:, 0].add(a[:, 0] * h0)

    def comb(left, right):
        return left[0] * right[0], right[0] * left[1] + right[1]

    _, h = lax.associative_scan(comb, (a, b), axis=1)
    return h


def _bidir_rglru(xl, xc, ga_w, ga_b, gx_w, gx_b, lam):
    B = xl.shape[0]
    h0 = jnp.zeros((B, D_RNN), jnp.float32)
    outs_l, outs_c = [], []
    for d in range(2):
        seq_c = xc if d == 0 else jnp.flip(xc, axis=1)
        seq_l = xl if d == 0 else jnp.flip(xl, axis=1)
        a, b = _rglru_coeffs(seq_c, ga_w[d], ga_b[d], gx_w[d], gx_b[d], lam[d])
        hc = _linear_scan(a, b, h0)
        a, b = _rglru_coeffs(seq_l, ga_w[d], ga_b[d], gx_w[d], gx_b[d], lam[d])
        hl = _linear_scan(a, b, hc[:, -1])
        if d == 1:
            hc = jnp.flip(hc, axis=1)
            hl = jnp.flip(hl, axis=1)
        outs_l.append(hl)
        outs_c.append(hc)
    return (outs_l[0] + outs_l[1]).astype(xl.dtype), (outs_c[0] + outs_c[1]).astype(xc.dtype)


def _merge(attn, rec, g_attn, g_rec, w_o_attn, w_o_lru, w_out):
    m = jax.nn.sigmoid(g_attn) * (attn @ w_o_attn) + jax.nn.sigmoid(g_rec) * (rec @ w_o_lru)
    return m @ w_out


def _token_mixer(hl, hc, ang_row, ang_col, w_in, sink, conv_w, conv_b, ga_w, ga_b, gx_w, gx_b, lam,
                 w_o_attn, w_o_lru, w_out, need_ctx):
    B, S = hl.shape[0], hl.shape[1]
    C = hc.shape[1]
    ql, kl, vl, xl, yl, gal, grl = jnp.split(hl @ w_in, SPLIT_IDX, axis=-1)
    qc, kc, vc, xc, yc, gac, grc = jnp.split(hc @ w_in, SPLIT_IDX, axis=-1)
    ql = _rope_2d(ql.reshape(B, S, N_HEADS, HEAD_DIM), ang_row, ang_col)
    kl = _rope_2d(kl.reshape(B, S, N_KV_HEADS, HEAD_DIM), ang_row, ang_col)
    vl = vl.reshape(B, S, N_KV_HEADS, HEAD_DIM)
    kc = kc.reshape(B, C, N_KV_HEADS, HEAD_DIM)
    vc = vc.reshape(B, C, N_KV_HEADS, HEAD_DIM)
    attn_l = _windowed_attention(ql, kl, vl, kc, vc, sink)
    xl = _conv_centred(xl, conv_w, conv_b)
    xc = _conv_centred(xc, conv_w, conv_b)
    rl, rc = _bidir_rglru(xl, xc, ga_w, ga_b, gx_w, gx_b, lam)
    out_l = _merge(attn_l, rl * jax.nn.gelu(yl), gal, grl, w_o_attn, w_o_lru, w_out)
    if not need_ctx:
        return out_l, None
    attn_c = _context_attention(qc.reshape(B, C, N_HEADS, HEAD_DIM), kc, vc, sink)
    out_c = _merge(attn_c, rc * jax.nn.gelu(yc), gac, grc, w_o_attn, w_o_lru, w_out)
    return out_l, out_c


def _swiglu(h, wg, wu, wd):
    return (jax.nn.silu(h @ wg) * (h @ wu)) @ wd


def _moe(h, w_r, wg, wu, wd):
    logits = (h @ w_r).astype(jnp.float32)
    top_v, top_i = lax.top_k(logits, TOP_K)
    top_w = jax.nn.softmax(top_v, axis=-1)
    gates = jnp.sum(jax.nn.one_hot(top_i, N_EXPERTS, dtype=jnp.float32) * top_w[..., None], axis=-2)
    gates = gates.astype(h.dtype)
    out = gates[..., 0:1] * _swiglu(h, wg[0], wu[0], wd[0])
    for e in range(1, N_EXPERTS):
        out = out + gates[..., e:e + 1] * _swiglu(h, wg[e], wu[e], wd[e])
    return out


def setup_inputs(seed: int = 0) -> dict:
    key = jax.random.key(seed)
    ks = jax.random.split(key, 32)
    f32 = jnp.float32

    def nrm(k, shape, s):
        return jax.random.normal(k, shape, f32) * s

    u = jax.random.uniform(ks[15], (DEPTH, 2, D_RNN), f32, minval=0.9, maxval=0.999)
    a = u ** (1.0 / LRU_C)
    lru_lambda = jnp.log(a) - jnp.log1p(-a)
    return {
        "x": nrm(ks[0], (BATCH, SEQ, D_MODEL), 1.0),
        "c": nrm(ks[1], (BATCH, D_MODEL), 1.0),
        "ctx": nrm(ks[2], (BATCH, CTX_LEN, D_MODEL), 1.0),
        "c_ctx": nrm(ks[3], (D_MODEL,), 1.0),
        "w_mod": nrm(ks[4], (DEPTH, D_MODEL, 6 * D_MODEL), 0.5 * D_MODEL ** -0.5),
        "b_mod": nrm(ks[5], (DEPTH, 6 * D_MODEL), 0.02),
        "norm1_g": 1.0 + nrm(ks[6], (DEPTH, D_MODEL), 0.05),
        "norm2_g": 1.0 + nrm(ks[7], (DEPTH, D_MODEL), 0.05),
        "w_in": nrm(ks[8], (DEPTH, D_MODEL, IN_COLS), D_MODEL ** -0.5),
        "attn_sink": nrm(ks[9], (DEPTH, N_HEADS), 0.5),
        "conv_w": nrm(ks[10], (DEPTH, CONV_W, D_RNN), CONV_W ** -0.5),
        "conv_b": nrm(ks[11], (DEPTH, D_RNN), 0.02),
        "gate_a_w": nrm(ks[12], (DEPTH, 2, N_RNN_BLOCKS, RNN_BLOCK, RNN_BLOCK), RNN_BLOCK ** -0.5),
        "gate_a_b": nrm(ks[13], (DEPTH, 2, D_RNN), 0.02),
        "gate_x_w": nrm(ks[14], (DEPTH, 2, N_RNN_BLOCKS, RNN_BLOCK, RNN_BLOCK), RNN_BLOCK ** -0.5),
        "gate_x_b": nrm(ks[16], (DEPTH, 2, D_RNN), 0.02),
        "lru_lambda": lru_lambda,
        "w_o_attn": nrm(ks[17], (DEPTH, Q_COLS, D_MODEL), Q_COLS ** -0.5),
        "w_o_lru": nrm(ks[18], (DEPTH, D_RNN, D_MODEL), D_RNN ** -0.5),
        "w_out": nrm(ks[19], (DEPTH, D_MODEL, D_MODEL), D_MODEL ** -0.5),
        "ff_w_gate": nrm(ks[20], (N_DENSE_LAYERS, D_MODEL, D_FF), D_MODEL ** -0.5),
        "ff_w_up": nrm(ks[21], (N_DENSE_LAYERS, D_MODEL, D_FF), D_MODEL ** -0.5),
        "ff_w_down": nrm(ks[22], (N_DENSE_LAYERS, D_FF, D_MODEL), D_FF ** -0.5),
        "router_w": nrm(ks[23], (N_MOE_LAYERS, D_MODEL, N_EXPERTS), D_MODEL ** -0.5),
        "exp_w_gate": nrm(ks[24], (N_MOE_LAYERS, N_EXPERTS, D_MODEL, D_FF_EXPERT), D_MODEL ** -0.5),
        "exp_w_up": nrm(ks[25], (N_MOE_LAYERS, N_EXPERTS, D_MODEL, D_FF_EXPERT), D_MODEL ** -0.5),
        "exp_w_down": nrm(ks[26], (N_MOE_LAYERS, N_EXPERTS, D_FF_EXPERT, D_MODEL), D_FF_EXPERT ** -0.5),
        "final_g": 1.0 + nrm(ks[27], (D_MODEL,), 0.05),
    }


def reference(x, c, ctx, c_ctx, w_mod, b_mod, norm1_g, norm2_g, w_in, attn_sink, conv_w, conv_b,
              gate_a_w, gate_a_b, gate_x_w, gate_x_b, lru_lambda, w_o_attn, w_o_lru, w_out,
              ff_w_gate, ff_w_up, ff_w_down, router_w, exp_w_gate, exp_w_up, exp_w_down, final_g):
    S = x.shape[1]
    C = ctx.shape[1]
    rows = S // GRID_W
    row = jnp.repeat(jnp.arange(rows), GRID_W)
    col = jnp.tile(jnp.arange(GRID_W), rows)
    ang_row, ang_col = _axial_angles(row, col)
    s_c = jax.nn.silu(c)
    s_cc = jax.nn.silu(c_ctx)
    h_lat = x
    h_ctx = ctx
    for l in range(DEPTH):
        last = l == DEPTH - 1
        mod_l = (s_c @ w_mod[l] + b_mod[l])[:, None, :]
        mod_c = (s_cc @ w_mod[l] + b_mod[l])[None, None, :]
        sh1, sc1, g1, sh2, sc2, g2 = jnp.split(mod_l, 6, axis=-1)
        csh1, csc1, cg1, csh2, csc2, cg2 = jnp.split(mod_c, 6, axis=-1)
        nl = _modulate(_rmsnorm(h_lat, norm1_g[l]), sh1, sc1)
        nc = _modulate(_rmsnorm(h_ctx, norm1_g[l]), csh1, csc1)
        yl, yc = _token_mixer(nl, nc, ang_row, ang_col, w_in[l], attn_sink[l], conv_w[l], conv_b[l],
                              gate_a_w[l], gate_a_b[l], gate_x_w[l], gate_x_b[l], lru_lambda[l],
                              w_o_attn[l], w_o_lru[l], w_out[l], not last)
        h_lat = h_lat + g1 * yl
        nl2 = _modulate(_rmsnorm(h_lat, norm2_g[l]), sh2, sc2)
        if last:
            n2 = nl2
        else:
            h_ctx = h_ctx + cg1 * yc
            nc2 = _modulate(_rmsnorm(h_ctx, norm2_g[l]), csh2, csc2)
            n2 = jnp.concatenate([nc2, nl2], axis=1)
        i = l // 2
        if l % 2 == 0:
            f = _swiglu(n2, ff_w_gate[i], ff_w_up[i], ff_w_down[i])
        else:
            f = _moe(n2, router_w[i], exp_w_gate[i], exp_w_up[i], exp_w_down[i])
        if last:
            h_lat = h_lat + g2 * f
        else:
            h_ctx = h_ctx + cg2 * f[:, :C]
            h_lat = h_lat + g2 * f[:, C:]
    return _rmsnorm(h_lat, final_g)
```

```cpp
#include <hip/hip_runtime.h>
#include <cstdio>
#include <cstdint>

constexpr int D = 1024, BATCH = 2, SEQ = 8192, DEPTH = 4, CTX = 256, GRIDW = 64;
constexpr int NH = 8, NKV = 2, HD = 128, WIN = 128;
constexpr int DFF = 2816, NE = 8, DFE = 3584;
constexpr int INC = 5632;
constexpr int OFF_Q = 0, OFF_K = 1024, OFF_V = 1280, OFF_X = 1536, OFF_Y = 2560, OFF_GA = 3584, OFF_GR = 4608;
constexpr int ML = BATCH * SEQ, MC = BATCH * CTX, MT = ML + MC;
constexpr int NSLOT = 35840;
constexpr float EPS = 1e-6f;
constexpr size_t MiB = 1u << 20;

typedef float f32x4 __attribute__((ext_vector_type(4)));

__device__ __forceinline__ float sigm(float x) { return 1.f / (1.f + expf(-x)); }
__device__ __forceinline__ float silu_f(float x) { return x * sigm(x); }
__device__ __forceinline__ float gelu_tanh(float x) { return 0.5f * x * (1.f + tanhf(0.7978845608028654f * (x + 0.044715f * x * x * x))); }
__device__ __forceinline__ float wave_sum(float v) {
#pragma unroll
    for (int o = 1; o < 64; o <<= 1) v += __shfl_xor(v, o);
    return v;
}
__device__ __forceinline__ float wave_max(float v) {
#pragma unroll
    for (int o = 1; o < 64; o <<= 1) v = fmaxf(v, __shfl_xor(v, o));
    return v;
}
__device__ __forceinline__ int row_vec(int m) { return m < ML ? m / SEQ : 2; }

namespace nv {
__global__ __launch_bounds__(256) void k_mod(const float* c, const float* c_ctx, const float* w_mod, const float* b_mod, float* MOD) {
    __shared__ float s[3][D];
    const int l = blockIdx.y, n = blockIdx.x * 256 + threadIdx.x;
    for (int i = threadIdx.x; i < 3 * D; i += 256) { const int v = i / D, k = i % D; const float x = v < 2 ? c[v * D + k] : c_ctx[k]; s[v][k] = silu_f(x); }
    __syncthreads();
    const float* w = w_mod + (size_t)l * D * 6 * D + n;
    float a0 = 0.f, a1 = 0.f, a2 = 0.f;
    for (int k = 0; k < D; ++k) { const float wv = w[(size_t)k * 6 * D]; a0 += s[0][k] * wv; a1 += s[1][k] * wv; a2 += s[2][k] * wv; }
    const float b = b_mod[l * 6 * D + n];
    float* o = MOD + (size_t)l * 3 * 6 * D + n;
    o[0] = a0 + b; o[6 * D] = a1 + b; o[12 * D] = a2 + b;
}
__global__ __launch_bounds__(256) void k_norm_mod(const float* H, const float* g, const float* MODl, int sh_off, int sc_off, float* XN, int nrows) {
    const int m = (blockIdx.x * 256 + threadIdx.x) >> 6, lane = threadIdx.x & 63;
    if (m >= nrows) return;
    const float* h = H + (size_t)m * D;
    float v[16]; float ss = 0.f;
#pragma unroll
    for (int j = 0; j < 16; ++j) { v[j] = h[lane + 64 * j]; ss += v[j] * v[j]; }
    ss = wave_sum(ss);
    const float r = rsqrtf(ss * (1.f / D) + EPS);
    const float* mv = MODl + (size_t)row_vec(m) * 6 * D;
#pragma unroll
    for (int j = 0; j < 16; ++j) { const int n = lane + 64 * j; XN[(size_t)m * D + n] = (v[j] * r * g[n]) * (1.f + mv[sc_off + n]) + mv[sh_off + n]; }
}
struct NGemm {
    const float* A; int lda; const int* arow;
    const float* B; int ldb; float* C; int ldc; int K;
    long sA, sB, sC;
    const int* tile_e; long sBe;
    int mode;
};
__global__ __launch_bounds__(256) void k_gemm(NGemm g) {
    const int z = blockIdx.z, tm = blockIdx.y, tn = blockIdx.x;
    const float* A = g.A + (long)z * g.sA; const float* B = g.B + (long)z * g.sB; float* C = g.C + (long)z * g.sC;
    if (g.tile_e) { const int e = g.tile_e[tm]; if (e < 0) return; B += (long)e * g.sBe; }
    const int wave = threadIdx.x >> 6, lane = threadIdx.x & 63, lr = lane & 15, lk = lane >> 4;
    const int m0 = tm * 128 + (wave >> 1) * 64, n0 = tn * 128 + (wave & 1) * 64;
    const float* ap0; const float* ap1; const float* ap2; const float* ap3;
    {
        int r0 = m0 + lr, r1 = r0 + 16, r2 = r0 + 32, r3 = r0 + 48;
        if (g.arow) { r0 = g.arow[r0]; r1 = g.arow[r1]; r2 = g.arow[r2]; r3 = g.arow[r3]; r0 = r0 < 0 ? 0 : r0; r1 = r1 < 0 ? 0 : r1; r2 = r2 < 0 ? 0 : r2; r3 = r3 < 0 ? 0 : r3; }
        ap0 = A + (long)r0 * g.lda + lk; ap1 = A + (long)r1 * g.lda + lk; ap2 = A + (long)r2 * g.lda + lk; ap3 = A + (long)r3 * g.lda + lk;
    }
    const float* bp = B + (long)lk * g.ldb + n0 + lr;
    f32x4 acc[4][4];
#pragma unroll
    for (int i = 0; i < 4; ++i)
#pragma unroll
        for (int j = 0; j < 4; ++j) acc[i][j] = (f32x4){0.f, 0.f, 0.f, 0.f};
    const long ldb = g.ldb;
#pragma unroll 2
    for (int k = 0; k < g.K; k += 4) {
        float a[4], b[4];
        a[0] = ap0[k]; a[1] = ap1[k]; a[2] = ap2[k]; a[3] = ap3[k];
        const float* bk = bp + (long)k * ldb;
        b[0] = bk[0]; b[1] = bk[16]; b[2] = bk[32]; b[3] = bk[48];
#pragma unroll
        for (int i = 0; i < 4; ++i)
#pragma unroll
            for (int j = 0; j < 4; ++j) acc[i][j] = __builtin_amdgcn_mfma_f32_16x16x4f32(a[i], b[j], acc[i][j], 0, 0, 0);
    }
#pragma unroll
    for (int i = 0; i < 4; ++i)
#pragma unroll
        for (int j = 0; j < 4; ++j)
#pragma unroll
            for (int r = 0; r < 4; ++r) {
                float* cp = C + (long)(m0 + 16 * i + 4 * lk + r) * g.ldc + n0 + 16 * j + lr;
                const float v = acc[i][j][r];
                *cp = g.mode == 1 ? silu_f(*cp) * v : v;
            }
}
__global__ __launch_bounds__(256) void k_rope(float* P) {
    const long idx = (long)blockIdx.x * 256 + threadIdx.x;
    if (idx >= (long)ML * 10 * 64) return;
    const int pi = (int)(idx & 63), slot = (int)((idx >> 6) % 10), m = (int)(idx / 640);
    const int t = m % SEQ, half = pi >> 5, i = pi & 31;
    const int base = (slot < 8 ? OFF_Q + slot * HD : OFF_K + (slot - 8) * HD) + half * 64;
    const float pos = half == 0 ? (float)(t / GRIDW) : (float)(t % GRIDW);
    const float inv = powf(10000.f, -(float)i / 32.f);
    const float ang = pos * inv, cs = cosf(ang), sn = sinf(ang);
    float* p = P + (size_t)m * INC + base;
    const float x1 = p[i], x2 = p[32 + i];
    p[i] = x1 * cs - x2 * sn; p[32 + i] = x2 * cs + x1 * sn;
}
__global__ __launch_bounds__(256) void k_attn(const float* P, const float* sink, float* O) {
    __shared__ float ps[4][576];
    __shared__ int prow[4][576];
    const int w = threadIdx.x >> 6, lane = threadIdx.x & 63;
    const int gw = blockIdx.x * 4 + w;
    const int m = gw >> 3, h = gw & 7, kvh = h >> 2;
    const bool lat = m < ML;
    const int b = lat ? m / SEQ : (m - ML) / CTX, t = lat ? m % SEQ : 0;
    const int lo = lat ? (t - WIN < 0 ? 0 : t - WIN) : 0, hi = lat ? (t + WIN > SEQ - 1 ? SEQ - 1 : t + WIN) : -1;
    const int nlat = lat ? hi - lo + 1 : 0, nk = nlat + CTX;
    const f32x4* q = (const f32x4*)(P + (size_t)m * INC + OFF_Q + h * HD);
    const float scale = 0.08838834764831845f;
    const float sk = sink[h];
    float sc[9]; float mx = sk;
#pragma unroll
    for (int i = 0; i < 9; ++i) {
        const int j = lane + 64 * i; float s = -INFINITY;
        if (j < nk) {
            const int row = j < nlat ? b * SEQ + lo + j : ML + b * CTX + (j - nlat);
            const f32x4* kp = (const f32x4*)(P + (size_t)row * INC + OFF_K + kvh * HD);
            float d = 0.f;
            for (int e = 0; e < 32; ++e) { const f32x4 a = q[e], c = kp[e]; d += a.x * c.x + a.y * c.y + a.z * c.z + a.w * c.w; }
            s = d * scale; prow[w][j] = row;
        }
        sc[i] = s; mx = fmaxf(mx, s);
    }
    mx = wave_max(mx);
    float sum = 0.f;
#pragma unroll
    for (int i = 0; i < 9; ++i) { const int j = lane + 64 * i; if (j < nk) { const float p = expf(sc[i] - mx); ps[w][j] = p; sum += p; } }
    sum = wave_sum(sum) + expf(sk - mx);
    const float rs = 1.f / sum;
    __syncthreads();
    float o0 = 0.f, o1 = 0.f;
    for (int j = 0; j < nk; ++j) { const float p = ps[w][j]; const float* vp = P + (size_t)prow[w][j] * INC + OFF_V + kvh * HD; o0 += p * vp[lane]; o1 += p * vp[lane + 64]; }
    float* op = O + (size_t)m * D + h * HD;
    op[lane] = o0 * rs; op[lane + 64] = o1 * rs;
}
__global__ __launch_bounds__(256) void k_conv(const float* P, const float* cw, const float* cb, float* XC) {
    const long idx = (long)blockIdx.x * 256 + threadIdx.x;
    if (idx >= (long)MT * D) return;
    const int ch = (int)(idx & (D - 1)), m = (int)(idx >> 10);
    const bool lat = m < ML; const int L = lat ? SEQ : CTX, t = lat ? m % SEQ : (m - ML) % CTX;
    float y = 0.f;
#pragma unroll
    for (int j = 0; j < 4; ++j) { const int tt = t + j - 2; if (tt >= 0 && tt < L) y += P[(size_t)(m + j - 2) * INC + OFF_X + ch] * cw[j * D + ch]; }
    XC[idx] = y + cb[ch];
}
__device__ __forceinline__ void scan_seq(const float* XC, const float* RG, const float* IG, float* REC, int mbase, int L, int dir, int ch, float sp, float bav, float bxv, float& h) {
    for (int s0 = 0; s0 < L; s0 += 8) {
        float x[8], r[8], g[8], pr[8];
#pragma unroll
        for (int u = 0; u < 8; ++u) { const int t = dir == 0 ? s0 + u : L - 1 - (s0 + u); const size_t o = (size_t)(mbase + t) * D + ch; x[u] = XC[o]; r[u] = RG[o]; g[u] = IG[o]; pr[u] = dir == 0 ? 0.f : REC[o]; }
#pragma unroll
        for (int u = 0; u < 8; ++u) { const int t = dir == 0 ? s0 + u : L - 1 - (s0 + u); const size_t o = (size_t)(mbase + t) * D + ch;
            const float rr = sigm(r[u] + bav), ig = sigm(g[u] + bxv);
            const float la = -8.f * rr * sp, a = expf(la), bc = sqrtf(-expm1f(2.f * la)) * (ig * x[u]);
            h = a * h + bc; REC[o] = pr[u] + h; }
    }
}
__global__ __launch_bounds__(64) void k_scan(const float* XC, const float* RG, const float* IG, const float* ba, const float* bx, const float* lam, int dir, float* REC) {
    const int idx = blockIdx.x * 64 + threadIdx.x;
    const int b = idx >> 10, ch = idx & (D - 1);
    const float sp = log1pf(expf(-lam[ch])), bav = ba[ch], bxv = bx[ch];
    float h = 0.f;
    scan_seq(XC, RG, IG, REC, ML + b * CTX, CTX, dir, ch, sp, bav, bxv, h);
    scan_seq(XC, RG, IG, REC, b * SEQ, SEQ, dir, ch, sp, bav, bxv, h);
}
__global__ __launch_bounds__(256) void k_recgate(float* REC, const float* P) {
    const long idx = (long)blockIdx.x * 256 + threadIdx.x; if (idx >= (long)MT * D) return;
    const int ch = (int)(idx & (D - 1)), m = (int)(idx >> 10);
    REC[idx] *= gelu_tanh(P[(size_t)m * INC + OFF_Y + ch]);
}
__global__ __launch_bounds__(256) void k_merge(float* T1, const float* T2, const float* P) {
    const long idx = (long)blockIdx.x * 256 + threadIdx.x; if (idx >= (long)MT * D) return;
    const int ch = (int)(idx & (D - 1)), m = (int)(idx >> 10);
    const float* p = P + (size_t)m * INC;
    T1[idx] = sigm(p[OFF_GA + ch]) * T1[idx] + sigm(p[OFF_GR + ch]) * T2[idx];
}
__global__ __launch_bounds__(256) void k_resid(float* H, const float* Y, const float* MODl, int g_off) {
    const long idx = (long)blockIdx.x * 256 + threadIdx.x; if (idx >= (long)MT * D) return;
    const int n = (int)(idx & (D - 1)), m = (int)(idx >> 10);
    H[idx] += MODl[(size_t)row_vec(m) * 6 * D + g_off + n] * Y[idx];
}
__global__ __launch_bounds__(256) void k_route(const float* XN, const float* wr, int* te, float* tw) {
    const int m = (blockIdx.x * 256 + threadIdx.x) >> 6, lane = threadIdx.x & 63;
    if (m >= MT) return;
    float lg[NE];
#pragma unroll
    for (int e = 0; e < NE; ++e) lg[e] = 0.f;
    for (int j = 0; j < 16; ++j) { const int k = lane + 64 * j; const float x = XN[(size_t)m * D + k]; const float* w = wr + (size_t)k * NE;
#pragma unroll
        for (int e = 0; e < NE; ++e) lg[e] += x * w[e]; }
#pragma unroll
    for (int e = 0; e < NE; ++e) lg[e] = wave_sum(lg[e]);
    if (lane == 0) {
        int i0 = 0; float v0 = lg[0];
#pragma unroll
        for (int e = 1; e < NE; ++e) if (lg[e] > v0) { v0 = lg[e]; i0 = e; }
        int i1 = -1; float v1 = -INFINITY;
#pragma unroll
        for (int e = 0; e < NE; ++e) if (e != i0 && lg[e] > v1) { v1 = lg[e]; i1 = e; }
        const float e1 = expf(v1 - v0), w0 = 1.f / (1.f + e1), w1 = e1 / (1.f + e1);
        te[2 * m] = i0; te[2 * m + 1] = i1; tw[2 * m] = w0; tw[2 * m + 1] = w1;
    }
}
__global__ __launch_bounds__(1024) void k_moe_lists(const int* te, int* slot_tok, int* tok_slot, int* tile_e) {
    __shared__ int cnt[NE], off[NE + 1], cur[NE];
    const int tid = threadIdx.x;
    if (tid < NE) { cnt[tid] = 0; cur[tid] = 0; }
    for (int i = tid; i < NSLOT; i += 1024) slot_tok[i] = -1;
    __syncthreads();
    for (int i = tid; i < 2 * MT; i += 1024) atomicAdd(&cnt[te[i]], 1);
    __syncthreads();
    if (tid == 0) { int o = 0; for (int e = 0; e < NE; ++e) { off[e] = o; o += (cnt[e] + 255) / 256 * 256; } off[NE] = o; }
    __syncthreads();
    for (int i = tid; i < NSLOT / 128; i += 1024) { int e = -1; for (int x = 0; x < NE; ++x) if (i * 128 >= off[x] && i * 128 < off[x + 1]) e = x; tile_e[i] = e; }
    for (int i = tid; i < 2 * MT; i += 1024) { const int e = te[i]; const int pos = atomicAdd(&cur[e], 1); const int s = off[e] + pos; slot_tok[s] = i >> 1; tok_slot[i] = s; }
}
__global__ __launch_bounds__(256) void k_moe_combine(float* H, const float* FS, const int* tok_slot, const float* tw, const float* MODl, int g_off) {
    const long idx = (long)blockIdx.x * 256 + threadIdx.x; if (idx >= (long)MT * D) return;
    const int n = (int)(idx & (D - 1)), m = (int)(idx >> 10);
    const float f = tw[2 * m] * FS[(size_t)tok_slot[2 * m] * D + n] + tw[2 * m + 1] * FS[(size_t)tok_slot[2 * m + 1] * D + n];
    H[idx] += MODl[(size_t)row_vec(m) * 6 * D + g_off + n] * f;
}
__global__ __launch_bounds__(256) void k_final(const float* H, const float* g, float* out) {
    const int m = (blockIdx.x * 256 + threadIdx.x) >> 6, lane = threadIdx.x & 63;
    if (m >= ML) return;
    const float* h = H + (size_t)m * D;
    float v[16]; float ss = 0.f;
#pragma unroll
    for (int j = 0; j < 16; ++j) { v[j] = h[lane + 64 * j]; ss += v[j] * v[j]; }
    ss = wave_sum(ss);
    const float r = rsqrtf(ss * (1.f / D) + EPS);
#pragma unroll
    for (int j = 0; j < 16; ++j) { const int n = lane + 64 * j; out[(size_t)m * D + n] = v[j] * r * g[n]; }
}
}

constexpr size_t NW_MOD = 2 * MiB, NW_ROUTE = 3 * MiB;
constexpr size_t NW_H = 4 * MiB, NW_XN = 70 * MiB, NW_P = 136 * MiB, NW_XC = 499 * MiB, NW_RG = 565 * MiB, NW_IG = 631 * MiB, NW_REC = 697 * MiB, NW_ATT = 763 * MiB, NW_END = 829 * MiB;
constexpr size_t NW_BIG = NW_P;
constexpr size_t NW_FS = NW_IG;
static_assert((size_t)MT * D * 4 == 66 * MiB && (size_t)MT * INC * 4 == 363 * MiB, "sizes");
static_assert(NW_BIG + (size_t)NSLOT * DFE * 4 <= NW_IG && NW_FS + (size_t)NSLOT * D * 4 <= NW_END, "overlays");

static void ngemm(hipStream_t st, const float* A, int lda, const int* arow, const float* B, int ldb, float* C, int ldc, int M, int N, int K,
                  int nz = 1, long sA = 0, long sB = 0, long sC = 0, const int* tile_e = nullptr, long sBe = 0, int mode = 0) {
    nv::NGemm g{}; g.A = A; g.lda = lda; g.arow = arow; g.B = B; g.ldb = ldb; g.C = C; g.ldc = ldc; g.K = K; g.sA = sA; g.sB = sB; g.sC = sC; g.tile_e = tile_e; g.sBe = sBe; g.mode = mode;
    hipLaunchKernelGGL(nv::k_gemm, dim3(N / 128, M / 128, nz), dim3(256), 0, st, g);
}

extern "C" void kernel_launch(void* const* d_in, const int* in_sizes, int n_in, void* d_out, int out_size, void* d_ws, size_t ws_size, hipStream_t stream) {
    if (n_in != 28 || ws_size < NW_END) { fprintf(stderr, "kernel_launch: unexpected n_in %d or ws_size %zu\n", n_in, ws_size); return; }
    const float* x = (const float*)d_in[0]; const float* c = (const float*)d_in[1]; const float* ctx = (const float*)d_in[2]; const float* c_ctx = (const float*)d_in[3];
    const float* w_mod = (const float*)d_in[4]; const float* b_mod = (const float*)d_in[5]; const float* norm1_g = (const float*)d_in[6]; const float* norm2_g = (const float*)d_in[7];
    const float* w_in = (const float*)d_in[8]; const float* attn_sink = (const float*)d_in[9]; const float* conv_w = (const float*)d_in[10]; const float* conv_b = (const float*)d_in[11];
    const float* gate_a_w = (const float*)d_in[12]; const float* gate_a_b = (const float*)d_in[13]; const float* gate_x_w = (const float*)d_in[14]; const float* gate_x_b = (const float*)d_in[15];
    const float* lru_lambda = (const float*)d_in[16]; const float* w_o_attn = (const float*)d_in[17]; const float* w_o_lru = (const float*)d_in[18]; const float* w_out = (const float*)d_in[19];
    const float* ff_w_gate = (const float*)d_in[20]; const float* ff_w_up = (const float*)d_in[21]; const float* ff_w_down = (const float*)d_in[22]; const float* router_w = (const float*)d_in[23];
    const float* exp_w_gate = (const float*)d_in[24]; const float* exp_w_up = (const float*)d_in[25]; const float* exp_w_down = (const float*)d_in[26]; const float* final_g = (const float*)d_in[27];
    char* ws = (char*)d_ws;
    float* MOD = (float*)(ws + NW_MOD);
    int* te = (int*)(ws + NW_ROUTE); float* tw = (float*)(ws + NW_ROUTE + 256 * 1024); int* slot_tok = (int*)(ws + NW_ROUTE + 512 * 1024); int* tok_slot = (int*)(ws + NW_ROUTE + 704 * 1024); int* tile_e = (int*)(ws + NW_ROUTE + 896 * 1024);
    float* H = (float*)(ws + NW_H); float* XN = (float*)(ws + NW_XN); float* P = (float*)(ws + NW_P); float* XC = (float*)(ws + NW_XC); float* RG = (float*)(ws + NW_RG);
    float* IG = (float*)(ws + NW_IG); float* REC = (float*)(ws + NW_REC); float* ATT = (float*)(ws + NW_ATT); float* BIG = (float*)(ws + NW_BIG); float* FS = (float*)(ws + NW_FS);
    const int EB = (int)(((long)MT * D + 255) / 256);

    (void)hipMemcpyAsync(H, x, (size_t)ML * D * 4, hipMemcpyDeviceToDevice, stream);
    (void)hipMemcpyAsync(H + (size_t)ML * D, ctx, (size_t)MC * D * 4, hipMemcpyDeviceToDevice, stream);
    hipLaunchKernelGGL(nv::k_mod, dim3(6 * D / 256, DEPTH), dim3(256), 0, stream, c, c_ctx, w_mod, b_mod, MOD);
    for (int l = 0; l < DEPTH; ++l) {
        const float* MODl = MOD + (size_t)l * 3 * 6 * D;
        hipLaunchKernelGGL(nv::k_norm_mod, dim3(MT / 4), dim3(256), 0, stream, H, norm1_g + l * D, MODl, 0, D, XN, MT);
        ngemm(stream, XN, D, nullptr, w_in + (size_t)l * D * INC, INC, P, INC, MT, INC, D);
        hipLaunchKernelGGL(nv::k_rope, dim3((ML * 640 + 255) / 256), dim3(256), 0, stream, P);
        hipLaunchKernelGGL(nv::k_attn, dim3(MT * NH / 4), dim3(256), 0, stream, P, attn_sink + l * NH, ATT);
        hipLaunchKernelGGL(nv::k_conv, dim3(EB), dim3(256), 0, stream, P, conv_w + (size_t)l * 4 * D, conv_b + l * D, XC);
        for (int d = 0; d < 2; ++d) {
            const size_t go = ((size_t)l * 2 + d) * 8 * 128 * 128, vo = ((size_t)l * 2 + d) * D;
            ngemm(stream, XC, D, nullptr, gate_a_w + go, 128, RG, D, MT, 128, 128, 8, 128, 128 * 128, 128);
            ngemm(stream, XC, D, nullptr, gate_x_w + go, 128, IG, D, MT, 128, 128, 8, 128, 128 * 128, 128);
            hipLaunchKernelGGL(nv::k_scan, dim3(BATCH * D / 64), dim3(64), 0, stream, XC, RG, IG, gate_a_b + vo, gate_x_b + vo, lru_lambda + vo, d, REC);
        }
        hipLaunchKernelGGL(nv::k_recgate, dim3(EB), dim3(256), 0, stream, REC, P);
        ngemm(stream, ATT, D, nullptr, w_o_attn + (size_t)l * D * D, D, RG, D, MT, D, D);
        ngemm(stream, REC, D, nullptr, w_o_lru + (size_t)l * D * D, D, IG, D, MT, D, D);
        hipLaunchKernelGGL(nv::k_merge, dim3(EB), dim3(256), 0, stream, RG, IG, P);
        ngemm(stream, RG, D, nullptr, w_out + (size_t)l * D * D, D, XC, D, MT, D, D);
        hipLaunchKernelGGL(nv::k_resid, dim3(EB), dim3(256), 0, stream, H, XC, MODl, 2 * D);
        hipLaunchKernelGGL(nv::k_norm_mod, dim3(MT / 4), dim3(256), 0, stream, H, norm2_g + l * D, MODl, 3 * D, 4 * D, XN, MT);
        const int i = l / 2;
        if (l % 2 == 0) {
            ngemm(stream, XN, D, nullptr, ff_w_gate + (size_t)i * D * DFF, DFF, BIG, DFF, MT, DFF, D);
            ngemm(stream, XN, D, nullptr, ff_w_up + (size_t)i * D * DFF, DFF, BIG, DFF, MT, DFF, D, 1, 0, 0, 0, nullptr, 0, 1);
            ngemm(stream, BIG, DFF, nullptr, ff_w_down + (size_t)i * DFF * D, D, IG, D, MT, D, DFF);
            hipLaunchKernelGGL(nv::k_resid, dim3(EB), dim3(256), 0, stream, H, IG, MODl, 5 * D);
        } else {
            hipLaunchKernelGGL(nv::k_route, dim3(MT / 4), dim3(256), 0, stream, XN, router_w + (size_t)i * D * NE, te, tw);
            hipLaunchKernelGGL(nv::k_moe_lists, dim3(1), dim3(1024), 0, stream, te, slot_tok, tok_slot, tile_e);
            const size_t eo = (size_t)i * NE * D * DFE;
            ngemm(stream, XN, D, slot_tok, exp_w_gate + eo, DFE, BIG, DFE, NSLOT, DFE, D, 1, 0, 0, 0, tile_e, (long)D * DFE, 0);
            ngemm(stream, XN, D, slot_tok, exp_w_up + eo, DFE, BIG, DFE, NSLOT, DFE, D, 1, 0, 0, 0, tile_e, (long)D * DFE, 1);
            ngemm(stream, BIG, DFE, nullptr, exp_w_down + eo, D, FS, D, NSLOT, D, DFE, 1, 0, 0, 0, tile_e, (long)DFE * D, 0);
            hipLaunchKernelGGL(nv::k_moe_combine, dim3(EB), dim3(256), 0, stream, H, FS, tok_slot, tw, MODl, 5 * D);
        }
    }
    hipLaunchKernelGGL(nv::k_final, dim3(ML / 4), dim3(256), 0, stream, H, final_g, (float*)d_out);
}
```

```cpp
#include <hip/hip_runtime.h>
#include <cstdio>
#include <cstdint>

#ifndef OPT_STEP
#define OPT_STEP 8
#endif

constexpr int D = 1024, BATCH = 2, SEQ = 8192, DEPTH = 4, CTX = 256, GRIDW = 64;
constexpr int NH = 8, NKV = 2, HD = 128, WIN = 128;
constexpr int DFF = 2816, NE = 8, DFE = 3584;
constexpr int INC = 5632;
constexpr int OFF_Q = 0, OFF_K = 1024, OFF_V = 1280, OFF_X = 1536, OFF_Y = 2560, OFF_GA = 3584, OFF_GR = 4608;
constexpr int ML = BATCH * SEQ, MC = BATCH * CTX, MT = ML + MC;
constexpr int NSLOT = 35840;
constexpr int NCHUNK = MT / 64;
constexpr float EPS = 1e-6f;
constexpr size_t MiB = 1u << 20;

typedef unsigned short bf16;
typedef float f32x4 __attribute__((ext_vector_type(4)));
typedef float f32x2 __attribute__((ext_vector_type(2)));
typedef float f32x16 __attribute__((ext_vector_type(16)));
typedef unsigned u32x4 __attribute__((ext_vector_type(4)));
typedef unsigned u32x2 __attribute__((ext_vector_type(2)));
typedef short bf16x8 __attribute__((ext_vector_type(8)));
typedef __bf16 bf2_t __attribute__((ext_vector_type(2)));
#define LAS __attribute__((address_space(3)))
#define GAS __attribute__((address_space(1)))
typedef GAS unsigned gu32;

__device__ __forceinline__ unsigned pk2(float lo, float hi) { f32x2 v = {lo, hi}; return __builtin_bit_cast(unsigned, __builtin_convertvector(v, bf2_t)); }
__device__ __forceinline__ bf16 f2bf(float f) { return (bf16)(pk2(f, 0.f) & 0xffffu); }
__device__ __forceinline__ float bf2f(bf16 b) { return __uint_as_float(((unsigned)b) << 16); }
__device__ __forceinline__ float bflo(unsigned u) { return __uint_as_float(u << 16); }
__device__ __forceinline__ float bfhi(unsigned u) { return __uint_as_float(u & 0xffff0000u); }
__device__ __forceinline__ float ldf(const float* p) { return *p; }
__device__ __forceinline__ float ldf(const bf16* p) { return bf2f(*p); }
__device__ __forceinline__ void stf(float* p, float v) { *p = v; }
__device__ __forceinline__ void stf(bf16* p, float v) { *p = f2bf(v); }

__device__ __forceinline__ float sigm(float x) { return 1.f / (1.f + expf(-x)); }
__device__ __forceinline__ float silu_f(float x) { return x * sigm(x); }
__device__ __forceinline__ float gelu_tanh(float x) { return 0.5f * x * (1.f + tanhf(0.7978845608028654f * (x + 0.044715f * x * x * x))); }
__device__ __forceinline__ float fsigm(float x) { return __builtin_amdgcn_rcpf(1.f + __builtin_amdgcn_exp2f(-1.4426950408889634f * x)); }
__device__ __forceinline__ float fsilu(float x) { return x * fsigm(x); }
__device__ __forceinline__ float fgelu(float x) { return x * __builtin_amdgcn_rcpf(1.f + __builtin_amdgcn_exp2f(-2.302208198f * (x + 0.044715f * x * x * x))); }
__device__ __forceinline__ float wave_sum(float v) {
#pragma unroll
    for (int o = 1; o < 64; o <<= 1) v += __shfl_xor(v, o);
    return v;
}
__device__ __forceinline__ float wave_max(float v) {
#pragma unroll
    for (int o = 1; o < 64; o <<= 1) v = fmaxf(v, __shfl_xor(v, o));
    return v;
}
__device__ __forceinline__ int row_vec(int m) { return m < ML ? m / SEQ : 2; }
__host__ __device__ __forceinline__ int qk_orig(int ni) { return (ni >> 6) * 64 + (ni & 1) * 32 + ((ni & 63) >> 1); }

constexpr size_t WS_CTL = 0, CTL_ZERO_BYTES = 1 * MiB;
constexpr size_t WS_MOD = 2 * MiB, WS_ROPE = WS_MOD + 320 * 1024, WS_TE = WS_MOD + 384 * 1024, WS_TW = WS_MOD + 576 * 1024, WS_TOKSLOT = WS_MOD + 768 * 1024, WS_PANELE = WS_MOD + 960 * 1024;
constexpr size_t WS_SLOTTOK = 3 * MiB;
constexpr size_t WS_AGG = 4 * MiB;
constexpr size_t AGG_BYTES = (size_t)2 * NCHUNK * D * 4;
constexpr size_t WS_GT = 12 * MiB;
constexpr size_t WS_WIN = 16 * MiB;
constexpr size_t WS_WO = 60 * MiB;
constexpr size_t WS_FF = 84 * MiB, FF_STRIDE = (size_t)(2 * DFF * D + D * DFF) * 2;
constexpr size_t WS_EXP = 117 * MiB, EXP_STRIDE = (size_t)NE * (2 * DFE * D + D * DFE) * 2;
constexpr size_t WS_H = 453 * MiB, WS_XN = 519 * MiB, WS_P = 552 * MiB, WS_ATT = 734 * MiB, WS_RECG = 767 * MiB, WS_T1 = 800 * MiB, WS_MM = 833 * MiB, WS_XS = 866 * MiB, WS_END = 936 * MiB;
constexpr size_t WS_HID = WS_P, WS_FS = WS_XS;
static_assert(WS_FF + 2 * FF_STRIDE <= WS_EXP && WS_EXP + 2 * EXP_STRIDE <= WS_H && WS_HID + (size_t)NSLOT * DFE * 2 <= WS_T1 && WS_AGG + 3 * AGG_BYTES <= WS_GT, "ws map");
constexpr size_t NV_XC = WS_EXP, NV_RG = WS_EXP + 66 * MiB, NV_IG = WS_EXP + 132 * MiB, NV_REC = WS_EXP + 198 * MiB, NV_PF32 = 16 * MiB;
constexpr int CW_TMO = 0, CW_CNT = 2048, CW_CUR = 2048 + 256, CW_BAR = 4096;

namespace nv {
__global__ __launch_bounds__(256) void k_mod(const float* c, const float* c_ctx, const float* w_mod, const float* b_mod, float* MOD) {
    __shared__ float s[3][D];
    const int l = blockIdx.y, n = blockIdx.x * 256 + threadIdx.x;
    for (int i = threadIdx.x; i < 3 * D; i += 256) { const int v = i / D, k = i % D; const float x = v < 2 ? c[v * D + k] : c_ctx[k]; s[v][k] = silu_f(x); }
    __syncthreads();
    const float* w = w_mod + (size_t)l * D * 6 * D + n;
    float a0 = 0.f, a1 = 0.f, a2 = 0.f;
    for (int k = 0; k < D; ++k) { const float wv = w[(size_t)k * 6 * D]; a0 += s[0][k] * wv; a1 += s[1][k] * wv; a2 += s[2][k] * wv; }
    const float b = b_mod[l * 6 * D + n];
    float* o = MOD + (size_t)l * 3 * 6 * D + n;
    o[0] = a0 + b; o[6 * D] = a1 + b; o[12 * D] = a2 + b;
}
template <class TO> __global__ __launch_bounds__(256) void k_norm_mod(const float* H, const float* g, const float* MODl, int sh_off, int sc_off, TO* XN, int nrows) {
    const int m = (blockIdx.x * 256 + threadIdx.x) >> 6, lane = threadIdx.x & 63;
    if (m >= nrows) return;
    const float* h = H + (size_t)m * D;
    float v[16]; float ss = 0.f;
#pragma unroll
    for (int j = 0; j < 16; ++j) { v[j] = h[lane + 64 * j]; ss += v[j] * v[j]; }
    ss = wave_sum(ss);
    const float r = rsqrtf(ss * (1.f / D) + EPS);
    const float* mv = MODl + (size_t)row_vec(m) * 6 * D;
#pragma unroll
    for (int j = 0; j < 16; ++j) { const int n = lane + 64 * j; stf(XN + (size_t)m * D + n, (v[j] * r * g[n]) * (1.f + mv[sc_off + n]) + mv[sh_off + n]); }
}
template <class TA, class TC> struct NGemm {
    const TA* A; int lda; const int* arow;
    const float* B; int ldb; TC* C; int ldc; int K;
    long sA, sB, sC;
    const int* tile_e; long sBe;
    int mode;
};
template <class TA, class TC> __global__ __launch_bounds__(256) void k_gemm(NGemm<TA, TC> g) {
    const int z = blockIdx.z, tm = blockIdx.y, tn = blockIdx.x;
    const TA* A = g.A + (long)z * g.sA; const float* B = g.B + (long)z * g.sB; TC* C = g.C + (long)z * g.sC;
    if (g.tile_e) { const int e = g.tile_e[tm]; if (e < 0) return; B += (long)e * g.sBe; }
    const int wave = threadIdx.x >> 6, lane = threadIdx.x & 63, lr = lane & 15, lk = lane >> 4;
    const int m0 = tm * 128 + (wave >> 1) * 64, n0 = tn * 128 + (wave & 1) * 64;
    const TA* ap0; const TA* ap1; const TA* ap2; const TA* ap3;
    {
        int r0 = m0 + lr, r1 = r0 + 16, r2 = r0 + 32, r3 = r0 + 48;
        if (g.arow) { r0 = g.arow[r0]; r1 = g.arow[r1]; r2 = g.arow[r2]; r3 = g.arow[r3]; r0 = r0 < 0 ? 0 : r0; r1 = r1 < 0 ? 0 : r1; r2 = r2 < 0 ? 0 : r2; r3 = r3 < 0 ? 0 : r3; }
        ap0 = A + (long)r0 * g.lda + lk; ap1 = A + (long)r1 * g.lda + lk; ap2 = A + (long)r2 * g.lda + lk; ap3 = A + (long)r3 * g.lda + lk;
    }
    const float* bp = B + (long)lk * g.ldb + n0 + lr;
    f32x4 acc[4][4];
#pragma unroll
    for (int i = 0; i < 4; ++i)
#pragma unroll
        for (int j = 0; j < 4; ++j) acc[i][j] = (f32x4){0.f, 0.f, 0.f, 0.f};
    const long ldb = g.ldb;
    for (int k = 0; k < g.K; k += 4) {
        float a[4], b[4];
        a[0] = ldf(ap0 + k); a[1] = ldf(ap1 + k); a[2] = ldf(ap2 + k); a[3] = ldf(ap3 + k);
        const float* bk = bp + (long)k * ldb;
        b[0] = bk[0]; b[1] = bk[16]; b[2] = bk[32]; b[3] = bk[48];
#pragma unroll
        for (int i = 0; i < 4; ++i)
#pragma unroll
            for (int j = 0; j < 4; ++j) acc[i][j] = __builtin_amdgcn_mfma_f32_16x16x4f32(a[i], b[j], acc[i][j], 0, 0, 0);
    }
#pragma unroll
    for (int i = 0; i < 4; ++i)
#pragma unroll
        for (int j = 0; j < 4; ++j)
#pragma unroll
            for (int r = 0; r < 4; ++r) {
                TC* cp = C + (long)(m0 + 16 * i + 4 * lk + r) * g.ldc + n0 + 16 * j + lr;
                const float v = acc[i][j][r];
                stf(cp, g.mode == 1 ? silu_f(ldf(cp)) * v : v);
            }
}
__global__ __launch_bounds__(256) void k_rope(float* P) {
    const long idx = (long)blockIdx.x * 256 + threadIdx.x;
    if (idx >= (long)ML * 10 * 64) return;
    const int pi = (int)(idx & 63), slot = (int)((idx >> 6) % 10), m = (int)(idx / 640);
    const int t = m % SEQ, half = pi >> 5, i = pi & 31;
    const int base = (slot < 8 ? OFF_Q + slot * HD : OFF_K + (slot - 8) * HD) + half * 64;
    const float pos = half == 0 ? (float)(t / GRIDW) : (float)(t % GRIDW);
    const float inv = powf(10000.f, -(float)i / 32.f);
    const float ang = pos * inv, cs = cosf(ang), sn = sinf(ang);
    float* p = P + (size_t)m * INC + base;
    const float x1 = p[i], x2 = p[32 + i];
    p[i] = x1 * cs - x2 * sn; p[32 + i] = x2 * cs + x1 * sn;
}
__global__ __launch_bounds__(256) void k_pfmt(const float* Pf, bf16* P) {
    const long idx = (long)blockIdx.x * 256 + threadIdx.x; if (idx >= (long)MT * INC) return;
    const int n = (int)(idx % INC); const long m = idx / INC;
    float v;
    if (n < OFF_V) { const int hb = n & ~127; v = Pf[m * INC + hb + qk_orig(n & 127)]; }
    else { v = Pf[idx]; if (n >= OFF_Y && n < OFF_GA) v = gelu_tanh(v); else if (n >= OFF_GA) v = sigm(v); }
    P[idx] = f2bf(v);
}
__global__ __launch_bounds__(256) void k_attn(const bf16* P, const float* sink, bf16* O) {
    __shared__ float ps[4][576];
    __shared__ int prow[4][576];
    const int w = threadIdx.x >> 6, lane = threadIdx.x & 63;
    const int gw = blockIdx.x * 4 + w;
    const int m = gw >> 3, h = gw & 7, kvh = h >> 2;
    const bool lat = m < ML;
    const int b = lat ? m / SEQ : (m - ML) / CTX, t = lat ? m % SEQ : 0;
    const int lo = lat ? (t - WIN < 0 ? 0 : t - WIN) : 0, hi = lat ? (t + WIN > SEQ - 1 ? SEQ - 1 : t + WIN) : -1;
    const int nlat = lat ? hi - lo + 1 : 0, nk = nlat + CTX;
    const bf16* q = P + (size_t)m * INC + OFF_Q + h * HD;
    const float scale = 0.08838834764831845f;
    const float sk = sink[h];
    float sc[9]; float mx = sk;
#pragma unroll
    for (int i = 0; i < 9; ++i) {
        const int j = lane + 64 * i; float s = -INFINITY;
        if (j < nk) {
            const int row = j < nlat ? b * SEQ + lo + j : ML + b * CTX + (j - nlat);
            const bf16* kp = P + (size_t)row * INC + OFF_K + kvh * HD;
            float d = 0.f;
            for (int e = 0; e < 128; ++e) d += bf2f(q[e]) * bf2f(kp[e]);
            s = d * scale; prow[w][j] = row;
        }
        sc[i] = s; mx = fmaxf(mx, s);
    }
    mx = wave_max(mx);
    float sum = 0.f;
#pragma unroll
    for (int i = 0; i < 9; ++i) { const int j = lane + 64 * i; if (j < nk) { const float p = expf(sc[i] - mx); ps[w][j] = p; sum += p; } }
    sum = wave_sum(sum) + expf(sk - mx);
    const float rs = 1.f / sum;
    __syncthreads();
    float o0 = 0.f, o1 = 0.f;
    for (int j = 0; j < nk; ++j) { const float p = ps[w][j]; const bf16* vp = P + (size_t)prow[w][j] * INC + OFF_V + kvh * HD; o0 += p * bf2f(vp[lane]); o1 += p * bf2f(vp[lane + 64]); }
    bf16* op = O + (size_t)m * D + h * HD;
    op[lane] = f2bf(o0 * rs); op[lane + 64] = f2bf(o1 * rs);
}
__global__ __launch_bounds__(256) void k_conv(const bf16* P, const float* cw, const float* cb, float* XC) {
    const long idx = (long)blockIdx.x * 256 + threadIdx.x;
    if (idx >= (long)MT * D) return;
    const int ch = (int)(idx & (D - 1)), m = (int)(idx >> 10);
    const bool lat = m < ML; const int L = lat ? SEQ : CTX, t = lat ? m % SEQ : (m - ML) % CTX;
    float y = 0.f;
#pragma unroll
    for (int j = 0; j < 4; ++j) { const int tt = t + j - 2; if (tt >= 0 && tt < L) y += bf2f(P[(size_t)(m + j - 2) * INC + OFF_X + ch]) * cw[j * D + ch]; }
    XC[idx] = y + cb[ch];
}
__device__ __forceinline__ void scan_seq(const float* XC, const float* RG, const float* IG, float* REC, int mbase, int L, int dir, int ch, float sp, float bav, float bxv, float& h) {
    for (int s0 = 0; s0 < L; s0 += 8) {
        float x[8], r[8], g[8], pr[8];
#pragma unroll
        for (int u = 0; u < 8; ++u) { const int t = dir == 0 ? s0 + u : L - 1 - (s0 + u); const size_t o = (size_t)(mbase + t) * D + ch; x[u] = XC[o]; r[u] = RG[o]; g[u] = IG[o]; pr[u] = dir == 0 ? 0.f : REC[o]; }
#pragma unroll
        for (int u = 0; u < 8; ++u) { const int t = dir == 0 ? s0 + u : L - 1 - (s0 + u); const size_t o = (size_t)(mbase + t) * D + ch;
            const float rr = sigm(r[u] + bav), ig = sigm(g[u] + bxv);
            const float la = -8.f * rr * sp, a = expf(la), bc = sqrtf(-expm1f(2.f * la)) * (ig * x[u]);
            h = a * h + bc; REC[o] = pr[u] + h; }
    }
}
__global__ __launch_bounds__(64) void k_scan(const float* XC, const float* RG, const float* IG, const float* ba, const float* bx, const float* lam, int dir, float* REC) {
    const int idx = blockIdx.x * 64 + threadIdx.x;
    const int b = idx >> 10, ch = idx & (D - 1);
    const float sp = log1pf(expf(-lam[ch])), bav = ba[ch], bxv = bx[ch];
    float h = 0.f;
    scan_seq(XC, RG, IG, REC, ML + b * CTX, CTX, dir, ch, sp, bav, bxv, h);
    scan_seq(XC, RG, IG, REC, b * SEQ, SEQ, dir, ch, sp, bav, bxv, h);
}
__global__ __launch_bounds__(256) void k_recgate(const float* REC, const bf16* P, bf16* RECG) {
    const long idx = (long)blockIdx.x * 256 + threadIdx.x; if (idx >= (long)MT * D) return;
    const int ch = (int)(idx & (D - 1)), m = (int)(idx >> 10);
    RECG[idx] = f2bf(REC[idx] * bf2f(P[(size_t)m * INC + OFF_Y + ch]));
}
__global__ __launch_bounds__(256) void k_merge(const float* T1, const float* T2, const bf16* P, bf16* MM) {
    const long idx = (long)blockIdx.x * 256 + threadIdx.x; if (idx >= (long)MT * D) return;
    const int ch = (int)(idx & (D - 1)), m = (int)(idx >> 10);
    const bf16* p = P + (size_t)m * INC;
    MM[idx] = f2bf(bf2f(p[OFF_GA + ch]) * T1[idx] + bf2f(p[OFF_GR + ch]) * T2[idx]);
}
__global__ __launch_bounds__(256) void k_resid(float* H, const float* Y, const float* MODl, int g_off) {
    const long idx = (long)blockIdx.x * 256 + threadIdx.x; if (idx >= (long)MT * D) return;
    const int n = (int)(idx & (D - 1)), m = (int)(idx >> 10);
    H[idx] += MODl[(size_t)row_vec(m) * 6 * D + g_off + n] * Y[idx];
}
__global__ __launch_bounds__(256) void k_route(const bf16* XN, const float* wr, int* te, float* tw) {
    const int m = (blockIdx.x * 256 + threadIdx.x) >> 6, lane = threadIdx.x & 63;
    if (m >= MT) return;
    float lg[NE];
#pragma unroll
    for (int e = 0; e < NE; ++e) lg[e] = 0.f;
    for (int j = 0; j < 16; ++j) { const int k = lane + 64 * j; const float x = bf2f(XN[(size_t)m * D + k]); const float* w = wr + (size_t)k * NE;
#pragma unroll
        for (int e = 0; e < NE; ++e) lg[e] += x * w[e]; }
#pragma unroll
    for (int e = 0; e < NE; ++e) lg[e] = wave_sum(lg[e]);
    if (lane == 0) {
        int i0 = 0; float v0 = lg[0];
#pragma unroll
        for (int e = 1; e < NE; ++e) if (lg[e] > v0) { v0 = lg[e]; i0 = e; }
        int i1 = -1; float v1 = -INFINITY;
#pragma unroll
        for (int e = 0; e < NE; ++e) if (e != i0 && lg[e] > v1) { v1 = lg[e]; i1 = e; }
        const float e1 = expf(v1 - v0), w0 = 1.f / (1.f + e1), w1 = e1 / (1.f + e1);
        te[2 * m] = i0; te[2 * m + 1] = i1; tw[2 * m] = w0; tw[2 * m + 1] = w1;
    }
}
__global__ __launch_bounds__(1024) void k_moe_lists(const int* te, int* slot_tok, int* tok_slot, int* tile_e) {
    __shared__ int cnt[NE], off[NE + 1], cur[NE];
    const int tid = threadIdx.x;
    if (tid < NE) { cnt[tid] = 0; cur[tid] = 0; }
    for (int i = tid; i < NSLOT; i += 1024) slot_tok[i] = -1;
    __syncthreads();
    for (int i = tid; i < 2 * MT; i += 1024) atomicAdd(&cnt[te[i]], 1);
    __syncthreads();
    if (tid == 0) { int o = 0; for (int e = 0; e < NE; ++e) { off[e] = o; o += (cnt[e] + 255) / 256 * 256; } off[NE] = o; }
    __syncthreads();
    for (int i = tid; i < NSLOT / 128; i += 1024) { int e = -1; for (int x = 0; x < NE; ++x) if (i * 128 >= off[x] && i * 128 < off[x + 1]) e = x; tile_e[i] = e; }
    for (int i = tid; i < 2 * MT; i += 1024) { const int e = te[i]; const int pos = atomicAdd(&cur[e], 1); const int s = off[e] + pos; slot_tok[s] = i >> 1; tok_slot[i] = s; }
}
__global__ __launch_bounds__(256) void k_moe_combine(float* H, const bf16* FS, const int* tok_slot, const float* tw, const float* MODl, int g_off) {
    const long idx = (long)blockIdx.x * 256 + threadIdx.x; if (idx >= (long)MT * D) return;
    const int n = (int)(idx & (D - 1)), m = (int)(idx >> 10);
    const float f = tw[2 * m] * bf2f(FS[(size_t)tok_slot[2 * m] * D + n]) + tw[2 * m + 1] * bf2f(FS[(size_t)tok_slot[2 * m + 1] * D + n]);
    H[idx] += MODl[(size_t)row_vec(m) * 6 * D + g_off + n] * f;
}
__global__ __launch_bounds__(256) void k_final(const float* H, const float* g, float* out) {
    const int m = (blockIdx.x * 256 + threadIdx.x) >> 6, lane = threadIdx.x & 63;
    if (m >= ML) return;
    const float* h = H + (size_t)m * D;
    float v[16]; float ss = 0.f;
#pragma unroll
    for (int j = 0; j < 16; ++j) { v[j] = h[lane + 64 * j]; ss += v[j] * v[j]; }
    ss = wave_sum(ss);
    const float r = rsqrtf(ss * (1.f / D) + EPS);
#pragma unroll
    for (int j = 0; j < 16; ++j) { const int n = lane + 64 * j; out[(size_t)m * D + n] = v[j] * r * g[n]; }
}
}

template <class TA, class TC>
static void ngemm(hipStream_t st, const TA* A, int lda, const int* arow, const float* B, int ldb, TC* C, int ldc, int M, int N, int K,
                  int nz = 1, long sA = 0, long sB = 0, long sC = 0, const int* tile_e = nullptr, long sBe = 0, int mode = 0) {
    nv::NGemm<TA, TC> g{}; g.A = A; g.lda = lda; g.arow = arow; g.B = B; g.ldb = ldb; g.C = C; g.ldc = ldc; g.K = K; g.sA = sA; g.sB = sB; g.sC = sC; g.tile_e = tile_e; g.sBe = sBe; g.mode = mode;
    hipLaunchKernelGGL((nv::k_gemm<TA, TC>), dim3(N / 128, M / 128, nz), dim3(256), 0, st, g);
}

namespace pg8 {
#define PG8_LAS __attribute__((address_space(3)))
typedef unsigned short bf16_t;
typedef short bf16x8 __attribute__((ext_vector_type(8)));
typedef float f32x4 __attribute__((ext_vector_type(4)));
typedef unsigned u32x4 __attribute__((ext_vector_type(4)));
constexpr int BM = 256, BK = 64, HALF = 128, HTB = HALF * BK * 2  , STAGE_BYTES = 8 * HTB, NXCD = 8, WGM = 8;

__host__ __device__ __forceinline__ int lds_byte(int r, int c) { const int st = (r >> 4) * 2 + (c >> 5), rr = r & 15, cc = c & 31, ob = rr * 64 + cc * 2; return st * 1024 + (ob ^ (((ob >> 9) & 1) << 5)); }
__host__ __device__ __forceinline__ void stage_rc(int b, int& R, int& C) { const int st = b / 1024, sb = b % 1024, swz = sb ^ (((sb >> 9) & 1) << 5); R = (st >> 1) * 16 + swz / 64; C = (st & 1) * 32 + (swz % 64) / 2; }
__host__ __device__ __forceinline__ int perm32(int rho) { const int n = rho >> 4, i = rho & 15; return 8 * (i >> 2) + 4 * n + (i & 3); }

struct Unit { int pm, pn; };
struct Gemm { const bf16_t* A; const bf16_t* Bt; int M, N, K; };

struct StaticOrder {
    int nM, nN, nwg, G, c;
    __host__ __device__ void init(int M, int N, int G_, int c_) { nM = M / BM; nN = N / BM; nwg = nM * nN; G = G_; c = c_; }
    __host__ __device__ bool next(int i, Unit& u) const {
        const long L = (long)i * G + c; if (L >= nwg) return false;
        int wgid = (int)L; { const int q = nwg / NXCD, r = nwg % NXCD, xcd = wgid % NXCD, off = wgid / NXCD; wgid = (xcd < r ? xcd * (q + 1) : r * (q + 1) + (xcd - r) * q) + off; }
        const int nig = WGM * nN, gid = wgid / nig, fm = gid * WGM, gsz = (nM - fm) < WGM ? (nM - fm) : WGM;
        u.pm = fm + ((wgid % nig) % gsz); u.pn = (wgid % nig) / gsz; return true;
    }
    __device__ __forceinline__ void a_ready(const Unit&) const {}
    __device__ __forceinline__ size_t boff(const Unit&) const { return 0; }
    __device__ __forceinline__ void done(const Unit&) const {}
};


struct ExpertOrder : StaticOrder {
    const int* panel_e; size_t estride;
    __device__ __forceinline__ size_t boff(const Unit& u) const { return (size_t)__builtin_amdgcn_readfirstlane(panel_e[u.pm]) * estride; }
};
struct EpiInProj {
    static constexpr bool PERM = true, AFTER_DRAIN = false;
    bf16* P; const f32x4* rope;
    __device__ __forceinline__ void operator()(const f32x4 (&acc)[2][2][4][2], const Unit& u, int wr, int wc, int fr, int fq) const {
        const int pn = u.pn;
        const int kind = pn < 5 ? 0 : (pn < 10 ? 1 : (pn < 14 ? 2 : 3));
        const bool rope_on = kind == 0 && u.pm < 64;
        const int row0 = u.pm * BM + wr * 64 + fr, col0 = pn * BM + wc * 32 + 8 * fq;
#pragma unroll
        for (int ai = 0; ai < 2; ++ai)
#pragma unroll
            for (int m = 0; m < 4; ++m) {
                const int row = row0 + ai * HALF + m * 16;
                bf16* rowp = P + (size_t)row * INC + col0;
                f32x4 cs0 = {1.f, 0.f, 1.f, 0.f}, cs1 = {1.f, 0.f, 1.f, 0.f};
                if (rope_on) { const int t = row & (SEQ - 1); const int pos = (wc >> 1) ? (t & 63) : (t >> 6); const f32x4* rp = rope + pos * 16 + 8 * (wc & 1) + 2 * fq; cs0 = rp[0]; cs1 = rp[1]; }
#pragma unroll
                for (int bj = 0; bj < 2; ++bj) {
                    f32x4 v0 = acc[ai][bj][m][0], v1 = acc[ai][bj][m][1];
                    if (kind == 0) {
                        const f32x4 a = v0, b = v1;
                        v0[0] = a[0] * cs0[0] - a[1] * cs0[1]; v0[1] = a[1] * cs0[0] + a[0] * cs0[1];
                        v0[2] = a[2] * cs0[2] - a[3] * cs0[3]; v0[3] = a[3] * cs0[2] + a[2] * cs0[3];
                        v1[0] = b[0] * cs1[0] - b[1] * cs1[1]; v1[1] = b[1] * cs1[0] + b[0] * cs1[1];
                        v1[2] = b[2] * cs1[2] - b[3] * cs1[3]; v1[3] = b[3] * cs1[2] + b[2] * cs1[3];
                    } else if (kind == 2) {
#pragma unroll
                        for (int j = 0; j < 4; ++j) { v0[j] = fgelu(v0[j]); v1[j] = fgelu(v1[j]); }
                    } else if (kind == 3) {
#pragma unroll
                        for (int j = 0; j < 4; ++j) { v0[j] = fsigm(v0[j]); v1[j] = fsigm(v1[j]); }
                    }
                    u32x4 w; w.x = pk2(v0[0], v0[1]); w.y = pk2(v0[2], v0[3]); w.z = pk2(v1[0], v1[1]); w.w = pk2(v1[2], v1[3]);
                    *(u32x4*)(rowp + bj * HALF) = w;
                }
            }
    }
};
struct EpiMerge {
    static constexpr bool PERM = true, AFTER_DRAIN = false;
    const bf16* P; bf16* T1; bf16* MM; int mode;
    __device__ __forceinline__ void operator()(const f32x4 (&acc)[2][2][4][2], const Unit& u, int wr, int wc, int fr, int fq) const {
        const int row0 = u.pm * BM + wr * 64 + fr, col0 = u.pn * BM + wc * 32 + 8 * fq;
#pragma unroll
        for (int ai = 0; ai < 2; ++ai)
#pragma unroll
            for (int m = 0; m < 4; ++m) {
                const size_t row = (size_t)(row0 + ai * HALF + m * 16);
#pragma unroll
                for (int bj = 0; bj < 2; ++bj) {
                    const int col = col0 + bj * HALF;
                    const u32x4 g = *(const u32x4*)(P + row * INC + (mode ? OFF_GR : OFF_GA) + col);
                    const f32x4 a0 = acc[ai][bj][m][0], a1 = acc[ai][bj][m][1];
                    float o[8] = {bflo(g.x) * a0[0], bfhi(g.x) * a0[1], bflo(g.y) * a0[2], bfhi(g.y) * a0[3], bflo(g.z) * a1[0], bfhi(g.z) * a1[1], bflo(g.w) * a1[2], bfhi(g.w) * a1[3]};
                    if (mode) { const u32x4 t = *(const u32x4*)(T1 + row * D + col);
                        o[0] += bflo(t.x); o[1] += bfhi(t.x); o[2] += bflo(t.y); o[3] += bfhi(t.y); o[4] += bflo(t.z); o[5] += bfhi(t.z); o[6] += bflo(t.w); o[7] += bfhi(t.w); }
                    u32x4 w; w.x = pk2(o[0], o[1]); w.y = pk2(o[2], o[3]); w.z = pk2(o[4], o[5]); w.w = pk2(o[6], o[7]);
                    *(u32x4*)((mode ? MM : T1) + row * D + col) = w;
                }
            }
    }
};
struct EpiResid {
    static constexpr bool PERM = false, AFTER_DRAIN = false;
    float* H; const float* gate;
    __device__ __forceinline__ void operator()(const f32x4 (&acc)[2][2][4][2], const Unit& u, int wr, int wc, int fr, int fq) const {
        const int row0 = u.pm * BM + wr * 64 + fr, col0 = u.pn * BM + wc * 32 + 4 * fq;
        const float* gv = gate + (size_t)(u.pm < 32 ? 0 : (u.pm < 64 ? 1 : 2)) * 6 * D;
        f32x4 g4[2][2];
#pragma unroll
        for (int bj = 0; bj < 2; ++bj)
#pragma unroll
            for (int n = 0; n < 2; ++n) g4[bj][n] = *(const f32x4*)(gv + col0 + bj * HALF + n * 16);
#pragma unroll
        for (int ai = 0; ai < 2; ++ai)
#pragma unroll
            for (int m = 0; m < 4; ++m) { float* rowp = H + (size_t)(row0 + ai * HALF + m * 16) * D + col0;
#pragma unroll
                for (int bj = 0; bj < 2; ++bj)
#pragma unroll
                    for (int n = 0; n < 2; ++n) { f32x4* p = (f32x4*)(rowp + bj * HALF + n * 16); *p = *p + g4[bj][n] * acc[ai][bj][m][n]; } }
    }
};
struct EpiSwiGLU {
    static constexpr bool PERM = true, AFTER_DRAIN = false;
    bf16* HID; int ldh;
    __device__ __forceinline__ void operator()(const f32x4 (&acc)[2][2][4][2], const Unit& u, int wr, int wc, int fr, int fq) const {
        const int row0 = u.pm * BM + wr * 64 + fr, col0 = u.pn * HALF + wc * 32 + 8 * fq;
#pragma unroll
        for (int ai = 0; ai < 2; ++ai)
#pragma unroll
            for (int m = 0; m < 4; ++m) {
                const f32x4 g0 = acc[ai][0][m][0], g1 = acc[ai][0][m][1], u0 = acc[ai][1][m][0], u1 = acc[ai][1][m][1];
                u32x4 w; w.x = pk2(fsilu(g0[0]) * u0[0], fsilu(g0[1]) * u0[1]); w.y = pk2(fsilu(g0[2]) * u0[2], fsilu(g0[3]) * u0[3]);
                w.z = pk2(fsilu(g1[0]) * u1[0], fsilu(g1[1]) * u1[1]); w.w = pk2(fsilu(g1[2]) * u1[2], fsilu(g1[3]) * u1[3]);
                *(u32x4*)(HID + (size_t)(row0 + ai * HALF + m * 16) * ldh + col0) = w;
            }
    }
};
struct EpiPlain {
    static constexpr bool PERM = true, AFTER_DRAIN = false;
    bf16* O; int ldc;
    __device__ __forceinline__ void operator()(const f32x4 (&acc)[2][2][4][2], const Unit& u, int wr, int wc, int fr, int fq) const {
        const int row0 = u.pm * BM + wr * 64 + fr, col0 = u.pn * BM + wc * 32 + 8 * fq;
#pragma unroll
        for (int ai = 0; ai < 2; ++ai)
#pragma unroll
            for (int m = 0; m < 4; ++m) { bf16* rowp = O + (size_t)(row0 + ai * HALF + m * 16) * ldc + col0;
#pragma unroll
                for (int bj = 0; bj < 2; ++bj) { const f32x4 v0 = acc[ai][bj][m][0], v1 = acc[ai][bj][m][1];
                    u32x4 w; w.x = pk2(v0[0], v0[1]); w.y = pk2(v0[2], v0[3]); w.z = pk2(v1[0], v1[1]); w.w = pk2(v1[2], v1[3]);
                    *(u32x4*)(rowp + bj * HALF) = w; } }
    }
};
template <class Epi, class Sched, bool ALIGN_EPI = false, bool SP2 = false>
__device__ __forceinline__ void gemm_phase(PG8_LAS unsigned char* lds, const Gemm g, const Sched& S, const Epi& E) {
    int tid_ = threadIdx.x; asm volatile("" : "+v"(tid_));
    const int tid = tid_, wid = __builtin_amdgcn_readfirstlane(tid >> 6), lane = tid & 63, wr = wid >> 2, wc = wid & 3, fr = lane & 15, fq = lane >> 4;
    const int K = g.K, nt = K / BK;
    unsigned voffA[2], voffB[2];
#pragma unroll
    for (int i = 0; i < 2; ++i) { int R, C; stage_rc(tid * 16 + i * 8192, R, C); const int Rb = Epi::PERM ? ((R & ~31) + perm32(R & 31)) : R;
        voffA[i] = (unsigned)(R * K + C) * 2u; voffB[i] = (unsigned)(Rb * K + C) * 2u; }
    const size_t kstep = (size_t)(BK * 2);
    const size_t hstep = (size_t)HALF * K * 2;
    const size_t tstep = 2 * hstep;
    const unsigned ldsw = (unsigned)wid * 1024u;
    const int aoff = lds_byte(wr * 64 + fr, fq * 8), boff = lds_byte(wc * 32 + fr, fq * 8);
#define PG8_SA(b, h) (((b) * 2 + (h)) * HTB)
#define PG8_SB(b, h) ((4 + (b) * 2 + (h)) * HTB)
#define PG8_STAGE(bufoff, gbase, voff) do { _Pragma("unroll") for (int _i = 0; _i < 2; ++_i) \
        __builtin_amdgcn_global_load_lds((const unsigned*)((const char*)(gbase) + (voff)[_i]), (PG8_LAS unsigned*)(lds + (bufoff) + ldsw + _i * 8192), 16, 0, 0); } while (0)
#define PG8_LDA(dst, b, h) do { _Pragma("unroll") for (int m = 0; m < 4; ++m) _Pragma("unroll") for (int k = 0; k < 2; ++k) dst[m][k] = *(const PG8_LAS bf16x8*)(lds + PG8_SA(b, h) + aoff + m * 2048 + k * 1024); } while (0)
#define PG8_LDB(dst, b, h) do { _Pragma("unroll") for (int n = 0; n < 2; ++n) _Pragma("unroll") for (int k = 0; k < 2; ++k) dst[n][k] = *(const PG8_LAS bf16x8*)(lds + PG8_SB(b, h) + boff + n * 2048 + k * 1024); } while (0)
#define PG8_MMA(ai, bj, At, Bt) do { __builtin_amdgcn_s_setprio(1); _Pragma("unroll") for (int m = 0; m < 4; ++m) _Pragma("unroll") for (int n = 0; n < 2; ++n) _Pragma("unroll") for (int k = 0; k < 2; ++k) \
        acc[ai][bj][m][n] = __builtin_amdgcn_mfma_f32_16x16x32_bf16(Bt[n][k], At[m][k], acc[ai][bj][m][n], 0, 0, 0); __builtin_amdgcn_s_setprio(0); } while (0)
#define PG8_WAIT_V(n) asm volatile("s_waitcnt vmcnt(" #n ")" ::: "memory")
#define PG8_WAIT_L(n) asm volatile("s_waitcnt lgkmcnt(" #n ")" ::: "memory")
#define PG8_BAR __builtin_amdgcn_s_barrier()
#define PG8_SCHED __builtin_amdgcn_sched_barrier(0)
    Unit cur, nxt; int ui = 0;
    if (!S.next(0, cur)) return;
    f32x4 acc[2][2][4][2];
#pragma unroll
    for (int a = 0; a < 2; ++a)
#pragma unroll
        for (int b = 0; b < 2; ++b)
#pragma unroll
            for (int m = 0; m < 4; ++m)
#pragma unroll
                for (int n = 0; n < 2; ++n) acc[a][b][m][n] = (f32x4){0.f, 0.f, 0.f, 0.f};
    bf16x8 At[4][2], B0[2][2], B1[2][2];
    const char* cA = (const char*)g.A + (size_t)cur.pm * tstep; const char* cB = (const char*)g.Bt + S.boff(cur) + (size_t)cur.pn * tstep;
    S.a_ready(cur);
    if constexpr (SP2) {
        PG8_STAGE(PG8_SB(0, 0), cB, voffB); PG8_STAGE(PG8_SB(0, 1), cB + hstep, voffB); PG8_STAGE(PG8_SA(0, 0), cA, voffA); PG8_STAGE(PG8_SA(0, 1), cA + hstep, voffA);
        if (wr == 1) PG8_BAR;
        PG8_WAIT_V(2); PG8_BAR;
        PG8_STAGE(PG8_SB(1, 0), cB + kstep, voffB); PG8_STAGE(PG8_SA(1, 0), cA + kstep, voffA); PG8_STAGE(PG8_SB(1, 1), cB + hstep + kstep, voffB);
        PG8_WAIT_V(6); PG8_BAR;
    } else {
        PG8_STAGE(PG8_SB(0, 0), cB, voffB); PG8_STAGE(PG8_SA(0, 0), cA, voffA); PG8_STAGE(PG8_SB(0, 1), cB + hstep, voffB); PG8_STAGE(PG8_SA(0, 1), cA + hstep, voffA);
        if (wr == 1) PG8_BAR;
        PG8_WAIT_V(4); PG8_BAR;
        PG8_STAGE(PG8_SB(1, 0), cB + kstep, voffB); PG8_STAGE(PG8_SA(1, 0), cA + kstep, voffA); PG8_STAGE(PG8_SB(1, 1), cB + hstep + kstep, voffB);
        PG8_WAIT_V(6); PG8_BAR;
    }
    for (;;) {
        const bool has_next = S.next(ui + 1, nxt);
        const char* nA = has_next ? (const char*)g.A + (size_t)nxt.pm * tstep : cA; const char* nB = has_next ? (const char*)g.Bt + S.boff(nxt) + (size_t)nxt.pn * tstep : cB;
        for (int t = 0; t < nt; t += 2) {
            const bool last = (t == nt - 2);
            const char* a1 = cA + (size_t)(t + 1) * kstep;
            const char* a2 = last ? nA : cA + (size_t)(t + 2) * kstep; const char* b2 = last ? nB : cB + (size_t)(t + 2) * kstep;
            const char* a3 = a2 + kstep; const char* b3 = b2 + kstep;
            if (last && has_next) S.a_ready(nxt);
            if constexpr (SP2) {
            PG8_LDB(B0, 0, 0); PG8_LDB(B1, 0, 1); PG8_SCHED; PG8_LDA(At, 0, 0); PG8_STAGE(PG8_SA(1, 1), a1 + hstep, voffA);
            PG8_WAIT_V(8); PG8_WAIT_L(0); PG8_BAR; PG8_MMA(0, 0, At, B0); PG8_MMA(0, 1, At, B1); PG8_BAR; PG8_SCHED;
            PG8_LDA(At, 0, 1); PG8_STAGE(PG8_SB(0, 0), b2, voffB); PG8_STAGE(PG8_SB(0, 1), b2 + hstep, voffB); PG8_STAGE(PG8_SA(0, 0), a2, voffA);
            PG8_WAIT_V(8); PG8_WAIT_L(0); PG8_BAR; PG8_MMA(1, 0, At, B0); PG8_MMA(1, 1, At, B1); PG8_BAR; PG8_SCHED;
            PG8_LDB(B0, 1, 0); PG8_LDB(B1, 1, 1); PG8_SCHED; PG8_LDA(At, 1, 0); PG8_STAGE(PG8_SA(0, 1), a2 + hstep, voffA);
            PG8_WAIT_V(8); PG8_WAIT_L(0); PG8_BAR; PG8_MMA(0, 0, At, B0); PG8_MMA(0, 1, At, B1); PG8_BAR; PG8_SCHED;
            PG8_LDA(At, 1, 1); PG8_STAGE(PG8_SB(1, 0), b3, voffB); PG8_STAGE(PG8_SB(1, 1), b3 + hstep, voffB); PG8_STAGE(PG8_SA(1, 0), a3, voffA);
            PG8_WAIT_V(8); PG8_WAIT_L(0); PG8_BAR; PG8_MMA(1, 0, At, B0); PG8_MMA(1, 1, At, B1); PG8_BAR; PG8_SCHED;
            } else {
            PG8_LDB(B0, 0, 0); PG8_SCHED; PG8_LDA(At, 0, 0); PG8_STAGE(PG8_SA(1, 1), a1 + hstep, voffA);
            PG8_WAIT_L(8); PG8_BAR; PG8_WAIT_L(0); PG8_MMA(0, 0, At, B0); PG8_BAR; PG8_SCHED;
            PG8_LDB(B1, 0, 1); PG8_STAGE(PG8_SB(0, 0), b2, voffB);
            PG8_BAR; PG8_WAIT_L(0); PG8_MMA(0, 1, At, B1); PG8_BAR;
            PG8_LDA(At, 0, 1); PG8_STAGE(PG8_SA(0, 0), a2, voffA);
            PG8_BAR; PG8_WAIT_L(0); PG8_MMA(1, 0, At, B0); PG8_BAR; PG8_SCHED;
            PG8_STAGE(PG8_SB(0, 1), b2 + hstep, voffB);
            PG8_WAIT_V(6); PG8_BAR; PG8_MMA(1, 1, At, B1); PG8_BAR;
            PG8_LDB(B0, 1, 0); PG8_SCHED; PG8_LDA(At, 1, 0); PG8_STAGE(PG8_SA(0, 1), a2 + hstep, voffA);
            PG8_WAIT_L(8); PG8_BAR; PG8_WAIT_L(0); PG8_MMA(0, 0, At, B0); PG8_BAR; PG8_SCHED;
            PG8_LDB(B1, 1, 1); PG8_STAGE(PG8_SB(1, 0), b3, voffB);
            PG8_BAR; PG8_WAIT_L(0); PG8_MMA(0, 1, At, B1); PG8_BAR;
            PG8_LDA(At, 1, 1); PG8_STAGE(PG8_SA(1, 0), a3, voffA);
            PG8_BAR; PG8_WAIT_L(0); PG8_MMA(1, 0, At, B0); PG8_BAR; PG8_SCHED;
            PG8_STAGE(PG8_SB(1, 1), b3 + hstep, voffB);
            PG8_WAIT_V(6); PG8_BAR; PG8_MMA(1, 1, At, B1); PG8_BAR;
            }
        }
        if constexpr (ALIGN_EPI) { if (wr == 0) PG8_BAR; }
        if constexpr (!Epi::AFTER_DRAIN) { E(acc, cur, wr, wc, fr, fq); S.done(cur); }
        if (!has_next) break;
#pragma unroll
        for (int a = 0; a < 2; ++a)
#pragma unroll
            for (int b = 0; b < 2; ++b)
#pragma unroll
                for (int m = 0; m < 4; ++m)
#pragma unroll
                    for (int n = 0; n < 2; ++n) acc[a][b][m][n] = (f32x4){0.f, 0.f, 0.f, 0.f};
        cur = nxt; cA = nA; cB = nB; ++ui;
        if constexpr (ALIGN_EPI) { if (wr == 1) PG8_BAR; }
    }
    PG8_WAIT_V(0);
    if constexpr (!ALIGN_EPI) { if (wr == 0) PG8_BAR; }
    PG8_BAR;
    if constexpr (Epi::AFTER_DRAIN) { E.fused(acc, cur, wr, wc, fr, fq, lds, wid, lane); S.done(cur); }
#undef PG8_SA
#undef PG8_SB
#undef PG8_STAGE
#undef PG8_LDA
#undef PG8_LDB
#undef PG8_MMA
#undef PG8_WAIT_V
#undef PG8_WAIT_L
#undef PG8_BAR
#undef PG8_SCHED
}

}

constexpr int NWAVES = 8;
constexpr int RING_OFF = 0;
constexpr int TR_WAVE_BYTES = 64 * 65 * 4;
constexpr int SVEC_OFF = NWAVES * TR_WAVE_BYTES;
constexpr int LDSCTL_OFF = 147456 - 512, LDS_BYTES = 147456;
static_assert(SVEC_OFF + 3 * D * 4 <= LDSCTL_OFF, "LDS map");

#define RLX_AGENT __ATOMIC_RELAXED, __HIP_MEMORY_SCOPE_AGENT
#define XB_TMO      128
#define XB_XCNT(j)  (256  + 64 * (j))
#define XB_XSUB(j)  (1280 + 64 * (j))
#define XB_XGEN(j)  (2304 + 64 * (j))
#define XB_TOP      3328
#define XB_TOPGEN   3392
#define XCD_BAR_WORDS 3456
#define XB_SPIN_CAP (1u << 18)

__device__ __forceinline__ unsigned xb_ld(unsigned* p)              { return __hip_atomic_load(p, __ATOMIC_RELAXED, __HIP_MEMORY_SCOPE_AGENT); }
__device__ __forceinline__ unsigned xb_add(unsigned* p, unsigned v) { return __hip_atomic_fetch_add(p, v, __ATOMIC_RELAXED, __HIP_MEMORY_SCOPE_AGENT); }
__device__ __forceinline__ unsigned xb_xcc_id() { return (unsigned)__builtin_amdgcn_s_getreg((3 << 11) | 20) & 0xFu; }
#define XB_SPIN(cond, bar) do { unsigned _sp = 0; while (cond) { __builtin_amdgcn_s_sleep(1); \
    if ((++_sp & 255u) == 0u) { if (xb_ld(&(bar)[XB_TMO])) break; if (_sp > XB_SPIN_CAP) { atomicAdd(&(bar)[XB_TMO], 1u); break; } } } } while (0)

struct XcdBarrier {
    unsigned* bar; unsigned x;
    volatile LAS unsigned* st;
};

__device__ __forceinline__ XcdBarrier xcd_barrier_post(unsigned* bar, volatile LAS unsigned* st) {
    XcdBarrier b; b.bar = bar; b.x = xb_xcc_id(); b.st = st;
    if (threadIdx.x == 0) (void)xb_add(&bar[XB_XCNT(b.x)], 1u);
    return b;
}
__device__ __forceinline__ void xcd_barrier_complete(unsigned* bar, unsigned x, unsigned& nloc, unsigned& nx) {
    const unsigned G = gridDim.x * gridDim.y * gridDim.z;
    unsigned sum, cnt, mine, sp = 0u;
    for (;;) {
        sum = 0u; cnt = 0u; mine = 0u;
#pragma unroll
        for (unsigned j = 0; j < 16; ++j) { const unsigned c = xb_ld(&bar[XB_XCNT(j)]); sum += c; cnt += (c > 0u) ? 1u : 0u; mine = (j == x) ? c : mine; }
        if (sum == G) break;
        __builtin_amdgcn_s_sleep(1);
        if ((++sp & 255u) == 0u) { if (xb_ld(&bar[XB_TMO])) break; if (sp > XB_SPIN_CAP) { atomicAdd(&bar[XB_TMO], 1u); break; } }
    }
    nloc = mine > 0u ? mine : 1u; nx = cnt > 0u ? cnt : 1u;
}

__device__ __forceinline__ void xcd_barrier(const XcdBarrier& b) {
    asm volatile("s_waitcnt vmcnt(0)" ::: "memory");
    __syncthreads();
    if (threadIdx.x == 0) {
        unsigned* bar = b.bar;
        __builtin_amdgcn_s_waitcnt(0);
        unsigned nloc = b.st[0], nx = b.st[1];
        if (nloc == 0u) { xcd_barrier_complete(bar, b.x, nloc, nx); b.st[0] = nloc; b.st[1] = nx; }
        const unsigned old = xb_add(&bar[XB_XSUB(b.x)], 1u);
        const unsigned gen = old / nloc;
        if (old + 1u == (gen + 1u) * nloc) {
            __builtin_amdgcn_fence(__ATOMIC_RELEASE, "agent");
            asm volatile("s_waitcnt vmcnt(0)" ::: "memory");
            const unsigned og = xb_add(&bar[XB_TOP], 1u);
            const unsigned tg = og / nx;
            if (og + 1u == (tg + 1u) * nx) xb_add(&bar[XB_TOPGEN], 1u);
            else XB_SPIN(xb_ld(&bar[XB_TOPGEN]) == tg, bar);
            __builtin_amdgcn_fence(__ATOMIC_ACQUIRE, "agent");
            xb_add(&bar[XB_XGEN(b.x)], 1u);
            asm volatile("s_waitcnt vmcnt(0)" ::: "memory");
        } else {
            XB_SPIN(xb_ld(&bar[XB_XGEN(b.x)]) == gen, bar);
            __builtin_amdgcn_fence(__ATOMIC_ACQUIRE, "agent");
            asm volatile("s_waitcnt vmcnt(0)" ::: "memory");
        }
    }
    __syncthreads();
}


__device__ __forceinline__ float bperm(float v, int src) { return __builtin_bit_cast(float, __builtin_amdgcn_ds_bpermute(src << 2, __builtin_bit_cast(int, v))); }
__device__ __forceinline__ int bpermi(int v, int src) { return __builtin_amdgcn_ds_bpermute(src << 2, v); }
__device__ __forceinline__ float wsum(float v, int lane) {
#pragma unroll
    for (int o = 1; o < 64; o <<= 1) v += bperm(v, lane ^ o);
    return v;
}
struct Args { const float* in[28]; float* out; unsigned char* ws; int ph_lo, ph_hi, flags, bar_idx; };
typedef const __attribute__((address_space(4))) Args CArgs;
struct Frame {
    LAS unsigned char* lds; volatile LAS unsigned* MISC;
    unsigned* ctl; unsigned char* ws;
    int tid, lane, wave, vcu, G, bx;
};

__device__ __forceinline__ void tr_item(const float* src, int ld, int k0, int c0, bf16* dst, int Kd, int n0, bool qkperm, LAS float* scr, int lane) {
    const float* s = src + (size_t)k0 * ld + c0;
    const int kr = lane >> 4, nq = lane & 15;
#pragma unroll 4
    for (int i = 0; i < 16; ++i) { const int k = 4 * i + kr; const f32x4 v = *(const f32x4*)(s + (size_t)k * ld + 4 * nq);
        LAS float* d = scr + k * 65 + 4 * nq; d[0] = v[0]; d[1] = v[1]; d[2] = v[2]; d[3] = v[3]; }
    asm volatile("s_waitcnt lgkmcnt(0)" ::: "memory");
    const int c = lane & 7;
#pragma unroll
    for (int j = 0; j < 8; ++j) { const int n = (lane >> 3) + 8 * j; const int sc_ = qkperm ? ((n & 1) * 32 + (n >> 1)) : n; const LAS float* p = scr + (8 * c) * 65 + sc_;
        u32x4 o; o.x = pk2(p[0], p[65]); o.y = pk2(p[130], p[195]); o.z = pk2(p[260], p[325]); o.w = pk2(p[390], p[455]);
        *(u32x4*)(dst + (size_t)(n0 + n) * Kd + k0 + 8 * c) = o; }
    asm volatile("s_waitcnt lgkmcnt(0)" ::: "memory");
}
constexpr int TI_WIN = 4 * 16 * 88, TI_GT = 4 * 2 * 2 * 8 * 4, TI_WO = 4 * 3 * 256, TI_FGU = 2 * 16 * 88, TI_FD = 2 * 44 * 16, TI_EGU = 16 * 16 * 112, TI_ED = 16 * 56 * 16;
constexpr int TI_TOTAL = TI_WIN + TI_GT + TI_WO + TI_FGU + TI_FD + TI_EGU + TI_ED, MOD_ITEMS = 4 * 96;

__device__ __forceinline__ void ph_prologue(Frame& F, CArgs* a) {
    LAS float* scr = (LAS float*)(F.lds + F.wave * TR_WAVE_BYTES);
    LAS float* sv = (LAS float*)(F.lds + SVEC_OFF);
    for (int i = F.tid; i < 3 * D; i += NWAVES * 64) { const int v = i >> 10, k = i & (D - 1); const float x = v < 2 ? a->in[1][v * D + k] : a->in[3][k]; sv[i] = x * fsigm(x); }
    __syncthreads();
    const int gw = F.vcu * NWAVES + F.wave, NGW = F.G * NWAVES, lane = F.lane;
    unsigned char* ws = F.ws;
    if (gw == NGW - 1) { f32x2* rt = (f32x2*)(ws + WS_ROPE);
        for (int e = lane; e < 128 * 32; e += 64) { const int pos = e >> 5, i = e & 31; const float ang = (float)pos * powf(10000.f, -(float)i / 32.f); rt[e] = (f32x2){cosf(ang), sinf(ang)}; } }
    for (int it = NGW - 2 - gw; it >= 0 && it < MOD_ITEMS; it += NGW) {
        const int l = it / 96, n = (it % 96) * 64 + lane;
        const float* w = a->in[4] + (size_t)l * D * 6 * D + n;
        float a0 = 0.f, a1 = 0.f, a2 = 0.f;
#pragma unroll 8
        for (int k = 0; k < D; ++k) { const float wv = w[(size_t)k * 6 * D]; a0 += sv[k] * wv; a1 += sv[D + k] * wv; a2 += sv[2 * D + k] * wv; }
        const float b = a->in[5][l * 6 * D + n];
        float* o = (float*)(ws + WS_MOD) + (size_t)l * 18 * D + n;
        o[0] = a0 + b; o[6 * D] = a1 + b; o[12 * D] = a2 + b;
    }
    for (int it = gw; it < TI_TOTAL; it += NGW) {
        int r = it;
        if (r < TI_WIN) { const int l = r / (16 * 88), q = r % (16 * 88), kt = q / 88, nt = q % 88;
            tr_item(a->in[8] + (size_t)l * D * INC, INC, 64 * kt, 64 * nt, (bf16*)(ws + WS_WIN) + (size_t)l * INC * D, D, 64 * nt, nt < 20, scr, lane); continue; }
        r -= TI_WIN;
        if (r < TI_GT) { const int tl = r & 3, m = r >> 2, h = m & 7, gx = (m >> 3) & 1, d = (m >> 4) & 1, l = m >> 5;
            const float* src = (gx ? a->in[14] : a->in[12]) + (size_t)((l * 2 + d) * 8 + h) * 128 * 128;
            bf16* dst = (bf16*)(ws + WS_GT) + (size_t)((l * 8 + h) * 4 + 2 * d + gx) * 128 * 128;
            tr_item(src, 128, 64 * (tl >> 1), 64 * (tl & 1), dst, 128, 64 * (tl & 1), false, scr, lane); continue; }
        r -= TI_GT;
        if (r < TI_WO) { const int mi = r / 256, q = r % 256, kt = q / 16, nt = q % 16, l = mi / 3, w = mi % 3;
            const float* src = (w == 0 ? a->in[17] : (w == 1 ? a->in[18] : a->in[19])) + (size_t)l * D * D;
            tr_item(src, D, 64 * kt, 64 * nt, (bf16*)(ws + WS_WO) + (size_t)mi * D * D, D, 64 * nt, false, scr, lane); continue; }
        r -= TI_WO;
        if (r < TI_FGU) { const int i = r / (16 * 88), q = r % (16 * 88), kt = q / 88, nt = q % 88;
            const int pn = nt >> 2, bj = (nt >> 1) & 1, hf = nt & 1;
            const float* src = (bj ? a->in[21] : a->in[20]) + (size_t)i * D * DFF;
            tr_item(src, DFF, 64 * kt, 128 * pn + 64 * hf, (bf16*)(ws + WS_FF + i * FF_STRIDE), D, 64 * nt, false, scr, lane); continue; }
        r -= TI_FGU;
        if (r < TI_FD) { const int i = r / (44 * 16), q = r % (44 * 16), kt = q / 16, nt = q % 16;
            tr_item(a->in[22] + (size_t)i * DFF * D, D, 64 * kt, 64 * nt, (bf16*)(ws + WS_FF + i * FF_STRIDE) + (size_t)2 * DFF * D, DFF, 64 * nt, false, scr, lane); continue; }
        r -= TI_FD;
        if (r < TI_EGU) { const int ie = r / (16 * 112), q = r % (16 * 112), kt = q / 112, nt = q % 112, i = ie >> 3, e = ie & 7;
            const int pn = nt >> 2, bj = (nt >> 1) & 1, hf = nt & 1;
            const float* src = (bj ? a->in[25] : a->in[24]) + (size_t)ie * D * DFE;
            tr_item(src, DFE, 64 * kt, 128 * pn + 64 * hf, (bf16*)(ws + WS_EXP + i * EXP_STRIDE) + (size_t)e * 2 * DFE * D, D, 64 * nt, false, scr, lane); continue; }
        r -= TI_EGU;
        { const int ie = r / (56 * 16), q = r % (56 * 16), kt = q / 16, nt = q % 16, i = ie >> 3, e = ie & 7;
            tr_item(a->in[26] + (size_t)ie * DFE * D, D, 64 * kt, 64 * nt, (bf16*)(ws + WS_EXP + i * EXP_STRIDE) + (size_t)NE * 2 * DFE * D + (size_t)e * D * DFE, DFE, 64 * nt, false, scr, lane); }
    }
}

template <int KIND> __device__ __forceinline__ void ph_rows(Frame& F, CArgs* a, int l, bool combine) {
    const int gw = F.vcu * NWAVES + F.wave, NGW = F.G * NWAVES, lane = F.lane;
    unsigned char* ws = F.ws;
    float* H = (float*)(ws + WS_H); bf16* XN = (bf16*)(ws + WS_XN);
    const float* MOD = (const float*)(ws + WS_MOD);
    const bool moe = KIND == 1 && (l & 1);
    LAS float* wr_l = (LAS float*)(F.lds);
    LAS int* lcnt = (LAS int*)(F.lds + 32768);
    if (moe) {
        const float* wr = a->in[23] + (size_t)(l >> 1) * D * NE;
        for (int i = F.tid; i < D * NE; i += NWAVES * 64) { const int k = i >> 3, e = i & 7; wr_l[e * D + k] = wr[i]; }
        if (F.tid < NE) lcnt[F.tid] = 0;
        __syncthreads();
    }
    const int nrows = (KIND == 2 || (KIND == 1 && l == DEPTH - 1)) ? ML : MT;
    const float* gvec = KIND == 0 ? a->in[6] + l * D : (KIND == 1 ? a->in[7] + l * D : a->in[27]);
    f32x4 g4[4];
#pragma unroll
    for (int j = 0; j < 4; ++j) g4[j] = *(const f32x4*)(gvec + 4 * lane + 256 * j);
    for (int m = gw; m < nrows; m += NGW) {
        const int vec = row_vec(m);
        const float* src = (KIND == 0 && l == 0) ? (m < ML ? a->in[0] + (size_t)m * D : a->in[2] + (size_t)(m - ML) * D) : H + (size_t)m * D;
        f32x4 v[4];
#pragma unroll
        for (int j = 0; j < 4; ++j) v[j] = *(const f32x4*)(src + 4 * lane + 256 * j);
        if (combine) {
            const int lp = KIND == 0 ? l - 1 : DEPTH - 1;
            const float* g2 = MOD + (size_t)lp * 18 * D + (size_t)vec * 6 * D + 5 * D;
            const int* tok_slot = (const int*)(ws + WS_TOKSLOT); const float* tw = (const float*)(ws + WS_TW);
            const int s0 = tok_slot[2 * m], s1 = tok_slot[2 * m + 1]; const float w0 = tw[2 * m], w1 = tw[2 * m + 1];
            const bf16* f0 = (const bf16*)(ws + WS_FS) + (size_t)s0 * D; const bf16* f1 = (const bf16*)(ws + WS_FS) + (size_t)s1 * D;
#pragma unroll
            for (int j = 0; j < 4; ++j) { const u32x2 p0 = *(const u32x2*)(f0 + 4 * lane + 256 * j), p1 = *(const u32x2*)(f1 + 4 * lane + 256 * j); const f32x4 gg = *(const f32x4*)(g2 + 4 * lane + 256 * j);
                v[j][0] += gg[0] * (w0 * bflo(p0.x) + w1 * bflo(p1.x)); v[j][1] += gg[1] * (w0 * bfhi(p0.x) + w1 * bfhi(p1.x));
                v[j][2] += gg[2] * (w0 * bflo(p0.y) + w1 * bflo(p1.y)); v[j][3] += gg[3] * (w0 * bfhi(p0.y) + w1 * bfhi(p1.y)); }
        }
        if (KIND != 2 && ((KIND == 0 && l == 0) || combine)) {
#pragma unroll
            for (int j = 0; j < 4; ++j) *(f32x4*)(H + (size_t)m * D + 4 * lane + 256 * j) = v[j];
        }
        float ss = 0.f;
#pragma unroll
        for (int j = 0; j < 4; ++j) ss += (v[j][0] * v[j][0] + v[j][1] * v[j][1]) + (v[j][2] * v[j][2] + v[j][3] * v[j][3]);
        ss = wsum(ss, lane);
        const float r = rsqrtf(ss * (1.f / D) + EPS);
        if (KIND == 2) {
#pragma unroll
            for (int j = 0; j < 4; ++j) *(f32x4*)(a->out + (size_t)m * D + 4 * lane + 256 * j) = v[j] * r * g4[j];
            continue;
        }
        const float* mv = MOD + (size_t)l * 18 * D + (size_t)vec * 6 * D + (KIND == 0 ? 0 : 3 * D);
        float lg[NE];
#pragma unroll
        for (int e = 0; e < NE; ++e) lg[e] = 0.f;
#pragma unroll
        for (int j = 0; j < 4; ++j) {
            const f32x4 sh = *(const f32x4*)(mv + 4 * lane + 256 * j), sc = *(const f32x4*)(mv + D + 4 * lane + 256 * j);
            const f32x4 y = (v[j] * r * g4[j]) * (sc + 1.f) + sh;
            u32x2 o; o.x = pk2(y[0], y[1]); o.y = pk2(y[2], y[3]);
            *(u32x2*)(XN + (size_t)m * D + 4 * lane + 256 * j) = o;
            if (moe) {
#pragma unroll
                for (int e = 0; e < NE; ++e) { const f32x4 w = *(const LAS f32x4*)(wr_l + e * D + 4 * lane + 256 * j); lg[e] += (y[0] * w[0] + y[1] * w[1]) + (y[2] * w[2] + y[3] * w[3]); }
            }
        }
        if (moe) {
#pragma unroll
            for (int e = 0; e < NE; ++e) lg[e] = wsum(lg[e], lane);
            int i0 = 0; float v0 = lg[0];
#pragma unroll
            for (int e = 1; e < NE; ++e) if (lg[e] > v0) { v0 = lg[e]; i0 = e; }
            int i1 = -1; float v1 = -INFINITY;
#pragma unroll
            for (int e = 0; e < NE; ++e) if (e != i0 && lg[e] > v1) { v1 = lg[e]; i1 = e; }
            if (lane == 0) {
                const float e1 = expf(v1 - v0), w0 = 1.f / (1.f + e1), w1 = e1 / (1.f + e1);
                int* te = (int*)(ws + WS_TE); float* tw = (float*)(ws + WS_TW);
                te[2 * m] = i0; te[2 * m + 1] = i1; tw[2 * m] = w0; tw[2 * m + 1] = w1;
                __hip_atomic_fetch_add(&lcnt[i0], 1, __ATOMIC_RELAXED, __HIP_MEMORY_SCOPE_WORKGROUP); __hip_atomic_fetch_add(&lcnt[i1], 1, __ATOMIC_RELAXED, __HIP_MEMORY_SCOPE_WORKGROUP);
            }
        }
    }
    if (moe) {
        __syncthreads();
        if (F.tid < NE) __hip_atomic_fetch_add(F.ctl + CW_CNT + 64 * (l >> 1) + F.tid, (unsigned)lcnt[F.tid], RLX_AGENT);
    }
}

__device__ __forceinline__ void ph_lists(Frame& F, int l) {
    const int gw = F.vcu * NWAVES + F.wave, NGW = F.G * NWAVES, lane = F.lane;
    unsigned char* ws = F.ws;
    const int nrows = l == DEPTH - 1 ? ML : MT;
    LAS int* lc = (LAS int*)(F.lds); LAS int* lb = lc + 8; LAS int* lc2 = lc + 16;
    const int* te = (const int*)(ws + WS_TE); int* tok_slot = (int*)(ws + WS_TOKSLOT); int* panel_e = (int*)(ws + WS_PANELE);
    const bf16* XN = (const bf16*)(ws + WS_XN); bf16* XS = (bf16*)(ws + WS_XS);
    int cnt[NE], off[NE + 1];
    { int o = 0;
#pragma unroll
      for (int e = 0; e < NE; ++e) { cnt[e] = (int)__hip_atomic_load(F.ctl + CW_CNT + 64 * (l >> 1) + e, RLX_AGENT); off[e] = o; o += (cnt[e] + 255) & ~255; }
      off[NE] = o; }
    if (F.tid < 24) lc[F.tid] = 0;
    __syncthreads();
    for (int m = gw; m < nrows; m += NGW) if (lane < 2) __hip_atomic_fetch_add(&lc[te[2 * m + lane]], 1, __ATOMIC_RELAXED, __HIP_MEMORY_SCOPE_WORKGROUP);
    __syncthreads();
    if (F.tid < NE) lb[F.tid] = (int)__hip_atomic_fetch_add(F.ctl + CW_CUR + 64 * (l >> 1) + F.tid, (unsigned)lc[F.tid], RLX_AGENT);
    __syncthreads();
    for (int m = gw; m < nrows; m += NGW) {
        int slot = 0;
        if (lane < 2) { const int e = te[2 * m + lane]; const int pos = lb[e] + __hip_atomic_fetch_add(&lc2[e], 1, __ATOMIC_RELAXED, __HIP_MEMORY_SCOPE_WORKGROUP); int o = 0;
#pragma unroll
            for (int x = 0; x < NE; ++x) o = (x == e) ? off[x] : o;
            slot = o + pos; tok_slot[2 * m + lane] = slot; }
        const int s0 = bpermi(slot, 0), s1 = bpermi(slot, 1);
        const u32x4* src = (const u32x4*)(XN + (size_t)m * D);
        const u32x4 r0 = src[lane], r1 = src[lane + 64];
        u32x4* d0 = (u32x4*)(XS + (size_t)s0 * D); u32x4* d1 = (u32x4*)(XS + (size_t)s1 * D);
        d0[lane] = r0; d0[lane + 64] = r1; d1[lane] = r0; d1[lane + 64] = r1;
    }
#pragma unroll
    for (int e = 0; e < NE; ++e) { const int base = off[e] + cnt[e], npad = off[e + 1] - base;
        for (int i = gw; i < npad; i += NGW) { u32x4* d = (u32x4*)(XS + (size_t)(base + i) * D); d[lane] = (u32x4){0u, 0u, 0u, 0u}; d[lane + 64] = (u32x4){0u, 0u, 0u, 0u}; } }
    if (F.bx == 0) { for (int p = F.tid; p < 256; p += NWAVES * 64) { int e = 0;
#pragma unroll
            for (int x = 1; x < NE; ++x) if (p * 256 >= off[x]) e = x;
            panel_e[p] = e; }
        if (F.tid == 0) panel_e[256] = off[NE] / 256; }
}

constexpr int AT_K = 0, AT_KSTR = 272, AT_V = 64 * AT_KSTR, AT_VSTR = 144;
__device__ __forceinline__ void attn_unit(Frame& F, const float* sinkl, int unit) {
    const int tid = F.tid, lane = F.lane, w = F.wave, l31 = lane & 31, h5 = lane >> 5;
    const bf16* P = (const bf16*)(F.ws + WS_P); bf16* ATT = (bf16*)(F.ws + WS_ATT);
    LAS unsigned char* lds = F.lds;
    const bool lat = unit < 512;
    int b, kvh, t0;
    if (lat) { b = unit >> 8; kvh = (unit >> 7) & 1; t0 = (unit & 127) * 64; } else { const int u = unit - 512; b = u >> 3; kvh = (u >> 2) & 1; t0 = (u & 3) * 64; }
    const int hh = kvh * 4 + (w >> 1), qlo = t0 + 32 * (w & 1), qt = qlo + l31;
    const size_t mq = lat ? (size_t)b * SEQ + qt : (size_t)ML + b * CTX + qt;
    bf16x8 qf[8];
    { const bf16* qp = P + mq * INC + OFF_Q + hh * HD + 8 * h5;
#pragma unroll
      for (int kk = 0; kk < 8; ++kk) qf[kk] = *(const bf16x8*)(qp + 16 * kk); }
    f32x16 o[4];
#pragma unroll
    for (int dt = 0; dt < 4; ++dt)
#pragma unroll
        for (int r = 0; r < 16; ++r) o[dt][r] = 0.f;
    const float c2 = 0.08838834764831845f * 1.4426950408889634f;
    float mrun = sinkl[hh] * 1.4426950408889634f, lrun = h5 == 0 ? 1.f : 0.f;
    const int nlt = lat ? 5 : 0;
    for (int ti = 0; ti < nlt + 4; ++ti) {
        const bool islat = ti < nlt; const int ks = islat ? t0 - 128 + 64 * ti : 64 * (ti - nlt);
        if (islat && (ks < 0 || ks >= SEQ)) continue;
        const size_t krow0 = islat ? (size_t)b * SEQ + ks : (size_t)ML + b * CTX + ks;
        __syncthreads();
#pragma unroll
        for (int p = 0; p < 2; ++p) { const int idx = tid + 512 * p, row = idx >> 4, ch = idx & 15;
            const u32x4 v = *(const u32x4*)(P + (krow0 + row) * INC + OFF_K + kvh * HD + 8 * ch);
            *(LAS u32x4*)(lds + AT_K + row * AT_KSTR + ch * 16) = v; }
#pragma unroll
        for (int p = 0; p < 2; ++p) { const int idx = tid + 512 * p, key = idx & 63, c = idx >> 6;
            const u32x4 v = *(const u32x4*)(P + (krow0 + key) * INC + OFF_V + kvh * HD + 8 * c);
            const int pos = (key & 0x33) | ((key & 4) << 1) | ((key & 8) >> 1);
            LAS unsigned char* d = lds + AT_V + (8 * c) * AT_VSTR + 2 * pos;
            *(LAS unsigned short*)(d + 0 * AT_VSTR) = (unsigned short)(v.x & 0xffff); *(LAS unsigned short*)(d + 1 * AT_VSTR) = (unsigned short)(v.x >> 16);
            *(LAS unsigned short*)(d + 2 * AT_VSTR) = (unsigned short)(v.y & 0xffff); *(LAS unsigned short*)(d + 3 * AT_VSTR) = (unsigned short)(v.y >> 16);
            *(LAS unsigned short*)(d + 4 * AT_VSTR) = (unsigned short)(v.z & 0xffff); *(LAS unsigned short*)(d + 5 * AT_VSTR) = (unsigned short)(v.z >> 16);
            *(LAS unsigned short*)(d + 6 * AT_VSTR) = (unsigned short)(v.w & 0xffff); *(LAS unsigned short*)(d + 7 * AT_VSTR) = (unsigned short)(v.w >> 16); }
        __syncthreads();
        f32x16 s0, s1;
#pragma unroll
        for (int r = 0; r < 16; ++r) { s0[r] = 0.f; s1[r] = 0.f; }
#pragma unroll
        for (int kk = 0; kk < 8; ++kk) {
            const bf16x8 k0 = *(const LAS bf16x8*)(lds + AT_K + l31 * AT_KSTR + (16 * kk + 8 * h5) * 2);
            const bf16x8 k1 = *(const LAS bf16x8*)(lds + AT_K + (32 + l31) * AT_KSTR + (16 * kk + 8 * h5) * 2);
            s0 = __builtin_amdgcn_mfma_f32_32x32x16_bf16(k0, qf[kk], s0, 0, 0, 0);
            s1 = __builtin_amdgcn_mfma_f32_32x32x16_bf16(k1, qf[kk], s1, 0, 0, 0);
        }
        const bool need_mask = islat && ((ks + 63 - qlo > WIN) || (qlo + 31 - ks > WIN));
        float mt = -INFINITY;
#pragma unroll
        for (int r = 0; r < 16; ++r) {
            float a0 = s0[r] * c2, a1 = s1[r] * c2;
            if (need_mask) { const int kp = ks + (r & 3) + 8 * (r >> 2) + 4 * h5; const int d0 = kp - qt, d1 = kp + 32 - qt;
                if (d0 > WIN || d0 < -WIN) a0 = -INFINITY; if (d1 > WIN || d1 < -WIN) a1 = -INFINITY; }
            s0[r] = a0; s1[r] = a1; mt = fmaxf(mt, fmaxf(a0, a1));
        }
        mt = fmaxf(mt, bperm(mt, lane ^ 32));
        const float mnew = fmaxf(mrun, mt), alpha = __builtin_amdgcn_exp2f(mrun - mnew);
        float psum = 0.f;
#pragma unroll
        for (int r = 0; r < 16; ++r) { s0[r] = __builtin_amdgcn_exp2f(s0[r] - mnew); s1[r] = __builtin_amdgcn_exp2f(s1[r] - mnew); psum += s0[r] + s1[r]; }
        lrun = lrun * alpha + psum; mrun = mnew;
#pragma unroll
        for (int dt = 0; dt < 4; ++dt)
#pragma unroll
            for (int r = 0; r < 16; ++r) o[dt][r] *= alpha;
        bf16x8 pf[4];
#pragma unroll
        for (int s = 0; s < 2; ++s) {
            u32x4 x0, x1;
            x0.x = pk2(s0[8 * s + 0], s0[8 * s + 1]); x0.y = pk2(s0[8 * s + 2], s0[8 * s + 3]); x0.z = pk2(s0[8 * s + 4], s0[8 * s + 5]); x0.w = pk2(s0[8 * s + 6], s0[8 * s + 7]);
            x1.x = pk2(s1[8 * s + 0], s1[8 * s + 1]); x1.y = pk2(s1[8 * s + 2], s1[8 * s + 3]); x1.z = pk2(s1[8 * s + 4], s1[8 * s + 5]); x1.w = pk2(s1[8 * s + 6], s1[8 * s + 7]);
            pf[s] = __builtin_bit_cast(bf16x8, x0); pf[2 + s] = __builtin_bit_cast(bf16x8, x1);
        }
#pragma unroll
        for (int dt = 0; dt < 4; ++dt)
#pragma unroll
            for (int ss = 0; ss < 4; ++ss) {
                const bf16x8 vf = *(const LAS bf16x8*)(lds + AT_V + (32 * dt + l31) * AT_VSTR + (16 * ss + 8 * h5) * 2);
                o[dt] = __builtin_amdgcn_mfma_f32_32x32x16_bf16(vf, pf[ss], o[dt], 0, 0, 0);
            }
    }
    const float ltot = lrun + bperm(lrun, lane ^ 32), inv = 1.f / ltot;
    bf16* op = ATT + mq * D + hh * HD + 4 * h5;
#pragma unroll
    for (int dt = 0; dt < 4; ++dt)
#pragma unroll
        for (int rg = 0; rg < 4; ++rg) { u32x2 wv; wv.x = pk2(o[dt][4 * rg] * inv, o[dt][4 * rg + 1] * inv); wv.y = pk2(o[dt][4 * rg + 2] * inv, o[dt][4 * rg + 3] * inv);
            *(u32x2*)(op + 32 * dt + 8 * rg) = wv; }
}

constexpr int SC_X = 0, SC_Y = 17408, SC_O = 34816, SC_STR = 272;
template <int PASS> __device__ __forceinline__ void scan_unit(Frame& F, CArgs* a, int l, int c, int h) {
    const int tid = F.tid, lane = F.lane, w = F.wave, l15 = lane & 15, g = lane >> 4;
    unsigned char* ws = F.ws; LAS unsigned char* lds = F.lds;
    const bf16* P = (const bf16*)(ws + WS_P);
    const int m0 = 64 * c;
    int seq_lo, seq_hi;
    if (c < 256) { seq_lo = (c >> 7) * SEQ; seq_hi = seq_lo + SEQ; } else { seq_lo = ML + ((c - 256) >> 2) * CTX; seq_hi = seq_lo + CTX; }
    {
        const int ch8 = tid & 15; const int cb = 128 * h + 8 * ch8;
        const float* cw = a->in[10] + (size_t)l * 4 * D + cb; const float* cbp = a->in[11] + l * D + cb;
        f32x4 w4[4][2];
#pragma unroll
        for (int j = 0; j < 4; ++j) { w4[j][0] = *(const f32x4*)(cw + j * D); w4[j][1] = *(const f32x4*)(cw + j * D + 4); }
        const f32x4 b0 = *(const f32x4*)(cbp), b1 = *(const f32x4*)(cbp + 4);
#pragma unroll
        for (int i = 0; i < 2; ++i) { const int t = (tid >> 4) + 32 * i;
            f32x4 a0 = b0, a1 = b1;
#pragma unroll
            for (int j = 0; j < 4; ++j) { const int mr = m0 + t + j - 2;
                if (mr >= seq_lo && mr < seq_hi) { const u32x4 xv = *(const u32x4*)(P + (size_t)mr * INC + OFF_X + cb);
                    a0[0] += bflo(xv.x) * w4[j][0][0]; a0[1] += bfhi(xv.x) * w4[j][0][1]; a0[2] += bflo(xv.y) * w4[j][0][2]; a0[3] += bfhi(xv.y) * w4[j][0][3];
                    a1[0] += bflo(xv.z) * w4[j][1][0]; a1[1] += bfhi(xv.z) * w4[j][1][1]; a1[2] += bflo(xv.w) * w4[j][1][2]; a1[3] += bfhi(xv.w) * w4[j][1][3]; } }
            u32x4 o; o.x = pk2(a0[0], a0[1]); o.y = pk2(a0[2], a0[3]); o.z = pk2(a1[0], a1[1]); o.w = pk2(a1[2], a1[3]);
            *(LAS u32x4*)(lds + SC_X + t * SC_STR + ch8 * 16) = o;
            if (PASS == 2) *(LAS u32x4*)(lds + SC_Y + t * SC_STR + ch8 * 16) = *(const u32x4*)(P + (size_t)(m0 + t) * INC + OFF_Y + cb);
        }
    }
    __syncthreads();
    f32x4 acc[4][4];
#pragma unroll
    for (int mt = 0; mt < 4; ++mt)
#pragma unroll
        for (int gt = 0; gt < 4; ++gt) acc[mt][gt] = (f32x4){0.f, 0.f, 0.f, 0.f};
    const bf16* Wt = (const bf16*)(ws + WS_GT) + (size_t)(l * 8 + h) * 4 * 128 * 128 + (size_t)(16 * w + l15) * 128 + 8 * g;
#pragma unroll
    for (int kk = 0; kk < 4; ++kk) {
        bf16x8 bfr[4];
#pragma unroll
        for (int gt = 0; gt < 4; ++gt) bfr[gt] = *(const bf16x8*)(Wt + gt * 128 * 128 + 32 * kk);
#pragma unroll
        for (int mt = 0; mt < 4; ++mt) { const bf16x8 af = *(const LAS bf16x8*)(lds + SC_X + (16 * mt + l15) * SC_STR + (32 * kk + 8 * g) * 2);
#pragma unroll
            for (int gt = 0; gt < 4; ++gt) acc[mt][gt] = __builtin_amdgcn_mfma_f32_16x16x32_bf16(af, bfr[gt], acc[mt][gt], 0, 0, 0); }
    }
    const int chl = 16 * w + l15, ch = 128 * h + chl;
    float xv[4][4];
#pragma unroll
    for (int mt = 0; mt < 4; ++mt)
#pragma unroll
        for (int r = 0; r < 4; ++r) xv[mt][r] = bf2f(*(const LAS bf16*)(lds + SC_X + (16 * mt + 4 * g + r) * SC_STR + chl * 2));
    float hsum[4][4];
    float* AGG_A = (float*)(ws + WS_AGG); float* AGG_B = (float*)(ws + WS_AGG + AGG_BYTES); const float* CARRY = (const float*)(ws + WS_AGG + 2 * AGG_BYTES);
#pragma unroll
    for (int d = 0; d < 2; ++d) {
        const size_t vo = ((size_t)l * 2 + d) * D + ch;
        const float bav = a->in[13][vo], bxv = a->in[15][vo], sp2 = -8.f * 1.4426950408889634f * log1pf(expf(-a->in[16][vo]));
        float av[4][4], bv[4][4];
#pragma unroll
        for (int mt = 0; mt < 4; ++mt)
#pragma unroll
            for (int r = 0; r < 4; ++r) {
                const float rg = fsigm(acc[mt][2 * d][r] + bav), ig = fsigm(acc[mt][2 * d + 1][r] + bxv);
                const float la2 = sp2 * rg, aa = __builtin_amdgcn_exp2f(la2);
                av[mt][r] = aa; bv[mt][r] = __builtin_amdgcn_sqrtf(fmaxf(1.f - aa * aa, 0.f)) * (ig * xv[mt][r]);
            }
        const size_t ao = ((size_t)d * NCHUNK + c) * D + ch;
        float hrun = PASS == 2 ? CARRY[ao] : 0.f, Arun = 1.f;
#pragma unroll
        for (int i = 0; i < 4; ++i) {
            const int mt = d == 0 ? i : 3 - i;
            float As = 1.f, Bs = 0.f;
#pragma unroll
            for (int j = 0; j < 4; ++j) { const int r = d == 0 ? j : 3 - j; Bs = av[mt][r] * Bs + bv[mt][r]; As = av[mt][r] * As; }
            const int gi = d == 0 ? g : 3 - g;
            const int p1 = d == 0 ? lane - 16 : lane + 16, p2 = d == 0 ? lane - 32 : lane + 32;
            float Ai = As, Bi = Bs;
            { const float A1 = bperm(Ai, p1 & 63), B1 = bperm(Bi, p1 & 63); if (gi >= 1) { Bi = Ai * B1 + Bi; Ai = Ai * A1; } }
            { const float A2 = bperm(Ai, p2 & 63), B2 = bperm(Bi, p2 & 63); if (gi >= 2) { Bi = Ai * B2 + Bi; Ai = Ai * A2; } }
            const int lastl = d == 0 ? l15 + 48 : l15;
            const float At = bperm(Ai, lastl), Bt = bperm(Bi, lastl);
            if (PASS == 2) {
                float Ae = bperm(Ai, p1 & 63), Be = bperm(Bi, p1 & 63); if (gi == 0) { Ae = 1.f; Be = 0.f; }
                float hc = Ae * hrun + Be;
#pragma unroll
                for (int j = 0; j < 4; ++j) { const int r = d == 0 ? j : 3 - j; hc = av[mt][r] * hc + bv[mt][r]; hsum[mt][r] = d == 0 ? hc : hsum[mt][r] + hc; }
            }
            hrun = At * hrun + Bt; Arun = At * Arun;
        }
        if (PASS == 1 && g == 0) { AGG_A[ao] = Arun; AGG_B[ao] = hrun; }
    }
    if (PASS == 2) {
#pragma unroll
        for (int mt = 0; mt < 4; ++mt)
#pragma unroll
            for (int r = 0; r < 4; ++r) { const int t = 16 * mt + 4 * g + r;
                const float y = bf2f(*(const LAS bf16*)(lds + SC_Y + t * SC_STR + chl * 2));
                *(LAS bf16*)(lds + SC_O + t * SC_STR + chl * 2) = f2bf(hsum[mt][r] * y); }
        __syncthreads();
        bf16* RECG = (bf16*)(ws + WS_RECG);
#pragma unroll
        for (int i = 0; i < 2; ++i) { const int t = (tid >> 4) + 32 * i, ch8 = tid & 15;
            *(u32x4*)(RECG + (size_t)(m0 + t) * D + 128 * h + 8 * ch8) = *(const LAS u32x4*)(lds + SC_O + t * SC_STR + ch8 * 16); }
    } else {
        __syncthreads();
    }
}
__device__ __forceinline__ void ph_carry(Frame& F) {
    const int gw = F.vcu * NWAVES + F.wave;
    if (gw >= 64) return;
    const int idx = gw * 64 + F.lane, ch = idx & (D - 1), b = (idx >> 10) & 1, d = idx >> 11;
    const float* AGG_A = (const float*)(F.ws + WS_AGG) + (size_t)d * NCHUNK * D + ch; const float* AGG_B = (const float*)(F.ws + WS_AGG + AGG_BYTES) + (size_t)d * NCHUNK * D + ch;
    float* CARRY = (float*)(F.ws + WS_AGG + 2 * AGG_BYTES) + (size_t)d * NCHUNK * D + ch;
    float hcur = 0.f;
    {   float A[4], B[4];
#pragma unroll
        for (int i = 0; i < 4; ++i) { const int c = 256 + 4 * b + (d == 0 ? i : 3 - i); A[i] = AGG_A[(size_t)c * D]; B[i] = AGG_B[(size_t)c * D]; }
#pragma unroll
        for (int i = 0; i < 4; ++i) { const int c = 256 + 4 * b + (d == 0 ? i : 3 - i); CARRY[(size_t)c * D] = hcur; hcur = A[i] * hcur + B[i]; }
    }
    for (int i0 = 0; i0 < 128; i0 += 16) {
        float A[16], B[16];
#pragma unroll
        for (int i = 0; i < 16; ++i) { const int c = 128 * b + (d == 0 ? i0 + i : 127 - i0 - i); A[i] = AGG_A[(size_t)c * D]; B[i] = AGG_B[(size_t)c * D]; }
#pragma unroll
        for (int i = 0; i < 16; ++i) { const int c = 128 * b + (d == 0 ? i0 + i : 127 - i0 - i); CARRY[(size_t)c * D] = hcur; hcur = A[i] * hcur + B[i]; }
    }
}

__global__ void __launch_bounds__(NWAVES * 64, 2) mk_fwd(Args args) {
    extern __shared__ __attribute__((aligned(16))) unsigned char lds_raw[];
    Frame F;
    F.lds = (LAS unsigned char*)lds_raw;
    F.MISC = (volatile LAS unsigned*)(F.lds + LDSCTL_OFF);
    F.tid = threadIdx.x; F.lane = F.tid & 63; F.wave = __builtin_amdgcn_readfirstlane(F.tid >> 6);
    F.G = gridDim.x; F.bx = blockIdx.x; F.vcu = 0;
    F.ws = args.ws; F.ctl = (unsigned*)(args.ws + WS_CTL);
    for (int u = F.tid; u < (LDS_BYTES - LDSCTL_OFF) / 4; u += NWAVES * 64) ((LAS unsigned*)(F.lds + LDSCTL_OFF))[u] = 0u;
    __syncthreads();
    const int lo = args.ph_lo, hi = args.ph_hi;
    const bool multi = hi - lo > 1;
    unsigned* barw = F.ctl + CW_BAR + args.bar_idx * XCD_BAR_WORDS;
    XcdBarrier bar; bar.bar = barw; bar.x = 0; bar.st = nullptr;
    if (multi) bar = xcd_barrier_post(barw, F.MISC + 8);
#ifndef PH_MASK
#define PH_MASK 0xffff
#endif
#define SITE(s) ((PH_MASK >> (s)) & 1)
#define IN(k) (lo <= (k) && (k) < hi)
#define REFRESH() do { CArgs* ap_ = (CArgs*)__builtin_amdgcn_kernarg_segment_ptr(); asm volatile("" : "+s"(ap_)); ap = ap_; \
    unsigned char* w_ = ap_->ws; int t_ = threadIdx.x, z_ = 0; asm volatile("" : "+s"(w_), "+v"(t_), "+s"(z_)); \
    ws = w_; F.ws = w_; F.ctl = (unsigned*)(w_ + WS_CTL); F.tid = t_; F.lane = t_ & 63; F.wave = __builtin_amdgcn_readfirstlane(t_ >> 6); \
    F.lds = (LAS unsigned char*)lds_raw + z_; ring = F.lds + RING_OFF; \
    int bx_ = blockIdx.x, g_ = gridDim.x; asm volatile("" : "+s"(bx_), "+s"(g_)); F.bx = bx_; F.G = g_; F.vcu = (g_ % 8 == 0) ? (bx_ % 8) * (g_ / 8) + bx_ / 8 : bx_; } while (0)
#define SEAM(k) do { if (IN(k) && IN((k) + 1)) { XcdBarrier b_ = bar; unsigned* p_ = b_.bar; unsigned x_ = b_.x; asm volatile("" : "+s"(p_), "+s"(x_)); b_.bar = p_; b_.x = x_; xcd_barrier(b_); } } while (0)
    unsigned char* ws = args.ws;
    LAS unsigned char* ring = F.lds + RING_OFF;
    CArgs* ap = (CArgs*)__builtin_amdgcn_kernarg_segment_ptr();

    if (SITE(0) && IN(0)) { REFRESH(); ph_prologue(F, ap); SEAM(0); }
    for (int l = 0; l < DEPTH; ++l) {
        const int pb = 1 + 11 * l;
        const bool moe = l & 1, last = l == DEPTH - 1;
        const int Mrows = last ? ML : MT;
        if (SITE(1) && IN(pb + 0)) { REFRESH(); ph_rows<0>(F, ap, l, (ap->flags & 4) && l > 0 && ((l - 1) & 1)); SEAM(pb + 0); }
        if (SITE(2) && IN(pb + 1)) { REFRESH();
            pg8::Gemm g{(const bf16*)(ws + WS_XN), (const bf16*)(ws + WS_WIN) + (size_t)l * INC * D, MT, INC, D}; pg8::StaticOrder S; S.init(MT, INC, F.G, F.bx);
            pg8::EpiInProj E{(bf16*)(ws + WS_P), (const f32x4*)(ws + WS_ROPE)};
            pg8::gemm_phase<pg8::EpiInProj, pg8::StaticOrder, true, true>(ring, g, S, E);
            SEAM(pb + 1);
        }
        if (SITE(3) && IN(pb + 2)) { REFRESH();
            const int fl = ap->flags & 3;
            if (fl == 0 || (fl & 1)) { for (int u = F.vcu; u < 528; u += F.G) attn_unit(F, ap->in[9] + l * NH, u); __syncthreads(); }
            if (fl == 0 || (fl & 2)) { const int h = F.vcu & 7; for (int c = F.vcu >> 3; c < NCHUNK; c += F.G >> 3) scan_unit<1>(F, ap, l, c, h); }
            SEAM(pb + 2);
        }
        if (SITE(4) && IN(pb + 3)) { REFRESH(); ph_carry(F); SEAM(pb + 3); }
        if (SITE(5) && IN(pb + 4)) { REFRESH(); const int h = F.vcu & 7; for (int c = F.vcu >> 3; c < NCHUNK; c += F.G >> 3) scan_unit<2>(F, ap, l, c, h); SEAM(pb + 4); }
        if (SITE(6) && IN(pb + 5)) { REFRESH();
            const bf16* WO = (const bf16*)(ws + WS_WO) + (size_t)l * 3 * D * D;
            pg8::StaticOrder S; S.init(MT, D, F.G, F.bx);
            { pg8::Gemm g{(const bf16*)(ws + WS_ATT), WO, MT, D, D}; pg8::EpiMerge E{(const bf16*)(ws + WS_P), (bf16*)(ws + WS_T1), (bf16*)(ws + WS_MM), 0};
              pg8::gemm_phase<pg8::EpiMerge, pg8::StaticOrder, true, true>(ring, g, S, E); }
            asm volatile("s_waitcnt vmcnt(0)" ::: "memory");
            if (F.tid == 0) { __builtin_amdgcn_fence(__ATOMIC_ACQUIRE, "agent"); asm volatile("s_waitcnt vmcnt(0)" ::: "memory"); }
            __syncthreads();
            { pg8::Gemm g{(const bf16*)(ws + WS_RECG), WO + (size_t)D * D, MT, D, D}; pg8::EpiMerge E{(const bf16*)(ws + WS_P), (bf16*)(ws + WS_T1), (bf16*)(ws + WS_MM), 1};
              pg8::gemm_phase<pg8::EpiMerge, pg8::StaticOrder, true, true>(ring, g, S, E); }
            SEAM(pb + 5);
        }
        if (SITE(7) && IN(pb + 6)) { REFRESH();
            pg8::Gemm g{(const bf16*)(ws + WS_MM), (const bf16*)(ws + WS_WO) + (size_t)(l * 3 + 2) * D * D, Mrows, D, D}; pg8::StaticOrder S; S.init(Mrows, D, F.G, F.bx);
            pg8::EpiResid E{(float*)(ws + WS_H), (const float*)(ws + WS_MOD) + (size_t)l * 18 * D + 2 * D};
            pg8::gemm_phase<pg8::EpiResid, pg8::StaticOrder, true, true>(ring, g, S, E);
            SEAM(pb + 6);
        }
        if (SITE(8) && IN(pb + 7)) { REFRESH(); ph_rows<1>(F, ap, l, false); SEAM(pb + 7); }
        if (SITE(9) && IN(pb + 8) && moe) { REFRESH(); ph_lists(F, l); SEAM(pb + 8); }
        if (SITE(10) && IN(pb + 9)) { REFRESH();
            if (!moe) {
                pg8::Gemm g{(const bf16*)(ws + WS_XN), (const bf16*)(ws + WS_FF + (l >> 1) * FF_STRIDE), Mrows, 2 * DFF, D}; pg8::ExpertOrder S; S.init(Mrows, 2 * DFF, F.G, F.bx); S.panel_e = (const int*)(ws + WS_PANELE); S.estride = 0;
                pg8::EpiSwiGLU E{(bf16*)(ws + WS_HID), DFF};
                pg8::gemm_phase<pg8::EpiSwiGLU, pg8::ExpertOrder, true, true>(ring, g, S, E);
            } else {
                const int np = __builtin_amdgcn_readfirstlane(((const int*)(ws + WS_PANELE))[256]);
                pg8::Gemm g{(const bf16*)(ws + WS_XS), (const bf16*)(ws + WS_EXP + (l >> 1) * EXP_STRIDE), np * 256, 2 * DFE, D}; pg8::ExpertOrder S; S.init(np * 256, 2 * DFE, F.G, F.bx); S.panel_e = (const int*)(ws + WS_PANELE); S.estride = (size_t)2 * DFE * D * 2;
                pg8::EpiSwiGLU E{(bf16*)(ws + WS_HID), DFE};
                pg8::gemm_phase<pg8::EpiSwiGLU, pg8::ExpertOrder, true, true>(ring, g, S, E);
            }
            SEAM(pb + 9);
        }
        if (SITE(11) && IN(pb + 10)) { REFRESH();
            if (!moe) {
                pg8::Gemm g{(const bf16*)(ws + WS_HID), (const bf16*)(ws + WS_FF + (l >> 1) * FF_STRIDE) + (size_t)2 * DFF * D, Mrows, D, DFF}; pg8::StaticOrder S; S.init(Mrows, D, F.G, F.bx);
                pg8::EpiResid E{(float*)(ws + WS_H), (const float*)(ws + WS_MOD) + (size_t)l * 18 * D + 5 * D};
                pg8::gemm_phase<pg8::EpiResid, pg8::StaticOrder, true, true>(ring, g, S, E);
            } else {
                const int np = __builtin_amdgcn_readfirstlane(((const int*)(ws + WS_PANELE))[256]);
                pg8::Gemm g{(const bf16*)(ws + WS_HID), (const bf16*)(ws + WS_EXP + (l >> 1) * EXP_STRIDE) + (size_t)NE * 2 * DFE * D, np * 256, D, DFE}; pg8::ExpertOrder S; S.init(np * 256, D, F.G, F.bx); S.panel_e = (const int*)(ws + WS_PANELE); S.estride = (size_t)D * DFE * 2;
                pg8::EpiPlain E{(bf16*)(ws + WS_FS), D};
                pg8::gemm_phase<pg8::EpiPlain, pg8::ExpertOrder, true, true>(ring, g, S, E);
            }
            SEAM(pb + 10);
        }
    }
    if (SITE(12) && IN(45)) { REFRESH(); ph_rows<2>(F, ap, DEPTH, (ap->flags & 4) != 0); }
#undef IN
#undef SEAM
}

static int g_bar_idx = 0;
static void opt_launch(void* const* d_in, void* d_out, void* d_ws, hipStream_t stream, int ph_lo, int ph_hi, int flags) {
    static int grid = 0;
    if (grid == 0) {
        int dev = 0, cus = 0, per_cu = 0;
        if (hipGetDevice(&dev) != hipSuccess || hipDeviceGetAttribute(&cus, hipDeviceAttributeMultiprocessorCount, dev) != hipSuccess) { fprintf(stderr, "opt_launch: device query failed\n"); grid = -1; return; }
        if (hipFuncSetAttribute((const void*)mk_fwd, hipFuncAttributeMaxDynamicSharedMemorySize, LDS_BYTES) != hipSuccess) { fprintf(stderr, "opt_launch: hipFuncSetAttribute failed\n"); grid = -1; return; }
        if (hipOccupancyMaxActiveBlocksPerMultiprocessor(&per_cu, (const void*)mk_fwd, NWAVES * 64, LDS_BYTES) != hipSuccess || per_cu < 1) { fprintf(stderr, "opt_launch: occupancy query says %d blocks per CU\n", per_cu); }
        (void)hipGetLastError();
        grid = cus;
        if (grid % 8 != 0 || grid < 64) fprintf(stderr, "opt_launch: unexpected CU count %d\n", grid);
    }
    if (grid < 0) return;
    Args a{};
    for (int i = 0; i < 28; ++i) a.in[i] = (const float*)d_in[i];
    a.out = (float*)d_out; a.ws = (unsigned char*)d_ws; a.ph_lo = ph_lo; a.ph_hi = ph_hi; a.flags = flags; a.bar_idx = (ph_hi - ph_lo > 1) ? g_bar_idx++ : 0;
    hipLaunchKernelGGL(mk_fwd, dim3(grid), dim3(NWAVES * 64), LDS_BYTES, stream, a);
    const hipError_t le = hipPeekAtLastError();
    if (le != hipSuccess) fprintf(stderr, "opt_launch: launch [%d,%d) failed: %s\n", ph_lo, ph_hi, hipGetErrorName(le));
}


extern "C" void kernel_launch(void* const* d_in, const int* in_sizes, int n_in, void* d_out, int out_size, void* d_ws, size_t ws_size, hipStream_t stream) {
    if (n_in != 28 || ws_size < WS_END) { fprintf(stderr, "kernel_launch: unexpected n_in %d or ws_size %zu (need %zu)\n", n_in, ws_size, (size_t)WS_END); return; }
    const float* x = (const float*)d_in[0]; const float* c = (const float*)d_in[1]; const float* ctx = (const float*)d_in[2]; const float* c_ctx = (const float*)d_in[3];
    const float* w_mod = (const float*)d_in[4]; const float* b_mod = (const float*)d_in[5]; const float* norm1_g = (const float*)d_in[6]; const float* norm2_g = (const float*)d_in[7];
    const float* w_in = (const float*)d_in[8]; const float* attn_sink = (const float*)d_in[9]; const float* conv_w = (const float*)d_in[10]; const float* conv_b = (const float*)d_in[11];
    const float* gate_a_w = (const float*)d_in[12]; const float* gate_a_b = (const float*)d_in[13]; const float* gate_x_w = (const float*)d_in[14]; const float* gate_x_b = (const float*)d_in[15];
    const float* lru_lambda = (const float*)d_in[16]; const float* w_o_attn = (const float*)d_in[17]; const float* w_o_lru = (const float*)d_in[18]; const float* w_out = (const float*)d_in[19];
    const float* ff_w_gate = (const float*)d_in[20]; const float* ff_w_up = (const float*)d_in[21]; const float* ff_w_down = (const float*)d_in[22]; const float* router_w = (const float*)d_in[23];
    const float* exp_w_gate = (const float*)d_in[24]; const float* exp_w_up = (const float*)d_in[25]; const float* exp_w_down = (const float*)d_in[26]; const float* final_g = (const float*)d_in[27];
    char* ws = (char*)d_ws;
    float* MOD = (float*)(ws + WS_MOD);
    int* te = (int*)(ws + WS_TE); float* tw = (float*)(ws + WS_TW); int* slot_tok = (int*)(ws + WS_SLOTTOK); int* tok_slot = (int*)(ws + WS_TOKSLOT); int* tile_e = (int*)(ws + WS_PANELE);
    float* H = (float*)(ws + WS_H); bf16* XN = (bf16*)(ws + WS_XN); bf16* P = (bf16*)(ws + WS_P); bf16* ATT = (bf16*)(ws + WS_ATT); bf16* RECG = (bf16*)(ws + WS_RECG);
    bf16* MM = (bf16*)(ws + WS_MM); bf16* HID = (bf16*)(ws + WS_HID); bf16* FS = (bf16*)(ws + WS_FS);
    float* XC = (float*)(ws + NV_XC); float* RG = (float*)(ws + NV_RG); float* IG = (float*)(ws + NV_IG); float* REC = (float*)(ws + NV_REC); float* PF = (float*)(ws + NV_PF32);
    const int EB = (int)(((long)MT * D + 255) / 256);
    (void)out_size; (void)in_sizes;

    (void)hipMemsetAsync(ws + WS_CTL, 0, CTL_ZERO_BYTES, stream);
    g_bar_idx = 0;
    const int CF = OPT_STEP >= 6 ? 4 : 0;
#if OPT_STEP >= 8
    opt_launch(d_in, d_out, d_ws, stream, 0, 46, 4);
    return;
#endif
#if OPT_STEP >= 1
    opt_launch(d_in, d_out, d_ws, stream, 0, 1, 0);
#else
    (void)hipMemcpyAsync(H, x, (size_t)ML * D * 4, hipMemcpyDeviceToDevice, stream);
    (void)hipMemcpyAsync(H + (size_t)ML * D, ctx, (size_t)MC * D * 4, hipMemcpyDeviceToDevice, stream);
    hipLaunchKernelGGL(nv::k_mod, dim3(6 * D / 256, DEPTH), dim3(256), 0, stream, c, c_ctx, w_mod, b_mod, MOD);
#endif
    for (int l = 0; l < DEPTH; ++l) {
        const float* MODl = MOD + (size_t)l * 3 * 6 * D;
        const int pb = 1 + 11 * l;
#if OPT_STEP >= 1
        opt_launch(d_in, d_out, d_ws, stream, pb + 0, pb + 2, CF);
#else
        hipLaunchKernelGGL((nv::k_norm_mod<bf16>), dim3(MT / 4), dim3(256), 0, stream, H, norm1_g + l * D, MODl, 0, D, XN, MT);
        ngemm(stream, XN, D, nullptr, w_in + (size_t)l * D * INC, INC, PF, INC, MT, INC, D);
        hipLaunchKernelGGL(nv::k_rope, dim3((ML * 640 + 255) / 256), dim3(256), 0, stream, PF);
        hipLaunchKernelGGL(nv::k_pfmt, dim3((int)(((long)MT * INC + 255) / 256)), dim3(256), 0, stream, PF, P);
#endif
#if OPT_STEP >= 2
        opt_launch(d_in, d_out, d_ws, stream, pb + 2, pb + 3, 1);
#else
        hipLaunchKernelGGL(nv::k_attn, dim3(MT * NH / 4), dim3(256), 0, stream, P, attn_sink + l * NH, ATT);
#endif
#if OPT_STEP >= 3
        opt_launch(d_in, d_out, d_ws, stream, pb + 2, pb + 3, 2);
        opt_launch(d_in, d_out, d_ws, stream, pb + 3, pb + 5, 0);
#else
        hipLaunchKernelGGL(nv::k_conv, dim3(EB), dim3(256), 0, stream, P, conv_w + (size_t)l * 4 * D, conv_b + l * D, XC);
        for (int d = 0; d < 2; ++d) {
            const size_t go = ((size_t)l * 2 + d) * 8 * 128 * 128, vo = ((size_t)l * 2 + d) * D;
            ngemm(stream, XC, D, nullptr, gate_a_w + go, 128, RG, D, MT, 128, 128, 8, 128, 128 * 128, 128);
            ngemm(stream, XC, D, nullptr, gate_x_w + go, 128, IG, D, MT, 128, 128, 8, 128, 128 * 128, 128);
            hipLaunchKernelGGL(nv::k_scan, dim3(BATCH * D / 64), dim3(64), 0, stream, XC, RG, IG, gate_a_b + vo, gate_x_b + vo, lru_lambda + vo, d, REC);
        }
        hipLaunchKernelGGL(nv::k_recgate, dim3(EB), dim3(256), 0, stream, REC, P, RECG);
#endif
#if OPT_STEP >= 4
        opt_launch(d_in, d_out, d_ws, stream, pb + 5, pb + 7, 0);
#else
        ngemm(stream, ATT, D, nullptr, w_o_attn + (size_t)l * D * D, D, RG, D, MT, D, D);
        ngemm(stream, RECG, D, nullptr, w_o_lru + (size_t)l * D * D, D, IG, D, MT, D, D);
        hipLaunchKernelGGL(nv::k_merge, dim3(EB), dim3(256), 0, stream, RG, IG, P, MM);
        ngemm(stream, MM, D, nullptr, w_out + (size_t)l * D * D, D, XC, D, MT, D, D);
        hipLaunchKernelGGL(nv::k_resid, dim3(EB), dim3(256), 0, stream, H, XC, MODl, 2 * D);
#endif
        const int i = l / 2;
        if (l % 2 == 0) {
#if OPT_STEP >= 5
            opt_launch(d_in, d_out, d_ws, stream, pb + 7, pb + 11, 0);
#else
            hipLaunchKernelGGL((nv::k_norm_mod<bf16>), dim3(MT / 4), dim3(256), 0, stream, H, norm2_g + l * D, MODl, 3 * D, 4 * D, XN, MT);
            ngemm(stream, XN, D, nullptr, ff_w_gate + (size_t)i * D * DFF, DFF, HID, DFF, MT, DFF, D);
            ngemm(stream, XN, D, nullptr, ff_w_up + (size_t)i * D * DFF, DFF, HID, DFF, MT, DFF, D, 1, 0, 0, 0, nullptr, 0, 1);
            ngemm(stream, HID, DFF, nullptr, ff_w_down + (size_t)i * DFF * D, D, IG, D, MT, D, DFF);
            hipLaunchKernelGGL(nv::k_resid, dim3(EB), dim3(256), 0, stream, H, IG, MODl, 5 * D);
#endif
        } else {
#if OPT_STEP >= 6
            opt_launch(d_in, d_out, d_ws, stream, pb + 7, pb + 11, 0);
#if OPT_STEP == 6
            if (l == DEPTH - 1) hipLaunchKernelGGL(nv::k_moe_combine, dim3(EB), dim3(256), 0, stream, H, FS, tok_slot, tw, MODl, 5 * D);
#endif
#else
            hipLaunchKernelGGL((nv::k_norm_mod<bf16>), dim3(MT / 4), dim3(256), 0, stream, H, norm2_g + l * D, MODl, 3 * D, 4 * D, XN, MT);
            hipLaunchKernelGGL(nv::k_route, dim3(MT / 4), dim3(256), 0, stream, XN, router_w + (size_t)i * D * NE, te, tw);
            hipLaunchKernelGGL(nv::k_moe_lists, dim3(1), dim3(1024), 0, stream, te, slot_tok, tok_slot, tile_e);
            const size_t eo = (size_t)i * NE * D * DFE;
            ngemm(stream, XN, D, slot_tok, exp_w_gate + eo, DFE, HID, DFE, NSLOT, DFE, D, 1, 0, 0, 0, tile_e, (long)D * DFE, 0);
            ngemm(stream, XN, D, slot_tok, exp_w_up + eo, DFE, HID, DFE, NSLOT, DFE, D, 1, 0, 0, 0, tile_e, (long)D * DFE, 1);
            ngemm(stream, HID, DFE, nullptr, exp_w_down + eo, D, FS, D, NSLOT, D, DFE, 1, 0, 0, 0, tile_e, (long)DFE * D, 0);
            hipLaunchKernelGGL(nv::k_moe_combine, dim3(EB), dim3(256), 0, stream, H, FS, tok_slot, tw, MODl, 5 * D);
#endif
        }
    }
#if OPT_STEP >= 7
    opt_launch(d_in, d_out, d_ws, stream, 45, 46, CF);
#else
    hipLaunchKernelGGL(nv::k_final, dim3(ML / 4), dim3(256), 0, stream, H, final_g, (float*)d_out);
#endif
}
```

```cpp
#include <hip/hip_runtime.h>
#include <cstdio>
#include <cstdint>

#ifndef OPT_STEP
#define OPT_STEP 8
#endif

constexpr int D = 1024, BATCH = 2, SEQ = 8192, DEPTH = 4, CTX = 256, GRIDW = 64;
constexpr int NH = 8, NKV = 2, HD = 128, WIN = 128;
constexpr int DFF = 2816, NE = 8, DFE = 3584;
constexpr int INC = 5632;
constexpr int OFF_Q = 0, OFF_K = 1024, OFF_V = 1280, OFF_X = 1536, OFF_Y = 2560, OFF_GA = 3584, OFF_GR = 4608;
constexpr int ML = BATCH * SEQ, MC = BATCH * CTX, MT = ML + MC;
constexpr int NSLOT = 35840;
constexpr int NCHUNK = MT / 64;
constexpr float EPS = 1e-6f;
constexpr size_t MiB = 1u << 20;

typedef unsigned short bf16;
typedef float f32x4 __attribute__((ext_vector_type(4)));
typedef float f32x2 __attribute__((ext_vector_type(2)));
typedef float f32x16 __attribute__((ext_vector_type(16)));
typedef unsigned u32x4 __attribute__((ext_vector_type(4)));
typedef unsigned u32x2 __attribute__((ext_vector_type(2)));
typedef short bf16x8 __attribute__((ext_vector_type(8)));
typedef __bf16 bf2_t __attribute__((ext_vector_type(2)));
#define LAS __attribute__((address_space(3)))
#define GAS __attribute__((address_space(1)))
typedef GAS unsigned gu32;

__device__ __forceinline__ unsigned pk2(float lo, float hi) { f32x2 v = {lo, hi}; return __builtin_bit_cast(unsigned, __builtin_convertvector(v, bf2_t)); }
__device__ __forceinline__ bf16 f2bf(float f) { return (bf16)(pk2(f, 0.f) & 0xffffu); }
__device__ __forceinline__ float bf2f(bf16 b) { return __uint_as_float(((unsigned)b) << 16); }
__device__ __forceinline__ float bflo(unsigned u) { return __uint_as_float(u << 16); }
__device__ __forceinline__ float bfhi(unsigned u) { return __uint_as_float(u & 0xffff0000u); }
__device__ __forceinline__ float ldf(const float* p) { return *p; }
__device__ __forceinline__ float ldf(const bf16* p) { return bf2f(*p); }
__device__ __forceinline__ void stf(float* p, float v) { *p = v; }
__device__ __forceinline__ void stf(bf16* p, float v) { *p = f2bf(v); }

__device__ __forceinline__ float sigm(float x) { return 1.f / (1.f + expf(-x)); }
__device__ __forceinline__ float silu_f(float x) { return x * sigm(x); }
__device__ __forceinline__ float gelu_tanh(float x) { return 0.5f * x * (1.f + tanhf(0.7978845608028654f * (x + 0.044715f * x * x * x))); }
__device__ __forceinline__ float fsigm(float x) { return __builtin_amdgcn_rcpf(1.f + __builtin_amdgcn_exp2f(-1.4426950408889634f * x)); }
__device__ __forceinline__ float fsilu(float x) { return x * fsigm(x); }
__device__ __forceinline__ float fgelu(float x) { return x * __builtin_amdgcn_rcpf(1.f + __builtin_amdgcn_exp2f(-2.302208198f * (x + 0.044715f * x * x * x))); }
__device__ __forceinline__ float wave_sum(float v) {
#pragma unroll
    for (int o = 1; o < 64; o <<= 1) v += __shfl_xor(v, o);
    return v;
}
__device__ __forceinline__ float wave_max(float v) {
#pragma unroll
    for (int o = 1; o < 64; o <<= 1) v = fmaxf(v, __shfl_xor(v, o));
    return v;
}
__device__ __forceinline__ int row_vec(int m) { return m < ML ? m / SEQ : 2; }
__host__ __device__ __forceinline__ int qk_orig(int ni) { return (ni >> 6) * 64 + (ni & 1) * 32 + ((ni & 63) >> 1); }

constexpr size_t WS_CTL = 0, CTL_ZERO_BYTES = 1 * MiB;
constexpr size_t WS_MOD = 2 * MiB, WS_ROPE = WS_MOD + 320 * 1024, WS_TE = WS_MOD + 384 * 1024, WS_TW = WS_MOD + 576 * 1024, WS_TOKSLOT = WS_MOD + 768 * 1024, WS_PANELE = WS_MOD + 960 * 1024;
constexpr size_t WS_SLOTTOK = 3 * MiB, WS_SPT = 3 * MiB + 512 * 1024;
constexpr size_t WS_AGG = 4 * MiB;
constexpr size_t AGG_BYTES = (size_t)2 * NCHUNK * D * 4;
constexpr size_t WS_GT = 12 * MiB;
constexpr size_t WS_WIN = 16 * MiB;
constexpr size_t WS_WO = 60 * MiB;
constexpr size_t WS_FF = 84 * MiB, FF_STRIDE = (size_t)(2 * DFF * D + D * DFF) * 2;
constexpr size_t WS_EXP = 117 * MiB, EXP_STRIDE = (size_t)NE * (2 * DFE * D + D * DFE) * 2;
constexpr size_t WS_H = 453 * MiB, WS_XN = 519 * MiB, WS_P = 552 * MiB, WS_ATT = 734 * MiB, WS_RECG = 767 * MiB, WS_T1 = 800 * MiB, WS_MM = 833 * MiB, WS_XS = 866 * MiB, WS_END = 966 * MiB;
constexpr size_t WS_HID = WS_P, WS_FS = WS_XS;
constexpr size_t WS_SCAB = WS_T1;
static_assert(WS_SCAB + (size_t)NCHUNK * 8 * 8 * 10 * 1024 <= WS_END, "scan block area");
static_assert(WS_FF + 2 * FF_STRIDE <= WS_EXP && WS_EXP + 2 * EXP_STRIDE <= WS_H && WS_HID + (size_t)NSLOT * DFE * 2 <= WS_T1 && WS_AGG + 3 * AGG_BYTES <= WS_GT, "ws map");
constexpr size_t NV_XC = WS_EXP, NV_RG = WS_EXP + 66 * MiB, NV_IG = WS_EXP + 132 * MiB, NV_REC = WS_EXP + 198 * MiB, NV_PF32 = 16 * MiB;
constexpr int CW_TMO = 0, CW_CNT = 2048, CW_CUR = 2048 + 256, CW_BAR = 4096;

namespace nv {
__global__ __launch_bounds__(256) void k_mod(const float* c, const float* c_ctx, const float* w_mod, const float* b_mod, float* MOD) {
    __shared__ float s[3][D];
    const int l = blockIdx.y, n = blockIdx.x * 256 + threadIdx.x;
    for (int i = threadIdx.x; i < 3 * D; i += 256) { const int v = i / D, k = i % D; const float x = v < 2 ? c[v * D + k] : c_ctx[k]; s[v][k] = silu_f(x); }
    __syncthreads();
    const float* w = w_mod + (size_t)l * D * 6 * D + n;
    float a0 = 0.f, a1 = 0.f, a2 = 0.f;
    for (int k = 0; k < D; ++k) { const float wv = w[(size_t)k * 6 * D]; a0 += s[0][k] * wv; a1 += s[1][k] * wv; a2 += s[2][k] * wv; }
    const float b = b_mod[l * 6 * D + n];
    float* o = MOD + (size_t)l * 3 * 6 * D + n;
    o[0] = a0 + b; o[6 * D] = a1 + b; o[12 * D] = a2 + b;
}
template <class TO> __global__ __launch_bounds__(256) void k_norm_mod(const float* H, const float* g, const float* MODl, int sh_off, int sc_off, TO* XN, int nrows) {
    const int m = (blockIdx.x * 256 + threadIdx.x) >> 6, lane = threadIdx.x & 63;
    if (m >= nrows) return;
    const float* h = H + (size_t)m * D;
    float v[16]; float ss = 0.f;
#pragma unroll
    for (int j = 0; j < 16; ++j) { v[j] = h[lane + 64 * j]; ss += v[j] * v[j]; }
    ss = wave_sum(ss);
    const float r = rsqrtf(ss * (1.f / D) + EPS);
    const float* mv = MODl + (size_t)row_vec(m) * 6 * D;
#pragma unroll
    for (int j = 0; j < 16; ++j) { const int n = lane + 64 * j; stf(XN + (size_t)m * D + n, (v[j] * r * g[n]) * (1.f + mv[sc_off + n]) + mv[sh_off + n]); }
}
template <class TA, class TC> struct NGemm {
    const TA* A; int lda; const int* arow;
    const float* B; int ldb; TC* C; int ldc; int K;
    long sA, sB, sC;
    const int* tile_e; long sBe;
    int mode;
};
template <class TA, class TC> __global__ __launch_bounds__(256) void k_gemm(NGemm<TA, TC> g) {
    const int z = blockIdx.z, tm = blockIdx.y, tn = blockIdx.x;
    const TA* A = g.A + (long)z * g.sA; const float* B = g.B + (long)z * g.sB; TC* C = g.C + (long)z * g.sC;
    if (g.tile_e) { const int e = g.tile_e[tm]; if (e < 0) return; B += (long)e * g.sBe; }
    const int wave = threadIdx.x >> 6, lane = threadIdx.x & 63, lr = lane & 15, lk = lane >> 4;
    const int m0 = tm * 128 + (wave >> 1) * 64, n0 = tn * 128 + (wave & 1) * 64;
    const TA* ap0; const TA* ap1; const TA* ap2; const TA* ap3;
    {
        int r0 = m0 + lr, r1 = r0 + 16, r2 = r0 + 32, r3 = r0 + 48;
        if (g.arow) { r0 = g.arow[r0]; r1 = g.arow[r1]; r2 = g.arow[r2]; r3 = g.arow[r3]; r0 = r0 < 0 ? 0 : r0; r1 = r1 < 0 ? 0 : r1; r2 = r2 < 0 ? 0 : r2; r3 = r3 < 0 ? 0 : r3; }
        ap0 = A + (long)r0 * g.lda + lk; ap1 = A + (long)r1 * g.lda + lk; ap2 = A + (long)r2 * g.lda + lk; ap3 = A + (long)r3 * g.lda + lk;
    }
    const float* bp = B + (long)lk * g.ldb + n0 + lr;
    f32x4 acc[4][4];
#pragma unroll
    for (int i = 0; i < 4; ++i)
#pragma unroll
        for (int j = 0; j < 4; ++j) acc[i][j] = (f32x4){0.f, 0.f, 0.f, 0.f};
    const long ldb = g.ldb;
    for (int k = 0; k < g.K; k += 4) {
        float a[4], b[4];
        a[0] = ldf(ap0 + k); a[1] = ldf(ap1 + k); a[2] = ldf(ap2 + k); a[3] = ldf(ap3 + k);
        const float* bk = bp + (long)k * ldb;
        b[0] = bk[0]; b[1] = bk[16]; b[2] = bk[32]; b[3] = bk[48];
#pragma unroll
        for (int i = 0; i < 4; ++i)
#pragma unroll
            for (int j = 0; j < 4; ++j) acc[i][j] = __builtin_amdgcn_mfma_f32_16x16x4f32(a[i], b[j], acc[i][j], 0, 0, 0);
    }
#pragma unroll
    for (int i = 0; i < 4; ++i)
#pragma unroll
        for (int j = 0; j < 4; ++j)
#pragma unroll
            for (int r = 0; r < 4; ++r) {
                TC* cp = C + (long)(m0 + 16 * i + 4 * lk + r) * g.ldc + n0 + 16 * j + lr;
                const float v = acc[i][j][r];
                stf(cp, g.mode == 1 ? silu_f(ldf(cp)) * v : v);
            }
}
__global__ __launch_bounds__(256) void k_rope(float* P) {
    const long idx = (long)blockIdx.x * 256 + threadIdx.x;
    if (idx >= (long)ML * 10 * 64) return;
    const int pi = (int)(idx & 63), slot = (int)((idx >> 6) % 10), m = (int)(idx / 640);
    const int t = m % SEQ, half = pi >> 5, i = pi & 31;
    const int base = (slot < 8 ? OFF_Q + slot * HD : OFF_K + (slot - 8) * HD) + half * 64;
    const float pos = half == 0 ? (float)(t / GRIDW) : (float)(t % GRIDW);
    const float inv = powf(10000.f, -(float)i / 32.f);
    const float ang = pos * inv, cs = cosf(ang), sn = sinf(ang);
    float* p = P + (size_t)m * INC + base;
    const float x1 = p[i], x2 = p[32 + i];
    p[i] = x1 * cs - x2 * sn; p[32 + i] = x2 * cs + x1 * sn;
}
__global__ __launch_bounds__(256) void k_pfmt(const float* Pf, bf16* P) {
    const long idx = (long)blockIdx.x * 256 + threadIdx.x; if (idx >= (long)MT * INC) return;
    const int n = (int)(idx % INC); const long m = idx / INC;
    float v;
    if (n < OFF_V) { const int hb = n & ~127; v = Pf[m * INC + hb + qk_orig(n & 127)]; }
    else { v = Pf[idx]; if (n >= OFF_Y && n < OFF_GA) v = gelu_tanh(v); else if (n >= OFF_GA) v = sigm(v); }
    P[idx] = f2bf(v);
}
__global__ __launch_bounds__(256) void k_attn(const bf16* P, const float* sink, bf16* O) {
    __shared__ float ps[4][576];
    __shared__ int prow[4][576];
    const int w = threadIdx.x >> 6, lane = threadIdx.x & 63;
    const int gw = blockIdx.x * 4 + w;
    const int m = gw >> 3, h = gw & 7, kvh = h >> 2;
    const bool lat = m < ML;
    const int b = lat ? m / SEQ : (m - ML) / CTX, t = lat ? m % SEQ : 0;
    const int lo = lat ? (t - WIN < 0 ? 0 : t - WIN) : 0, hi = lat ? (t + WIN > SEQ - 1 ? SEQ - 1 : t + WIN) : -1;
    const int nlat = lat ? hi - lo + 1 : 0, nk = nlat + CTX;
    const bf16* q = P + (size_t)m * INC + OFF_Q + h * HD;
    const float scale = 0.08838834764831845f;
    const float sk = sink[h];
    float sc[9]; float mx = sk;
#pragma unroll
    for (int i = 0; i < 9; ++i) {
        const int j = lane + 64 * i; float s = -INFINITY;
        if (j < nk) {
            const int row = j < nlat ? b * SEQ + lo + j : ML + b * CTX + (j - nlat);
            const bf16* kp = P + (size_t)row * INC + OFF_K + kvh * HD;
            float d = 0.f;
            for (int e = 0; e < 128; ++e) d += bf2f(q[e]) * bf2f(kp[e]);
            s = d * scale; prow[w][j] = row;
        }
        sc[i] = s; mx = fmaxf(mx, s);
    }
    mx = wave_max(mx);
    float sum = 0.f;
#pragma unroll
    for (int i = 0; i < 9; ++i) { const int j = lane + 64 * i; if (j < nk) { const float p = expf(sc[i] - mx); ps[w][j] = p; sum += p; } }
    sum = wave_sum(sum) + expf(sk - mx);
    const float rs = 1.f / sum;
    __syncthreads();
    float o0 = 0.f, o1 = 0.f;
    for (int j = 0; j < nk; ++j) { const float p = ps[w][j]; const bf16* vp = P + (size_t)prow[w][j] * INC + OFF_V + kvh * HD; o0 += p * bf2f(vp[lane]); o1 += p * bf2f(vp[lane + 64]); }
    bf16* op = O + (size_t)m * D + h * HD;
    op[lane] = f2bf(o0 * rs); op[lane + 64] = f2bf(o1 * rs);
}
__global__ __launch_bounds__(256) void k_conv(const bf16* P, const float* cw, const float* cb, float* XC) {
    const long idx = (long)blockIdx.x * 256 + threadIdx.x;
    if (idx >= (long)MT * D) return;
    const int ch = (int)(idx & (D - 1)), m = (int)(idx >> 10);
    const bool lat = m < ML; const int L = lat ? SEQ : CTX, t = lat ? m % SEQ : (m - ML) % CTX;
    float y = 0.f;
#pragma unroll
    for (int j = 0; j < 4; ++j) { const int tt = t + j - 2; if (tt >= 0 && tt < L) y += bf2f(P[(size_t)(m + j - 2) * INC + OFF_X + ch]) * cw[j * D + ch]; }
    XC[idx] = y + cb[ch];
}
__device__ __forceinline__ void scan_seq(const float* XC, const float* RG, const float* IG, float* REC, int mbase, int L, int dir, int ch, float sp, float bav, float bxv, float& h) {
    for (int s0 = 0; s0 < L; s0 += 8) {
        float x[8], r[8], g[8], pr[8];
#pragma unroll
        for (int u = 0; u < 8; ++u) { const int t = dir == 0 ? s0 + u : L - 1 - (s0 + u); const size_t o = (size_t)(mbase + t) * D + ch; x[u] = XC[o]; r[u] = RG[o]; g[u] = IG[o]; pr[u] = dir == 0 ? 0.f : REC[o]; }
#pragma unroll
        for (int u = 0; u < 8; ++u) { const int t = dir == 0 ? s0 + u : L - 1 - (s0 + u); const size_t o = (size_t)(mbase + t) * D + ch;
            const float rr = sigm(r[u] + bav), ig = sigm(g[u] + bxv);
            const float la = -8.f * rr * sp, a = expf(la), bc = sqrtf(-expm1f(2.f * la)) * (ig * x[u]);
            h = a * h + bc; REC[o] = pr[u] + h; }
    }
}
__global__ __launch_bounds__(64) void k_scan(const float* XC, const float* RG, const float* IG, const float* ba, const float* bx, const float* lam, int dir, float* REC) {
    const int idx = blockIdx.x * 64 + threadIdx.x;
    const int b = idx >> 10, ch = idx & (D - 1);
    const float sp = log1pf(expf(-lam[ch])), bav = ba[ch], bxv = bx[ch];
    float h = 0.f;
    scan_seq(XC, RG, IG, REC, ML + b * CTX, CTX, dir, ch, sp, bav, bxv, h);
    scan_seq(XC, RG, IG, REC, b * SEQ, SEQ, dir, ch, sp, bav, bxv, h);
}
__global__ __launch_bounds__(256) void k_recgate(const float* REC, const bf16* P, bf16* RECG) {
    const long idx = (long)blockIdx.x * 256 + threadIdx.x; if (idx >= (long)MT * D) return;
    const int ch = (int)(idx & (D - 1)), m = (int)(idx >> 10);
    RECG[idx] = f2bf(REC[idx] * bf2f(P[(size_t)m * INC + OFF_Y + ch]));
}
__global__ __launch_bounds__(256) void k_merge(const float* T1, const float* T2, const bf16* P, bf16* MM) {
    const long idx = (long)blockIdx.x * 256 + threadIdx.x; if (idx >= (long)MT * D) return;
    const int ch = (int)(idx & (D - 1)), m = (int)(idx >> 10);
    const bf16* p = P + (size_t)m * INC;
    MM[idx] = f2bf(bf2f(p[OFF_GA + ch]) * T1[idx] + bf2f(p[OFF_GR + ch]) * T2[idx]);
}
__global__ __launch_bounds__(256) void k_resid(float* H, const float* Y, const float* MODl, int g_off) {
    const long idx = (long)blockIdx.x * 256 + threadIdx.x; if (idx >= (long)MT * D) return;
    const int n = (int)(idx & (D - 1)), m = (int)(idx >> 10);
    H[idx] += MODl[(size_t)row_vec(m) * 6 * D + g_off + n] * Y[idx];
}
__global__ __launch_bounds__(256) void k_route(const bf16* XN, const float* wr, int* te, float* tw) {
    const int m = (blockIdx.x * 256 + threadIdx.x) >> 6, lane = threadIdx.x & 63;
    if (m >= MT) return;
    float lg[NE];
#pragma unroll
    for (int e = 0; e < NE; ++e) lg[e] = 0.f;
    for (int j = 0; j < 16; ++j) { const int k = lane + 64 * j; const float x = bf2f(XN[(size_t)m * D + k]); const float* w = wr + (size_t)k * NE;
#pragma unroll
        for (int e = 0; e < NE; ++e) lg[e] += x * w[e]; }
#pragma unroll
    for (int e = 0; e < NE; ++e) lg[e] = wave_sum(lg[e]);
    if (lane == 0) {
        int i0 = 0; float v0 = lg[0];
#pragma unroll
        for (int e = 1; e < NE; ++e) if (lg[e] > v0) { v0 = lg[e]; i0 = e; }
        int i1 = -1; float v1 = -INFINITY;
#pragma unroll
        for (int e = 0; e < NE; ++e) if (e != i0 && lg[e] > v1) { v1 = lg[e]; i1 = e; }
        const float e1 = expf(v1 - v0), w0 = 1.f / (1.f + e1), w1 = e1 / (1.f + e1);
        te[2 * m] = i0; te[2 * m + 1] = i1; tw[2 * m] = w0; tw[2 * m + 1] = w1;
    }
}
__global__ __launch_bounds__(1024) void k_moe_lists(const int* te, int* slot_tok, int* tok_slot, int* tile_e) {
    __shared__ int cnt[NE], off[NE + 1], cur[NE];
    const int tid = threadIdx.x;
    if (tid < NE) { cnt[tid] = 0; cur[tid] = 0; }
    for (int i = tid; i < NSLOT; i += 1024) slot_tok[i] = -1;
    __syncthreads();
    for (int i = tid; i < 2 * MT; i += 1024) atomicAdd(&cnt[te[i]], 1);
    __syncthreads();
    if (tid == 0) { int o = 0; for (int e = 0; e < NE; ++e) { off[e] = o; o += (cnt[e] + 255) / 256 * 256; } off[NE] = o; }
    __syncthreads();
    for (int i = tid; i < NSLOT / 128; i += 1024) { int e = -1; for (int x = 0; x < NE; ++x) if (i * 128 >= off[x] && i * 128 < off[x + 1]) e = x; tile_e[i] = e; }
    for (int i = tid; i < 2 * MT; i += 1024) { const int e = te[i]; const int pos = atomicAdd(&cur[e], 1); const int s = off[e] + pos; slot_tok[s] = i >> 1; tok_slot[i] = s; }
}
__global__ __launch_bounds__(256) void k_moe_combine(float* H, const bf16* FS, const int* tok_slot, const float* tw, const float* MODl, int g_off) {
    const long idx = (long)blockIdx.x * 256 + threadIdx.x; if (idx >= (long)MT * D) return;
    const int n = (int)(idx & (D - 1)), m = (int)(idx >> 10);
    const float f = tw[2 * m] * bf2f(FS[(size_t)tok_slot[2 * m] * D + n]) + tw[2 * m + 1] * bf2f(FS[(size_t)tok_slot[2 * m + 1] * D + n]);
    H[idx] += MODl[(size_t)row_vec(m) * 6 * D + g_off + n] * f;
}
__global__ __launch_bounds__(256) void k_final(const float* H, const float* g, float* out) {
    const int m = (blockIdx.x * 256 + threadIdx.x) >> 6, lane = threadIdx.x & 63;
    if (m >= ML) return;
    const float* h = H + (size_t)m * D;
    float v[16]; float ss = 0.f;
#pragma unroll
    for (int j = 0; j < 16; ++j) { v[j] = h[lane + 64 * j]; ss += v[j] * v[j]; }
    ss = wave_sum(ss);
    const float r = rsqrtf(ss * (1.f / D) + EPS);
#pragma unroll
    for (int j = 0; j < 16; ++j) { const int n = lane + 64 * j; out[(size_t)m * D + n] = v[j] * r * g[n]; }
}
}

template <class TA, class TC>
static void ngemm(hipStream_t st, const TA* A, int lda, const int* arow, const float* B, int ldb, TC* C, int ldc, int M, int N, int K,
                  int nz = 1, long sA = 0, long sB = 0, long sC = 0, const int* tile_e = nullptr, long sBe = 0, int mode = 0) {
    nv::NGemm<TA, TC> g{}; g.A = A; g.lda = lda; g.arow = arow; g.B = B; g.ldb = ldb; g.C = C; g.ldc = ldc; g.K = K; g.sA = sA; g.sB = sB; g.sC = sC; g.tile_e = tile_e; g.sBe = sBe; g.mode = mode;
    hipLaunchKernelGGL((nv::k_gemm<TA, TC>), dim3(N / 128, M / 128, nz), dim3(256), 0, st, g);
}

namespace pg8 {
#define PG8_LAS __attribute__((address_space(3)))
typedef unsigned short bf16_t;
typedef short bf16x8 __attribute__((ext_vector_type(8)));
typedef float f32x4 __attribute__((ext_vector_type(4)));
typedef unsigned u32x4 __attribute__((ext_vector_type(4)));
constexpr int BM = 256, BK = 64, HALF = 128, HTB = HALF * BK * 2  , STAGE_BYTES = 8 * HTB, NXCD = 8, WGM = 8;

__host__ __device__ __forceinline__ int lds_byte(int r, int c) { const int st = (r >> 4) * 2 + (c >> 5), rr = r & 15, cc = c & 31, ob = rr * 64 + cc * 2; return st * 1024 + (ob ^ (((ob >> 9) & 1) << 5)); }
__host__ __device__ __forceinline__ void stage_rc(int b, int& R, int& C) { const int st = b / 1024, sb = b % 1024, swz = sb ^ (((sb >> 9) & 1) << 5); R = (st >> 1) * 16 + swz / 64; C = (st & 1) * 32 + (swz % 64) / 2; }
__host__ __device__ __forceinline__ int perm32(int rho) { const int n = rho >> 4, i = rho & 15; return 8 * (i >> 2) + 4 * n + (i & 3); }

struct Unit { int pm, pn; };
struct Gemm { const bf16_t* A; const bf16_t* Bt; int M, N, K; };

struct StaticOrder {
    int nM, nN, nwg, G, c;
    __host__ __device__ void init(int M, int N, int G_, int c_) { nM = M / BM; nN = N / BM; nwg = nM * nN; G = G_; c = c_; }
    __host__ __device__ bool next(int i, Unit& u) const {
        const long L = (long)i * G + c; if (L >= nwg) return false;
        int wgid = (int)L; { const int q = nwg / NXCD, r = nwg % NXCD, xcd = wgid % NXCD, off = wgid / NXCD; wgid = (xcd < r ? xcd * (q + 1) : r * (q + 1) + (xcd - r) * q) + off; }
        const int nig = WGM * nN, gid = wgid / nig, fm = gid * WGM, gsz = (nM - fm) < WGM ? (nM - fm) : WGM;
        u.pm = fm + ((wgid % nig) % gsz); u.pn = (wgid % nig) / gsz; return true;
    }
    __device__ __forceinline__ void a_ready(const Unit&) const {}
    __device__ __forceinline__ size_t boff(const Unit&) const { return 0; }
    __device__ __forceinline__ void done(const Unit&) const {}
};


struct ExpertOrder : StaticOrder {
    const int* panel_e; size_t estride;
    __device__ __forceinline__ size_t boff(const Unit& u) const { return (size_t)__builtin_amdgcn_readfirstlane(panel_e[u.pm]) * estride; }
};
struct EpiInProj {
    static constexpr bool PERM = true, AFTER_DRAIN = false;
    bf16* P; const f32x4* rope;
    __device__ __forceinline__ void operator()(const f32x4 (&acc)[2][2][4][2], const Unit& u, int wr, int wc, int fr, int fq) const {
        const int pn = u.pn;
        const int kind = pn < 5 ? 0 : (pn < 10 ? 1 : (pn < 14 ? 2 : 3));
        const bool rope_on = kind == 0 && u.pm < 64;
        const int row0 = u.pm * BM + wr * 64 + fr, col0 = pn * BM + wc * 32 + 8 * fq;
#pragma unroll
        for (int ai = 0; ai < 2; ++ai)
#pragma unroll
            for (int m = 0; m < 4; ++m) {
                const int row = row0 + ai * HALF + m * 16;
                bf16* rowp = P + (size_t)row * INC + col0;
                f32x4 cs0 = {1.f, 0.f, 1.f, 0.f}, cs1 = {1.f, 0.f, 1.f, 0.f};
                if (rope_on) { const int t = row & (SEQ - 1); const int pos = (wc >> 1) ? (t & 63) : (t >> 6); const f32x4* rp = rope + pos * 16 + 8 * (wc & 1) + 2 * fq; cs0 = rp[0]; cs1 = rp[1]; }
#pragma unroll
                for (int bj = 0; bj < 2; ++bj) {
                    f32x4 v0 = acc[ai][bj][m][0], v1 = acc[ai][bj][m][1];
                    if (kind == 0) {
                        const f32x4 a = v0, b = v1;
                        v0[0] = a[0] * cs0[0] - a[1] * cs0[1]; v0[1] = a[1] * cs0[0] + a[0] * cs0[1];
                        v0[2] = a[2] * cs0[2] - a[3] * cs0[3]; v0[3] = a[3] * cs0[2] + a[2] * cs0[3];
                        v1[0] = b[0] * cs1[0] - b[1] * cs1[1]; v1[1] = b[1] * cs1[0] + b[0] * cs1[1];
                        v1[2] = b[2] * cs1[2] - b[3] * cs1[3]; v1[3] = b[3] * cs1[2] + b[2] * cs1[3];
                    } else if (kind == 2) {
#pragma unroll
                        for (int j = 0; j < 4; ++j) { v0[j] = fgelu(v0[j]); v1[j] = fgelu(v1[j]); }
                    } else if (kind == 3) {
#pragma unroll
                        for (int j = 0; j < 4; ++j) { v0[j] = fsigm(v0[j]); v1[j] = fsigm(v1[j]); }
                    }
                    u32x4 w; w.x = pk2(v0[0], v0[1]); w.y = pk2(v0[2], v0[3]); w.z = pk2(v1[0], v1[1]); w.w = pk2(v1[2], v1[3]);
                    *(u32x4*)(rowp + bj * HALF) = w;
                }
            }
    }
};
struct EpiMerge {
    static constexpr bool PERM = true, AFTER_DRAIN = false;
    const bf16* P; bf16* T1; bf16* MM; int mode;
    __device__ __forceinline__ void operator()(const f32x4 (&acc)[2][2][4][2], const Unit& u, int wr, int wc, int fr, int fq) const {
        const int row0 = u.pm * BM + wr * 64 + fr, col0 = u.pn * BM + wc * 32 + 8 * fq;
#pragma unroll
        for (int ai = 0; ai < 2; ++ai)
#pragma unroll
            for (int m = 0; m < 4; ++m) {
                const size_t row = (size_t)(row0 + ai * HALF + m * 16);
#pragma unroll
                for (int bj = 0; bj < 2; ++bj) {
                    const int col = col0 + bj * HALF;
                    const u32x4 g = *(const u32x4*)(P + row * INC + (mode ? OFF_GR : OFF_GA) + col);
                    const f32x4 a0 = acc[ai][bj][m][0], a1 = acc[ai][bj][m][1];
                    float o[8] = {bflo(g.x) * a0[0], bfhi(g.x) * a0[1], bflo(g.y) * a0[2], bfhi(g.y) * a0[3], bflo(g.z) * a1[0], bfhi(g.z) * a1[1], bflo(g.w) * a1[2], bfhi(g.w) * a1[3]};
                    if (mode) { const u32x4 t = *(const u32x4*)(T1 + row * D + col);
                        o[0] += bflo(t.x); o[1] += bfhi(t.x); o[2] += bflo(t.y); o[3] += bfhi(t.y); o[4] += bflo(t.z); o[5] += bfhi(t.z); o[6] += bflo(t.w); o[7] += bfhi(t.w); }
                    u32x4 w; w.x = pk2(o[0], o[1]); w.y = pk2(o[2], o[3]); w.z = pk2(o[4], o[5]); w.w = pk2(o[6], o[7]);
                    *(u32x4*)((mode ? MM : T1) + row * D + col) = w;
                }
            }
    }
};
struct EpiResid {
    static constexpr bool PERM = false, AFTER_DRAIN = false;
    float* H; const float* gate;
    __device__ __forceinline__ void operator()(const f32x4 (&acc)[2][2][4][2], const Unit& u, int wr, int wc, int fr, int fq) const {
        const int row0 = u.pm * BM + wr * 64 + fr, col0 = u.pn * BM + wc * 32 + 4 * fq;
        const float* gv = gate + (size_t)(u.pm < 32 ? 0 : (u.pm < 64 ? 1 : 2)) * 6 * D;
        f32x4 g4[2][2];
#pragma unroll
        for (int bj = 0; bj < 2; ++bj)
#pragma unroll
            for (int n = 0; n < 2; ++n) g4[bj][n] = *(const f32x4*)(gv + col0 + bj * HALF + n * 16);
#pragma unroll
        for (int ai = 0; ai < 2; ++ai)
#pragma unroll
            for (int m = 0; m < 4; ++m) { float* rowp = H + (size_t)(row0 + ai * HALF + m * 16) * D + col0;
#pragma unroll
                for (int bj = 0; bj < 2; ++bj)
#pragma unroll
                    for (int n = 0; n < 2; ++n) { f32x4* p = (f32x4*)(rowp + bj * HALF + n * 16); *p = *p + g4[bj][n] * acc[ai][bj][m][n]; } }
    }
};
struct EpiSwiGLU {
    static constexpr bool PERM = true, AFTER_DRAIN = false;
    bf16* HID; int ldh;
    __device__ __forceinline__ void operator()(const f32x4 (&acc)[2][2][4][2], const Unit& u, int wr, int wc, int fr, int fq) const {
        const int row0 = u.pm * BM + wr * 64 + fr, col0 = u.pn * HALF + wc * 32 + 8 * fq;
#pragma unroll
        for (int ai = 0; ai < 2; ++ai)
#pragma unroll
            for (int m = 0; m < 4; ++m) {
                const f32x4 g0 = acc[ai][0][m][0], g1 = acc[ai][0][m][1], u0 = acc[ai][1][m][0], u1 = acc[ai][1][m][1];
                u32x4 w; w.x = pk2(fsilu(g0[0]) * u0[0], fsilu(g0[1]) * u0[1]); w.y = pk2(fsilu(g0[2]) * u0[2], fsilu(g0[3]) * u0[3]);
                w.z = pk2(fsilu(g1[0]) * u1[0], fsilu(g1[1]) * u1[1]); w.w = pk2(fsilu(g1[2]) * u1[2], fsilu(g1[3]) * u1[3]);
                *(u32x4*)(HID + (size_t)(row0 + ai * HALF + m * 16) * ldh + col0) = w;
            }
    }
};
struct EpiPlain {
    static constexpr bool PERM = true, AFTER_DRAIN = false;
    bf16* O; int ldc;
    __device__ __forceinline__ void operator()(const f32x4 (&acc)[2][2][4][2], const Unit& u, int wr, int wc, int fr, int fq) const {
        const int row0 = u.pm * BM + wr * 64 + fr, col0 = u.pn * BM + wc * 32 + 8 * fq;
#pragma unroll
        for (int ai = 0; ai < 2; ++ai)
#pragma unroll
            for (int m = 0; m < 4; ++m) { bf16* rowp = O + (size_t)(row0 + ai * HALF + m * 16) * ldc + col0;
#pragma unroll
                for (int bj = 0; bj < 2; ++bj) { const f32x4 v0 = acc[ai][bj][m][0], v1 = acc[ai][bj][m][1];
                    u32x4 w; w.x = pk2(v0[0], v0[1]); w.y = pk2(v0[2], v0[3]); w.z = pk2(v1[0], v1[1]); w.w = pk2(v1[2], v1[3]);
                    *(u32x4*)(rowp + bj * HALF) = w; } }
    }
};
template <class Epi, class Sched, bool ALIGN_EPI = false, bool SP2 = false>
__device__ __forceinline__ void gemm_phase(PG8_LAS unsigned char* lds, const Gemm g, const Sched& S, const Epi& E) {
    int tid_ = threadIdx.x; asm volatile("" : "+v"(tid_));
    const int tid = tid_, wid = __builtin_amdgcn_readfirstlane(tid >> 6), lane = tid & 63, wr = wid >> 2, wc = wid & 3, fr = lane & 15, fq = lane >> 4;
    const int K = g.K, nt = K / BK;
    unsigned voffA[2], voffB[2];
#pragma unroll
    for (int i = 0; i < 2; ++i) { int R, C; stage_rc(tid * 16 + i * 8192, R, C); const int Rb = Epi::PERM ? ((R & ~31) + perm32(R & 31)) : R;
        voffA[i] = (unsigned)(R * K + C) * 2u; voffB[i] = (unsigned)(Rb * K + C) * 2u; }
    const size_t kstep = (size_t)(BK * 2);
    const size_t hstep = (size_t)HALF * K * 2;
    const size_t tstep = 2 * hstep;
    const unsigned ldsw = (unsigned)wid * 1024u;
    const int aoff = lds_byte(wr * 64 + fr, fq * 8), boff = lds_byte(wc * 32 + fr, fq * 8);
#define PG8_SA(b, h) (((b) * 2 + (h)) * HTB)
#define PG8_SB(b, h) ((4 + (b) * 2 + (h)) * HTB)
#define PG8_STAGE(bufoff, gbase, voff) do { _Pragma("unroll") for (int _i = 0; _i < 2; ++_i) \
        __builtin_amdgcn_global_load_lds((const unsigned*)((const char*)(gbase) + (voff)[_i]), (PG8_LAS unsigned*)(lds + (bufoff) + ldsw + _i * 8192), 16, 0, 0); } while (0)
#define PG8_LDA(dst, b, h) do { _Pragma("unroll") for (int m = 0; m < 4; ++m) _Pragma("unroll") for (int k = 0; k < 2; ++k) dst[m][k] = *(const PG8_LAS bf16x8*)(lds + PG8_SA(b, h) + aoff + m * 2048 + k * 1024); } while (0)
#define PG8_LDB(dst, b, h) do { _Pragma("unroll") for (int n = 0; n < 2; ++n) _Pragma("unroll") for (int k = 0; k < 2; ++k) dst[n][k] = *(const PG8_LAS bf16x8*)(lds + PG8_SB(b, h) + boff + n * 2048 + k * 1024); } while (0)
#define PG8_MMA(ai, bj, At, Bt) do { __builtin_amdgcn_s_setprio(1); _Pragma("unroll") for (int m = 0; m < 4; ++m) _Pragma("unroll") for (int n = 0; n < 2; ++n) _Pragma("unroll") for (int k = 0; k < 2; ++k) \
        acc[ai][bj][m][n] = __builtin_amdgcn_mfma_f32_16x16x32_bf16(Bt[n][k], At[m][k], acc[ai][bj][m][n], 0, 0, 0); __builtin_amdgcn_s_setprio(0); } while (0)
#define PG8_WAIT_V(n) asm volatile("s_waitcnt vmcnt(" #n ")" ::: "memory")
#define PG8_WAIT_L(n) asm volatile("s_waitcnt lgkmcnt(" #n ")" ::: "memory")
#define PG8_BAR __builtin_amdgcn_s_barrier()
#define PG8_SCHED __builtin_amdgcn_sched_barrier(0)
    Unit cur, nxt; int ui = 0;
    if (!S.next(0, cur)) return;
    f32x4 acc[2][2][4][2];
#pragma unroll
    for (int a = 0; a < 2; ++a)
#pragma unroll
        for (int b = 0; b < 2; ++b)
#pragma unroll
            for (int m = 0; m < 4; ++m)
#pragma unroll
                for (int n = 0; n < 2; ++n) acc[a][b][m][n] = (f32x4){0.f, 0.f, 0.f, 0.f};
    bf16x8 At[4][2], B0[2][2], B1[2][2];
    const char* cA = (const char*)g.A + (size_t)cur.pm * tstep; const char* cB = (const char*)g.Bt + S.boff(cur) + (size_t)cur.pn * tstep;
    S.a_ready(cur);
    if constexpr (SP2) {
        PG8_STAGE(PG8_SB(0, 0), cB, voffB); PG8_STAGE(PG8_SB(0, 1), cB + hstep, voffB); PG8_STAGE(PG8_SA(0, 0), cA, voffA); PG8_STAGE(PG8_SA(0, 1), cA + hstep, voffA);
        if (wr == 1) PG8_BAR;
        PG8_WAIT_V(2); PG8_BAR;
        PG8_STAGE(PG8_SB(1, 0), cB + kstep, voffB); PG8_STAGE(PG8_SA(1, 0), cA + kstep, voffA); PG8_STAGE(PG8_SB(1, 1), cB + hstep + kstep, voffB);
        PG8_WAIT_V(6); PG8_BAR;
    } else {
        PG8_STAGE(PG8_SB(0, 0), cB, voffB); PG8_STAGE(PG8_SA(0, 0), cA, voffA); PG8_STAGE(PG8_SB(0, 1), cB + hstep, voffB); PG8_STAGE(PG8_SA(0, 1), cA + hstep, voffA);
        if (wr == 1) PG8_BAR;
        PG8_WAIT_V(4); PG8_BAR;
        PG8_STAGE(PG8_SB(1, 0), cB + kstep, voffB); PG8_STAGE(PG8_SA(1, 0), cA + kstep, voffA); PG8_STAGE(PG8_SB(1, 1), cB + hstep + kstep, voffB);
        PG8_WAIT_V(6); PG8_BAR;
    }
    for (;;) {
        const bool has_next = S.next(ui + 1, nxt);
        const char* nA = has_next ? (const char*)g.A + (size_t)nxt.pm * tstep : cA; const char* nB = has_next ? (const char*)g.Bt + S.boff(nxt) + (size_t)nxt.pn * tstep : cB;
        for (int t = 0; t < nt; t += 2) {
            const bool last = (t == nt - 2);
            const char* a1 = cA + (size_t)(t + 1) * kstep;
            const char* a2 = last ? nA : cA + (size_t)(t + 2) * kstep; const char* b2 = last ? nB : cB + (size_t)(t + 2) * kstep;
            const char* a3 = a2 + kstep; const char* b3 = b2 + kstep;
            if (last && has_next) S.a_ready(nxt);
            if constexpr (SP2) {
            PG8_LDB(B0, 0, 0); PG8_LDB(B1, 0, 1); PG8_SCHED; PG8_LDA(At, 0, 0); PG8_STAGE(PG8_SA(1, 1), a1 + hstep, voffA);
            PG8_WAIT_V(8); PG8_WAIT_L(0); PG8_BAR; PG8_MMA(0, 0, At, B0); PG8_MMA(0, 1, At, B1); PG8_BAR; PG8_SCHED;
            PG8_LDA(At, 0, 1); PG8_STAGE(PG8_SB(0, 0), b2, voffB); PG8_STAGE(PG8_SB(0, 1), b2 + hstep, voffB); PG8_STAGE(PG8_SA(0, 0), a2, voffA);
            PG8_WAIT_V(8); PG8_WAIT_L(0); PG8_BAR; PG8_MMA(1, 0, At, B0); PG8_MMA(1, 1, At, B1); PG8_BAR; PG8_SCHED;
            PG8_LDB(B0, 1, 0); PG8_LDB(B1, 1, 1); PG8_SCHED; PG8_LDA(At, 1, 0); PG8_STAGE(PG8_SA(0, 1), a2 + hstep, voffA);
            PG8_WAIT_V(8); PG8_WAIT_L(0); PG8_BAR; PG8_MMA(0, 0, At, B0); PG8_MMA(0, 1, At, B1); PG8_BAR; PG8_SCHED;
            PG8_LDA(At, 1, 1); PG8_STAGE(PG8_SB(1, 0), b3, voffB); PG8_STAGE(PG8_SB(1, 1), b3 + hstep, voffB); PG8_STAGE(PG8_SA(1, 0), a3, voffA);
            PG8_WAIT_V(8); PG8_WAIT_L(0); PG8_BAR; PG8_MMA(1, 0, At, B0); PG8_MMA(1, 1, At, B1); PG8_BAR; PG8_SCHED;
            } else {
            PG8_LDB(B0, 0, 0); PG8_SCHED; PG8_LDA(At, 0, 0); PG8_STAGE(PG8_SA(1, 1), a1 + hstep, voffA);
            PG8_WAIT_L(8); PG8_BAR; PG8_WAIT_L(0); PG8_MMA(0, 0, At, B0); PG8_BAR; PG8_SCHED;
            PG8_LDB(B1, 0, 1); PG8_STAGE(PG8_SB(0, 0), b2, voffB);
            PG8_BAR; PG8_WAIT_L(0); PG8_MMA(0, 1, At, B1); PG8_BAR;
            PG8_LDA(At, 0, 1); PG8_STAGE(PG8_SA(0, 0), a2, voffA);
            PG8_BAR; PG8_WAIT_L(0); PG8_MMA(1, 0, At, B0); PG8_BAR; PG8_SCHED;
            PG8_STAGE(PG8_SB(0, 1), b2 + hstep, voffB);
            PG8_WAIT_V(6); PG8_BAR; PG8_MMA(1, 1, At, B1); PG8_BAR;
            PG8_LDB(B0, 1, 0); PG8_SCHED; PG8_LDA(At, 1, 0); PG8_STAGE(PG8_SA(0, 1), a2 + hstep, voffA);
            PG8_WAIT_L(8); PG8_BAR; PG8_WAIT_L(0); PG8_MMA(0, 0, At, B0); PG8_BAR; PG8_SCHED;
            PG8_LDB(B1, 1, 1); PG8_STAGE(PG8_SB(1, 0), b3, voffB);
            PG8_BAR; PG8_WAIT_L(0); PG8_MMA(0, 1, At, B1); PG8_BAR;
            PG8_LDA(At, 1, 1); PG8_STAGE(PG8_SA(1, 0), a3, voffA);
            PG8_BAR; PG8_WAIT_L(0); PG8_MMA(1, 0, At, B0); PG8_BAR; PG8_SCHED;
            PG8_STAGE(PG8_SB(1, 1), b3 + hstep, voffB);
            PG8_WAIT_V(6); PG8_BAR; PG8_MMA(1, 1, At, B1); PG8_BAR;
            }
        }
        if constexpr (ALIGN_EPI) { if (wr == 0) PG8_BAR; }
        if constexpr (!Epi::AFTER_DRAIN) { E(acc, cur, wr, wc, fr, fq); S.done(cur); }
        if (!has_next) break;
#pragma unroll
        for (int a = 0; a < 2; ++a)
#pragma unroll
            for (int b = 0; b < 2; ++b)
#pragma unroll
                for (int m = 0; m < 4; ++m)
#pragma unroll
                    for (int n = 0; n < 2; ++n) acc[a][b][m][n] = (f32x4){0.f, 0.f, 0.f, 0.f};
        cur = nxt; cA = nA; cB = nB; ++ui;
        if constexpr (ALIGN_EPI) { if (wr == 1) PG8_BAR; }
    }
    PG8_WAIT_V(0);
    if constexpr (!ALIGN_EPI) { if (wr == 0) PG8_BAR; }
    PG8_BAR;
    if constexpr (Epi::AFTER_DRAIN) { E.fused(acc, cur, wr, wc, fr, fq, lds, wid, lane); S.done(cur); }
#undef PG8_SA
#undef PG8_SB
#undef PG8_STAGE
#undef PG8_LDA
#undef PG8_LDB
#undef PG8_MMA
#undef PG8_WAIT_V
#undef PG8_WAIT_L
#undef PG8_BAR
#undef PG8_SCHED
}

}

constexpr int NWAVES = 8;
constexpr int RING_OFF = 0;
constexpr int TR_WAVE_BYTES = 64 * 65 * 4;
constexpr int SVEC_OFF = NWAVES * TR_WAVE_BYTES;
constexpr int LDSCTL_OFF = 147456 - 512, LDS_BYTES = 147456;
static_assert(SVEC_OFF + 3 * D * 4 <= LDSCTL_OFF, "LDS map");

#define RLX_AGENT __ATOMIC_RELAXED, __HIP_MEMORY_SCOPE_AGENT
#define XB_TMO      128
#define XB_XCNT(j)  (256  + 64 * (j))
#define XB_XSUB(j)  (1280 + 64 * (j))
#define XB_XGEN(j)  (2304 + 64 * (j))
#define XB_TOP      3328
#define XB_TOPGEN   3392
#define XCD_BAR_WORDS 3456
#define XB_SPIN_CAP (1u << 18)

__device__ __forceinline__ unsigned xb_ld(unsigned* p)              { return __hip_atomic_load(p, __ATOMIC_RELAXED, __HIP_MEMORY_SCOPE_AGENT); }
__device__ __forceinline__ unsigned xb_add(unsigned* p, unsigned v) { return __hip_atomic_fetch_add(p, v, __ATOMIC_RELAXED, __HIP_MEMORY_SCOPE_AGENT); }
__device__ __forceinline__ unsigned xb_xcc_id() { return (unsigned)__builtin_amdgcn_s_getreg((3 << 11) | 20) & 0xFu; }
#define XB_SPIN(cond, bar) do { unsigned _sp = 0; while (cond) { __builtin_amdgcn_s_sleep(1); \
    if ((++_sp & 255u) == 0u) { if (xb_ld(&(bar)[XB_TMO])) break; if (_sp > XB_SPIN_CAP) { atomicAdd(&(bar)[XB_TMO], 1u); break; } } } } while (0)

struct XcdBarrier {
    unsigned* bar; unsigned x;
    volatile LAS unsigned* st;
};

__device__ __forceinline__ XcdBarrier xcd_barrier_post(unsigned* bar, volatile LAS unsigned* st) {
    XcdBarrier b; b.bar = bar; b.x = xb_xcc_id(); b.st = st;
    if (threadIdx.x == 0) (void)xb_add(&bar[XB_XCNT(b.x)], 1u);
    return b;
}
__device__ __forceinline__ void xcd_barrier_complete(unsigned* bar, unsigned x, unsigned& nloc, unsigned& nx) {
    const unsigned G = gridDim.x * gridDim.y * gridDim.z;
    unsigned sum, cnt, mine, sp = 0u;
    for (;;) {
        sum = 0u; cnt = 0u; mine = 0u;
#pragma unroll
        for (unsigned j = 0; j < 16; ++j) { const unsigned c = xb_ld(&bar[XB_XCNT(j)]); sum += c; cnt += (c > 0u) ? 1u : 0u; mine = (j == x) ? c : mine; }
        if (sum == G) break;
        __builtin_amdgcn_s_sleep(1);
        if ((++sp & 255u) == 0u) { if (xb_ld(&bar[XB_TMO])) break; if (sp > XB_SPIN_CAP) { atomicAdd(&bar[XB_TMO], 1u); break; } }
    }
    nloc = mine > 0u ? mine : 1u; nx = cnt > 0u ? cnt : 1u;
}

__device__ __forceinline__ void xcd_barrier(const XcdBarrier& b) {
    asm volatile("s_waitcnt vmcnt(0)" ::: "memory");
    __syncthreads();
    if (threadIdx.x == 0) {
        unsigned* bar = b.bar;
        __builtin_amdgcn_s_waitcnt(0);
        unsigned nloc = b.st[0], nx = b.st[1];
        if (nloc == 0u) { xcd_barrier_complete(bar, b.x, nloc, nx); b.st[0] = nloc; b.st[1] = nx; }
        const unsigned old = xb_add(&bar[XB_XSUB(b.x)], 1u);
        const unsigned gen = old / nloc;
        if (old + 1u == (gen + 1u) * nloc) {
            __builtin_amdgcn_fence(__ATOMIC_RELEASE, "agent");
            asm volatile("s_waitcnt vmcnt(0)" ::: "memory");
            const unsigned og = xb_add(&bar[XB_TOP], 1u);
            const unsigned tg = og / nx;
            if (og + 1u == (tg + 1u) * nx) xb_add(&bar[XB_TOPGEN], 1u);
            else XB_SPIN(xb_ld(&bar[XB_TOPGEN]) == tg, bar);
            __builtin_amdgcn_fence(__ATOMIC_ACQUIRE, "agent");
            xb_add(&bar[XB_XGEN(b.x)], 1u);
            asm volatile("s_waitcnt vmcnt(0)" ::: "memory");
        } else {
            XB_SPIN(xb_ld(&bar[XB_XGEN(b.x)]) == gen, bar);
            __builtin_amdgcn_fence(__ATOMIC_ACQUIRE, "agent");
            asm volatile("s_waitcnt vmcnt(0)" ::: "memory");
        }
    }
    __syncthreads();
}


__device__ __forceinline__ float bperm(float v, int src) { return __builtin_bit_cast(float, __builtin_amdgcn_ds_bpermute(src << 2, __builtin_bit_cast(int, v))); }
__device__ __forceinline__ int bpermi(int v, int src) { return __builtin_amdgcn_ds_bpermute(src << 2, v); }
__device__ __forceinline__ float wsum(float v, int lane) {
#pragma unroll
    for (int o = 1; o < 64; o <<= 1) v += bperm(v, lane ^ o);
    return v;
}
struct Args { const float* in[28]; float* out; unsigned char* ws; int ph_lo, ph_hi, flags, bar_idx; };
typedef const __attribute__((address_space(4))) Args CArgs;
struct Frame {
    LAS unsigned char* lds; volatile LAS unsigned* MISC;
    unsigned* ctl; unsigned char* ws;
    int tid, lane, wave, vcu, G, bx; long zo;
};

__device__ __forceinline__ void tr_item(const float* src, int ld, int k0, int c0, bf16* dst, int Kd, int n0, bool qkperm, LAS float* scr, int lane) {
    const float* s = src + (size_t)k0 * ld + c0;
    const int kr = lane >> 4, nq = lane & 15;
#pragma unroll 4
    for (int i = 0; i < 16; ++i) { const int k = 4 * i + kr; const f32x4 v = *(const f32x4*)(s + (size_t)k * ld + 4 * nq);
        LAS float* d = scr + k * 65 + 4 * nq; d[0] = v[0]; d[1] = v[1]; d[2] = v[2]; d[3] = v[3]; }
    asm volatile("s_waitcnt lgkmcnt(0)" ::: "memory");
    const int c = lane & 7;
#pragma unroll
    for (int j = 0; j < 8; ++j) { const int n = (lane >> 3) + 8 * j; const int sc_ = qkperm ? ((n & 1) * 32 + (n >> 1)) : n; const LAS float* p = scr + (8 * c) * 65 + sc_;
        u32x4 o; o.x = pk2(p[0], p[65]); o.y = pk2(p[130], p[195]); o.z = pk2(p[260], p[325]); o.w = pk2(p[390], p[455]);
        *(u32x4*)(dst + (size_t)(n0 + n) * Kd + k0 + 8 * c) = o; }
    asm volatile("s_waitcnt lgkmcnt(0)" ::: "memory");
}
constexpr int TI_WIN = 4 * 16 * 88, TI_GT = 4 * 2 * 2 * 8 * 4, TI_WO = 4 * 3 * 256, TI_FGU = 2 * 16 * 88, TI_FD = 2 * 44 * 16, TI_EGU = 16 * 16 * 112, TI_ED = 16 * 56 * 16;
constexpr int TI_TOTAL = TI_WIN + TI_GT + TI_WO + TI_FGU + TI_FD + TI_EGU + TI_ED, MOD_ITEMS = 4 * 96;

__device__ __forceinline__ void ph_prologue(Frame& F, const Args& a) {
    LAS float* scr = (LAS float*)(F.lds + F.wave * TR_WAVE_BYTES);
    LAS float* sv = (LAS float*)(F.lds + SVEC_OFF);
    for (int i = F.tid; i < 3 * D; i += NWAVES * 64) { const int v = i >> 10, k = i & (D - 1); const float x = v < 2 ? (a.in[1] + F.zo)[v * D + k] : (a.in[3] + F.zo)[k]; sv[i] = x * fsigm(x); }
    __syncthreads();
    const int gw = F.vcu * NWAVES + F.wave, NGW = F.G * NWAVES, lane = F.lane;
    unsigned char* ws = F.ws;
    if (gw == NGW - 1) { f32x2* rt = (f32x2*)(ws + WS_ROPE);
        for (int e = lane; e < 128 * 32; e += 64) { const int pos = e >> 5, i = e & 31; const float ang = (float)pos * powf(10000.f, -(float)i / 32.f); rt[e] = (f32x2){cosf(ang), sinf(ang)}; } }
    for (int it = NGW - 2 - gw; it >= 0 && it < MOD_ITEMS; it += NGW) {
        const int l = it / 96, n = (it % 96) * 64 + lane;
        const float* w = (a.in[4] + F.zo) + (size_t)l * D * 6 * D + n;
        float a0 = 0.f, a1 = 0.f, a2 = 0.f;
#pragma unroll 8
        for (int k = 0; k < D; ++k) { const float wv = w[(size_t)k * 6 * D]; a0 += sv[k] * wv; a1 += sv[D + k] * wv; a2 += sv[2 * D + k] * wv; }
        const float b = (a.in[5] + F.zo)[l * 6 * D + n];
        float* o = (float*)(ws + WS_MOD) + (size_t)l * 18 * D + n;
        o[0] = a0 + b; o[6 * D] = a1 + b; o[12 * D] = a2 + b;
    }
    for (int i = gw * 64 + lane; i < DEPTH * 2 * D; i += NGW * 64) ((f32x4*)(ws + WS_SPT))[i] = (f32x4){(a.in[13] + F.zo)[i], (a.in[15] + F.zo)[i], -8.f * 1.4426950408889634f * log1pf(expf(-(a.in[16] + F.zo)[i])), 0.f};
    for (int it = gw; it < TI_TOTAL; it += NGW) {
        int r = it;
        if (r < TI_WIN) { const int l = r / (16 * 88), q = r % (16 * 88), kt = q / 88, nt = q % 88;
            tr_item((a.in[8] + F.zo) + (size_t)l * D * INC, INC, 64 * kt, 64 * nt, (bf16*)(ws + WS_WIN) + (size_t)l * INC * D, D, 64 * nt, nt < 20, scr, lane); continue; }
        r -= TI_WIN;
        if (r < TI_GT) { const int tl = r & 3, m = r >> 2, h = m & 7, gx = (m >> 3) & 1, d = (m >> 4) & 1, l = m >> 5;
            const float* src = (gx ? (a.in[14] + F.zo) : (a.in[12] + F.zo)) + (size_t)((l * 2 + d) * 8 + h) * 128 * 128;
            bf16* dst = (bf16*)(ws + WS_GT) + (size_t)((l * 8 + h) * 4 + 2 * d + gx) * 128 * 128;
            tr_item(src, 128, 64 * (tl >> 1), 64 * (tl & 1), dst, 128, 64 * (tl & 1), false, scr, lane); continue; }
        r -= TI_GT;
        if (r < TI_WO) { const int mi = r / 256, q = r % 256, kt = q / 16, nt = q % 16, l = mi / 3, w = mi % 3;
            const float* src = (w == 0 ? (a.in[17] + F.zo) : (w == 1 ? (a.in[18] + F.zo) : (a.in[19] + F.zo))) + (size_t)l * D * D;
            tr_item(src, D, 64 * kt, 64 * nt, (bf16*)(ws + WS_WO) + (size_t)mi * D * D, D, 64 * nt, false, scr, lane); continue; }
        r -= TI_WO;
        if (r < TI_FGU) { const int i = r / (16 * 88), q = r % (16 * 88), kt = q / 88, nt = q % 88;
            const int pn = nt >> 2, bj = (nt >> 1) & 1, hf = nt & 1;
            const float* src = (bj ? (a.in[21] + F.zo) : (a.in[20] + F.zo)) + (size_t)i * D * DFF;
            tr_item(src, DFF, 64 * kt, 128 * pn + 64 * hf, (bf16*)(ws + WS_FF + i * FF_STRIDE), D, 64 * nt, false, scr, lane); continue; }
        r -= TI_FGU;
        if (r < TI_FD) { const int i = r / (44 * 16), q = r % (44 * 16), kt = q / 16, nt = q % 16;
            tr_item((a.in[22] + F.zo) + (size_t)i * DFF * D, D, 64 * kt, 64 * nt, (bf16*)(ws + WS_FF + i * FF_STRIDE) + (size_t)2 * DFF * D, DFF, 64 * nt, false, scr, lane); continue; }
        r -= TI_FD;
        if (r < TI_EGU) { const int ie = r / (16 * 112), q = r % (16 * 112), kt = q / 112, nt = q % 112, i = ie >> 3, e = ie & 7;
            const int pn = nt >> 2, bj = (nt >> 1) & 1, hf = nt & 1;
            const float* src = (bj ? (a.in[25] + F.zo) : (a.in[24] + F.zo)) + (size_t)ie * D * DFE;
            tr_item(src, DFE, 64 * kt, 128 * pn + 64 * hf, (bf16*)(ws + WS_EXP + i * EXP_STRIDE) + (size_t)e * 2 * DFE * D, D, 64 * nt, false, scr, lane); continue; }
        r -= TI_EGU;
        { const int ie = r / (56 * 16), q = r % (56 * 16), kt = q / 16, nt = q % 16, i = ie >> 3, e = ie & 7;
            tr_item((a.in[26] + F.zo) + (size_t)ie * DFE * D, D, 64 * kt, 64 * nt, (bf16*)(ws + WS_EXP + i * EXP_STRIDE) + (size_t)NE * 2 * DFE * D + (size_t)e * D * DFE, DFE, 64 * nt, false, scr, lane); }
    }
}

template <int KIND> __device__ __forceinline__ void ph_rows(Frame& F, const Args& a, int l, bool combine) {
    const int gw = F.vcu * NWAVES + F.wave, NGW = F.G * NWAVES, lane = F.lane;
    unsigned char* ws = F.ws;
    float* H = (float*)(ws + WS_H); bf16* XN = (bf16*)(ws + WS_XN);
    const float* MOD = (const float*)(ws + WS_MOD);
    const bool moe = KIND == 1 && (l & 1);
    LAS float* wr_l = (LAS float*)(F.lds);
    LAS int* lcnt = (LAS int*)(F.lds + 32768);
    if (moe) {
        const float* wr = (a.in[23] + F.zo) + (size_t)(l >> 1) * D * NE;
        for (int i = F.tid; i < D * NE; i += NWAVES * 64) { const int k = i >> 3, e = i & 7; wr_l[e * D + k] = wr[i]; }
        if (F.tid < NE) lcnt[F.tid] = 0;
        __syncthreads();
    }
    const int nrows = (KIND == 2 || (KIND == 1 && l == DEPTH - 1)) ? ML : MT;
    const float* gvec = KIND == 0 ? (a.in[6] + F.zo) + l * D : (KIND == 1 ? (a.in[7] + F.zo) + l * D : (a.in[27] + F.zo));
    f32x4 g4[4];
#pragma unroll
    for (int j = 0; j < 4; ++j) g4[j] = *(const f32x4*)(gvec + 4 * lane + 256 * j);
    for (int m = gw; m < nrows; m += NGW) {
        const int vec = row_vec(m);
        const float* src = (KIND == 0 && l == 0) ? (m < ML ? (a.in[0] + F.zo) + (size_t)m * D : (a.in[2] + F.zo) + (size_t)(m - ML) * D) : H + (size_t)m * D;
        f32x4 v[4];
#pragma unroll
        for (int j = 0; j < 4; ++j) v[j] = *(const f32x4*)(src + 4 * lane + 256 * j);
        if (combine) {
            const int lp = KIND == 0 ? l - 1 : DEPTH - 1;
            const float* g2 = MOD + (size_t)lp * 18 * D + (size_t)vec * 6 * D + 5 * D;
            const int* tok_slot = (const int*)(ws + WS_TOKSLOT); const float* tw = (const float*)(ws + WS_TW);
            const int s0 = tok_slot[2 * m], s1 = tok_slot[2 * m + 1]; const float w0 = tw[2 * m], w1 = tw[2 * m + 1];
            const bf16* f0 = (const bf16*)(ws + WS_FS) + (size_t)s0 * D; const bf16* f1 = (const bf16*)(ws + WS_FS) + (size_t)s1 * D;
#pragma unroll
            for (int j = 0; j < 4; ++j) { const u32x2 p0 = *(const u32x2*)(f0 + 4 * lane + 256 * j), p1 = *(const u32x2*)(f1 + 4 * lane + 256 * j); const f32x4 gg = *(const f32x4*)(g2 + 4 * lane + 256 * j);
                v[j][0] += gg[0] * (w0 * bflo(p0.x) + w1 * bflo(p1.x)); v[j][1] += gg[1] * (w0 * bfhi(p0.x) + w1 * bfhi(p1.x));
                v[j][2] += gg[2] * (w0 * bflo(p0.y) + w1 * bflo(p1.y)); v[j][3] += gg[3] * (w0 * bfhi(p0.y) + w1 * bfhi(p1.y)); }
        }
        if (KIND != 2 && ((KIND == 0 && l == 0) || combine)) {
#pragma unroll
            for (int j = 0; j < 4; ++j) *(f32x4*)(H + (size_t)m * D + 4 * lane + 256 * j) = v[j];
        }
        float ss = 0.f;
#pragma unroll
        for (int j = 0; j < 4; ++j) ss += (v[j][0] * v[j][0] + v[j][1] * v[j][1]) + (v[j][2] * v[j][2] + v[j][3] * v[j][3]);
        ss = wsum(ss, lane);
        const float r = rsqrtf(ss * (1.f / D) + EPS);
        if (KIND == 2) {
#pragma unroll
            for (int j = 0; j < 4; ++j) *(f32x4*)((a.out + F.zo) + (size_t)m * D + 4 * lane + 256 * j) = v[j] * r * g4[j];
            continue;
        }
        const float* mv = MOD + (size_t)l * 18 * D + (size_t)vec * 6 * D + (KIND == 0 ? 0 : 3 * D);
        float lg[NE];
#pragma unroll
        for (int e = 0; e < NE; ++e) lg[e] = 0.f;
#pragma unroll
        for (int j = 0; j < 4; ++j) {
            const f32x4 sh = *(const f32x4*)(mv + 4 * lane + 256 * j), sc = *(const f32x4*)(mv + D + 4 * lane + 256 * j);
            const f32x4 y = (v[j] * r * g4[j]) * (sc + 1.f) + sh;
            u32x2 o; o.x = pk2(y[0], y[1]); o.y = pk2(y[2], y[3]);
            *(u32x2*)(XN + (size_t)m * D + 4 * lane + 256 * j) = o;
            if (moe) {
#pragma unroll
                for (int e = 0; e < NE; ++e) { const f32x4 w = *(const LAS f32x4*)(wr_l + e * D + 4 * lane + 256 * j); lg[e] += (y[0] * w[0] + y[1] * w[1]) + (y[2] * w[2] + y[3] * w[3]); }
            }
        }
        if (moe) {
#pragma unroll
            for (int e = 0; e < NE; ++e) lg[e] = wsum(lg[e], lane);
            int i0 = 0; float v0 = lg[0];
#pragma unroll
            for (int e = 1; e < NE; ++e) if (lg[e] > v0) { v0 = lg[e]; i0 = e; }
            int i1 = -1; float v1 = -INFINITY;
#pragma unroll
            for (int e = 0; e < NE; ++e) if (e != i0 && lg[e] > v1) { v1 = lg[e]; i1 = e; }
            if (lane == 0) {
                const float e1 = expf(v1 - v0), w0 = 1.f / (1.f + e1), w1 = e1 / (1.f + e1);
                int* te = (int*)(ws + WS_TE); float* tw = (float*)(ws + WS_TW);
                te[2 * m] = i0; te[2 * m + 1] = i1; tw[2 * m] = w0; tw[2 * m + 1] = w1;
                __hip_atomic_fetch_add(&lcnt[i0], 1, __ATOMIC_RELAXED, __HIP_MEMORY_SCOPE_WORKGROUP); __hip_atomic_fetch_add(&lcnt[i1], 1, __ATOMIC_RELAXED, __HIP_MEMORY_SCOPE_WORKGROUP);
            }
        }
    }
    if (moe) {
        __syncthreads();
        if (F.tid < NE) __hip_atomic_fetch_add(F.ctl + CW_CNT + 64 * (l >> 1) + F.tid, (unsigned)lcnt[F.tid], RLX_AGENT);
    }
}

__device__ __forceinline__ void ph_lists(Frame& F, int l) {
    const int gw = F.vcu * NWAVES + F.wave, NGW = F.G * NWAVES, lane = F.lane;
    unsigned char* ws = F.ws;
    const int nrows = l == DEPTH - 1 ? ML : MT;
    LAS int* lc = (LAS int*)(F.lds); LAS int* lb = lc + 8; LAS int* lc2 = lc + 16;
    const int* te = (const int*)(ws + WS_TE); int* tok_slot = (int*)(ws + WS_TOKSLOT); int* panel_e = (int*)(ws + WS_PANELE);
    const bf16* XN = (const bf16*)(ws + WS_XN); bf16* XS = (bf16*)(ws + WS_XS);
    int cnt[NE], off[NE + 1];
    { int o = 0;
#pragma unroll
      for (int e = 0; e < NE; ++e) { cnt[e] = (int)__hip_atomic_load(F.ctl + CW_CNT + 64 * (l >> 1) + e, RLX_AGENT); off[e] = o; o += (cnt[e] + 255) & ~255; }
      off[NE] = o; }
    if (F.tid < 24) lc[F.tid] = 0;
    __syncthreads();
    for (int m = gw; m < nrows; m += NGW) if (lane < 2) __hip_atomic_fetch_add(&lc[te[2 * m + lane]], 1, __ATOMIC_RELAXED, __HIP_MEMORY_SCOPE_WORKGROUP);
    __syncthreads();
    if (F.tid < NE) lb[F.tid] = (int)__hip_atomic_fetch_add(F.ctl + CW_CUR + 64 * (l >> 1) + F.tid, (unsigned)lc[F.tid], RLX_AGENT);
    __syncthreads();
    for (int m = gw; m < nrows; m += NGW) {
        int slot = 0;
        if (lane < 2) { const int e = te[2 * m + lane]; const int pos = lb[e] + __hip_atomic_fetch_add(&lc2[e], 1, __ATOMIC_RELAXED, __HIP_MEMORY_SCOPE_WORKGROUP); int o = 0;
#pragma unroll
            for (int x = 0; x < NE; ++x) o = (x == e) ? off[x] : o;
            slot = o + pos; tok_slot[2 * m + lane] = slot; }
        const int s0 = bpermi(slot, 0), s1 = bpermi(slot, 1);
        const u32x4* src = (const u32x4*)(XN + (size_t)m * D);
        const u32x4 r0 = src[lane], r1 = src[lane + 64];
        u32x4* d0 = (u32x4*)(XS + (size_t)s0 * D); u32x4* d1 = (u32x4*)(XS + (size_t)s1 * D);
        d0[lane] = r0; d0[lane + 64] = r1; d1[lane] = r0; d1[lane + 64] = r1;
    }
#pragma unroll
    for (int e = 0; e < NE; ++e) { const int base = off[e] + cnt[e], npad = off[e + 1] - base;
        for (int i = gw; i < npad; i += NGW) { u32x4* d = (u32x4*)(XS + (size_t)(base + i) * D); d[lane] = (u32x4){0u, 0u, 0u, 0u}; d[lane + 64] = (u32x4){0u, 0u, 0u, 0u}; } }
    if (F.bx == 0) { for (int p = F.tid; p < 256; p += NWAVES * 64) { int e = 0;
#pragma unroll
            for (int x = 1; x < NE; ++x) if (p * 256 >= off[x]) e = x;
            panel_e[p] = e; }
        if (F.tid == 0) panel_e[256] = off[NE] / 256; }
}

constexpr int AT_K = 0, AT_KSTR = 272, AT_V = 64 * AT_KSTR, AT_VSTR = 144, AT_BUF = 64 * 272 + 128 * 144;
__device__ __forceinline__ void attn_unit(Frame& F, const float* sinkl, int unit) {
    const int tid = F.tid, lane = F.lane, w = F.wave, l31 = lane & 31, h5 = lane >> 5;
    const bf16* P = (const bf16*)(F.ws + WS_P); bf16* ATT = (bf16*)(F.ws + WS_ATT);
    LAS unsigned char* lds = F.lds;
    const bool lat = unit < 512;
    int b, kvh, t0;
    if (lat) { b = unit >> 8; kvh = (unit >> 7) & 1; t0 = (unit & 127) * 64; } else { const int u = unit - 512; b = u >> 3; kvh = (u >> 2) & 1; t0 = (u & 3) * 64; }
    const int hh = kvh * 4 + (w >> 1), qlo = t0 + 32 * (w & 1), qt = qlo + l31;
    const size_t mq = lat ? (size_t)b * SEQ + qt : (size_t)ML + b * CTX + qt;
    bf16x8 qf[8];
    { const bf16* qp = P + mq * INC + OFF_Q + hh * HD + 8 * h5;
#pragma unroll
      for (int kk = 0; kk < 8; ++kk) qf[kk] = *(const bf16x8*)(qp + 16 * kk); }
    f32x16 o[4];
#pragma unroll
    for (int dt = 0; dt < 4; ++dt)
#pragma unroll
        for (int r = 0; r < 16; ++r) o[dt][r] = 0.f;
    const float c2 = 0.08838834764831845f * 1.4426950408889634f;
    float mrun = sinkl[hh] * 1.4426950408889634f, lrun = h5 == 0 ? 1.f : 0.f;
    const int ti_lo = lat ? (t0 >= 128 ? 0 : (128 - t0) >> 6) : 0, ti_hi = lat ? ((SEQ + 128 - t0) >> 6 < 5 ? (SEQ + 128 - t0) >> 6 : 5) : 0;
    const int nl = ti_hi - ti_lo, ntiles = nl + 4;
    u32x4 kreg[2], vreg[2];
#define AT_LOAD(n) do { const int ti_ = (n) < nl ? ti_lo + (n) : (n) - nl; const bool il_ = (n) < nl; const int ks_ = il_ ? t0 - 128 + 64 * ti_ : 64 * ti_; \
        const size_t kr_ = il_ ? (size_t)b * SEQ + ks_ : (size_t)ML + b * CTX + ks_; \
        _Pragma("unroll") for (int p = 0; p < 2; ++p) { const int idx = tid + 512 * p; \
            kreg[p] = *(const u32x4*)(P + (kr_ + (idx >> 4)) * INC + OFF_K + kvh * HD + 8 * (idx & 15)); \
            vreg[p] = *(const u32x4*)(P + (kr_ + (idx & 63)) * INC + OFF_V + kvh * HD + 8 * (idx >> 6)); } } while (0)
#define AT_STORE(bufo) do { _Pragma("unroll") for (int p = 0; p < 2; ++p) { const int idx = tid + 512 * p; \
            *(LAS u32x4*)(lds + (bufo) + AT_K + (idx >> 4) * AT_KSTR + (idx & 15) * 16) = kreg[p]; \
            const int key = idx & 63, c = idx >> 6; const int pos = (key & 0x33) | ((key & 4) << 1) | ((key & 8) >> 1); const u32x4 v = vreg[p]; \
            LAS unsigned char* d = lds + (bufo) + AT_V + (8 * c) * AT_VSTR + 2 * pos; \
            *(LAS unsigned short*)(d + 0 * AT_VSTR) = (unsigned short)(v.x & 0xffff); *(LAS unsigned short*)(d + 1 * AT_VSTR) = (unsigned short)(v.x >> 16); \
            *(LAS unsigned short*)(d + 2 * AT_VSTR) = (unsigned short)(v.y & 0xffff); *(LAS unsigned short*)(d + 3 * AT_VSTR) = (unsigned short)(v.y >> 16); \
            *(LAS unsigned short*)(d + 4 * AT_VSTR) = (unsigned short)(v.z & 0xffff); *(LAS unsigned short*)(d + 5 * AT_VSTR) = (unsigned short)(v.z >> 16); \
            *(LAS unsigned short*)(d + 6 * AT_VSTR) = (unsigned short)(v.w & 0xffff); *(LAS unsigned short*)(d + 7 * AT_VSTR) = (unsigned short)(v.w >> 16); } } while (0)
    __syncthreads();
    AT_LOAD(0); AT_STORE(0); AT_LOAD(1);
    for (int n = 0; n < ntiles; ++n) {
        const int ti = n < nl ? ti_lo + n : n - nl; const bool islat = n < nl; const int ks = islat ? t0 - 128 + 64 * ti : 64 * ti;
        const int bo = (n & 1) * AT_BUF;
        __syncthreads();
        if (n + 1 < ntiles) { AT_STORE(AT_BUF - bo); if (n + 2 < ntiles) AT_LOAD(n + 2); }
        f32x16 s0, s1;
#pragma unroll
        for (int r = 0; r < 16; ++r) { s0[r] = 0.f; s1[r] = 0.f; }
#pragma unroll
        for (int kk = 0; kk < 8; ++kk) {
            const bf16x8 k0 = *(const LAS bf16x8*)(lds + bo + AT_K + l31 * AT_KSTR + (16 * kk + 8 * h5) * 2);
            const bf16x8 k1 = *(const LAS bf16x8*)(lds + bo + AT_K + (32 + l31) * AT_KSTR + (16 * kk + 8 * h5) * 2);
            s0 = __builtin_amdgcn_mfma_f32_32x32x16_bf16(k0, qf[kk], s0, 0, 0, 0);
            s1 = __builtin_amdgcn_mfma_f32_32x32x16_bf16(k1, qf[kk], s1, 0, 0, 0);
        }
        const bool need_mask = islat && ((ks + 63 - qlo > WIN) || (qlo + 31 - ks > WIN));
        float mt = -INFINITY;
#pragma unroll
        for (int r = 0; r < 16; ++r) {
            float a0 = s0[r] * c2, a1 = s1[r] * c2;
            if (need_mask) { const int kp = ks + (r & 3) + 8 * (r >> 2) + 4 * h5; const int d0 = kp - qt, d1 = kp + 32 - qt;
                if (d0 > WIN || d0 < -WIN) a0 = -INFINITY; if (d1 > WIN || d1 < -WIN) a1 = -INFINITY; }
            s0[r] = a0; s1[r] = a1; mt = fmaxf(mt, fmaxf(a0, a1));
        }
        mt = fmaxf(mt, bperm(mt, lane ^ 32));
        const float mnew = fmaxf(mrun, mt), alpha = __builtin_amdgcn_exp2f(mrun - mnew);
        float psum = 0.f;
#pragma unroll
        for (int r = 0; r < 16; ++r) { s0[r] = __builtin_amdgcn_exp2f(s0[r] - mnew); s1[r] = __builtin_amdgcn_exp2f(s1[r] - mnew); psum += s0[r] + s1[r]; }
        lrun = lrun * alpha + psum; mrun = mnew;
#pragma unroll
        for (int dt = 0; dt < 4; ++dt)
#pragma unroll
            for (int r = 0; r < 16; ++r) o[dt][r] *= alpha;
        bf16x8 pf[4];
#pragma unroll
        for (int s = 0; s < 2; ++s) {
            u32x4 x0, x1;
            x0.x = pk2(s0[8 * s + 0], s0[8 * s + 1]); x0.y = pk2(s0[8 * s + 2], s0[8 * s + 3]); x0.z = pk2(s0[8 * s + 4], s0[8 * s + 5]); x0.w = pk2(s0[8 * s + 6], s0[8 * s + 7]);
            x1.x = pk2(s1[8 * s + 0], s1[8 * s + 1]); x1.y = pk2(s1[8 * s + 2], s1[8 * s + 3]); x1.z = pk2(s1[8 * s + 4], s1[8 * s + 5]); x1.w = pk2(s1[8 * s + 6], s1[8 * s + 7]);
            pf[s] = __builtin_bit_cast(bf16x8, x0); pf[2 + s] = __builtin_bit_cast(bf16x8, x1);
        }
#pragma unroll
        for (int dt = 0; dt < 4; ++dt)
#pragma unroll
            for (int ss = 0; ss < 4; ++ss) {
                const bf16x8 vf = *(const LAS bf16x8*)(lds + bo + AT_V + (32 * dt + l31) * AT_VSTR + (16 * ss + 8 * h5) * 2);
                o[dt] = __builtin_amdgcn_mfma_f32_32x32x16_bf16(vf, pf[ss], o[dt], 0, 0, 0);
            }
    }
#undef AT_LOAD
#undef AT_STORE
    const float ltot = lrun + bperm(lrun, lane ^ 32), inv = 1.f / ltot;
    bf16* op = ATT + mq * D + hh * HD + 4 * h5;
#pragma unroll
    for (int dt = 0; dt < 4; ++dt)
#pragma unroll
        for (int rg = 0; rg < 4; ++rg) { u32x2 wv; wv.x = pk2(o[dt][4 * rg] * inv, o[dt][4 * rg + 1] * inv); wv.y = pk2(o[dt][4 * rg + 2] * inv, o[dt][4 * rg + 3] * inv);
            *(u32x2*)(op + 32 * dt + 8 * rg) = wv; }
}

constexpr int SC_X = 0, SC_Y = 17408, SC_O = 34816, SC_STR = 272;
__device__ __forceinline__ int sc_rho(int t) { return (t & 3) | (((t >> 4) & 3) << 2) | (((t >> 2) & 3) << 4); }
struct ScanPref { u32x4 x[2][4]; u32x4 y[2]; };
template <int PASS> __device__ __forceinline__ void scan_prefetch(ScanPref& pf, const bf16* P, int c, int h, int tid) {
    const int m0 = 64 * c, ch8 = tid & 15, cb = 128 * h + 8 * ch8;
    int seq_lo, seq_hi;
    if (c < 256) { seq_lo = (c >> 7) * SEQ; seq_hi = seq_lo + SEQ; } else { seq_lo = ML + ((c - 256) >> 2) * CTX; seq_hi = seq_lo + CTX; }
#pragma unroll
    for (int i = 0; i < 2; ++i) { const int t = (tid >> 4) + 32 * i;
#pragma unroll
        for (int j = 0; j < 4; ++j) { const int mr = m0 + t + j - 2; pf.x[i][j] = (u32x4){0u, 0u, 0u, 0u};
            if (mr >= seq_lo && mr < seq_hi) pf.x[i][j] = *(const u32x4*)(P + (size_t)mr * INC + OFF_X + cb); }
        if (PASS == 2) pf.y[i] = *(const u32x4*)(P + (size_t)(m0 + t) * INC + OFF_Y + cb); }
}
__device__ __forceinline__ void scan_unit(Frame& F, const Args& a, int l, int c, int cn, int h, ScanPref& pf) {
    const int tid = F.tid, lane = F.lane, w = F.wave, l15 = lane & 15, g = lane >> 4;
    unsigned char* ws = F.ws; LAS unsigned char* lds = F.lds;
    const bf16* P = (const bf16*)(ws + WS_P);
    asm volatile("s_waitcnt vmcnt(0)" : "+v"(pf.x[0][0]), "+v"(pf.x[0][1]), "+v"(pf.x[0][2]), "+v"(pf.x[0][3]), "+v"(pf.x[1][0]), "+v"(pf.x[1][1]), "+v"(pf.x[1][2]), "+v"(pf.x[1][3]), "+v"(pf.y[0]), "+v"(pf.y[1]) :: "memory");
    const int chl = 16 * w + l15, ch = 128 * h + chl;
    const f32x4* SPT = (const f32x4*)(ws + WS_SPT);
    const f32x4 prm0 = SPT[((size_t)l * 2 + 0) * D + ch], prm1 = SPT[((size_t)l * 2 + 1) * D + ch];
    bf16x8 bfr[4][4];
    { const bf16* Wt = (const bf16*)(ws + WS_GT) + (size_t)(l * 8 + h) * 4 * 128 * 128 + (size_t)(16 * w + l15) * 128 + 8 * g;
#pragma unroll
      for (int kk = 0; kk < 4; ++kk)
#pragma unroll
        for (int gt = 0; gt < 4; ++gt) bfr[kk][gt] = *(const bf16x8*)(Wt + gt * 128 * 128 + 32 * kk); }
    {
        const int ch8 = tid & 15; const int cb = 128 * h + 8 * ch8;
        const float* cw = (a.in[10] + F.zo) + (size_t)l * 4 * D + cb; const float* cbp = (a.in[11] + F.zo) + l * D + cb;
        f32x4 w4[4][2];
#pragma unroll
        for (int j = 0; j < 4; ++j) { w4[j][0] = *(const f32x4*)(cw + j * D); w4[j][1] = *(const f32x4*)(cw + j * D + 4); }
        const f32x4 b0 = *(const f32x4*)(cbp), b1 = *(const f32x4*)(cbp + 4);
#pragma unroll
        for (int i = 0; i < 2; ++i) { const int t = (tid >> 4) + 32 * i, row = sc_rho(t);
            f32x4 a0 = b0, a1 = b1;
#pragma unroll
            for (int j = 0; j < 4; ++j) { const u32x4 xv = pf.x[i][j];
                a0[0] += bflo(xv.x) * w4[j][0][0]; a0[1] += bfhi(xv.x) * w4[j][0][1]; a0[2] += bflo(xv.y) * w4[j][0][2]; a0[3] += bfhi(xv.y) * w4[j][0][3];
                a1[0] += bflo(xv.z) * w4[j][1][0]; a1[1] += bfhi(xv.z) * w4[j][1][1]; a1[2] += bflo(xv.w) * w4[j][1][2]; a1[3] += bfhi(xv.w) * w4[j][1][3]; }
            u32x4 o; o.x = pk2(a0[0], a0[1]); o.y = pk2(a0[2], a0[3]); o.z = pk2(a1[0], a1[1]); o.w = pk2(a1[2], a1[3]);
            *(LAS u32x4*)(lds + SC_X + row * SC_STR + ch8 * 16) = o;
            *(LAS u32x4*)(lds + SC_Y + row * SC_STR + ch8 * 16) = pf.y[i];
        }
    }
    __syncthreads();
    if (cn >= 0) scan_prefetch<2>(pf, P, cn, h, tid);
    f32x4 acc[4][4];
#pragma unroll
    for (int mt = 0; mt < 4; ++mt)
#pragma unroll
        for (int gt = 0; gt < 4; ++gt) acc[mt][gt] = (f32x4){0.f, 0.f, 0.f, 0.f};
#pragma unroll
    for (int kk = 0; kk < 4; ++kk) {
#pragma unroll
        for (int mt = 0; mt < 4; ++mt) { const bf16x8 af = *(const LAS bf16x8*)(lds + SC_X + (16 * mt + l15) * SC_STR + (32 * kk + 8 * g) * 2);
#pragma unroll
            for (int gt = 0; gt < 4; ++gt) acc[mt][gt] = __builtin_amdgcn_mfma_f32_16x16x32_bf16(af, bfr[kk][gt], acc[mt][gt], 0, 0, 0); }
    }
    float xv[16], yv[16];
#pragma unroll
    for (int k = 0; k < 16; ++k) { const int row = 16 * (k >> 2) + 4 * g + (k & 3);
        xv[k] = bf2f(*(const LAS bf16*)(lds + SC_X + row * SC_STR + chl * 2)); yv[k] = bf2f(*(const LAS bf16*)(lds + SC_Y + row * SC_STR + chl * 2)); }
    float* AGG_A = (float*)(ws + WS_AGG); float* AGG_B = (float*)(ws + WS_AGG + AGG_BYTES);
    u32x4* blk = (u32x4*)(ws + WS_SCAB) + ((size_t)((c * 8 + h) * 8 + w) * 10) * 64 + lane;
    { u32x4 y0, y1; y0.x = pk2(yv[0], yv[1]); y0.y = pk2(yv[2], yv[3]); y0.z = pk2(yv[4], yv[5]); y0.w = pk2(yv[6], yv[7]);
      y1.x = pk2(yv[8], yv[9]); y1.y = pk2(yv[10], yv[11]); y1.z = pk2(yv[12], yv[13]); y1.w = pk2(yv[14], yv[15]); blk[8 * 64] = y0; blk[9 * 64] = y1; }
#pragma unroll
    for (int d = 0; d < 2; ++d) {
        const f32x4 prm = d == 0 ? prm0 : prm1;
        float av[16], bv[16];
#pragma unroll
        for (int k = 0; k < 16; ++k) {
            const float rg = fsigm(acc[k >> 2][2 * d][k & 3] + prm[0]), ig = fsigm(acc[k >> 2][2 * d + 1][k & 3] + prm[1]);
            const float aa = __builtin_amdgcn_exp2f(prm[2] * rg);
            const unsigned pq = pk2(1.f - aa, __builtin_amdgcn_sqrtf(fmaxf(1.f - aa * aa, 0.f)) * (ig * xv[k]));
            av[k] = 1.f - bflo(pq); bv[k] = bfhi(pq);
        }
#pragma unroll
        for (int hf = 0; hf < 2; ++hf) { u32x4 pa, pb;
            pa.x = pk2(1.f - av[8 * hf + 0], 1.f - av[8 * hf + 1]); pa.y = pk2(1.f - av[8 * hf + 2], 1.f - av[8 * hf + 3]); pa.z = pk2(1.f - av[8 * hf + 4], 1.f - av[8 * hf + 5]); pa.w = pk2(1.f - av[8 * hf + 6], 1.f - av[8 * hf + 7]);
            pb.x = pk2(bv[8 * hf + 0], bv[8 * hf + 1]); pb.y = pk2(bv[8 * hf + 2], bv[8 * hf + 3]); pb.z = pk2(bv[8 * hf + 4], bv[8 * hf + 5]); pb.w = pk2(bv[8 * hf + 6], bv[8 * hf + 7]);
            blk[(4 * d + hf) * 64] = pa; blk[(4 * d + 2 + hf) * 64] = pb; }
        const size_t ao = ((size_t)d * NCHUNK + c) * D + ch;
        float As = 1.f, Bs = 0.f;
#pragma unroll
        for (int i = 0; i < 16; ++i) { const int k = d == 0 ? i : 15 - i; Bs = av[k] * Bs + bv[k]; As = av[k] * As; }
        const int gi = d == 0 ? g : 3 - g;
        const int p1 = (d == 0 ? lane - 16 : lane + 16) & 63, p2 = (d == 0 ? lane - 32 : lane + 32) & 63;
        float Ai = As, Bi = Bs;
        { const float A1 = bperm(Ai, p1), B1 = bperm(Bi, p1); if (gi >= 1) { Bi = Ai * B1 + Bi; Ai = Ai * A1; } }
        { const float A2 = bperm(Ai, p2), B2 = bperm(Bi, p2); if (gi >= 2) { Bi = Ai * B2 + Bi; Ai = Ai * A2; } }
        if (gi == 3) { AGG_A[ao] = Ai; AGG_B[ao] = Bi; }
    }
    __syncthreads();
}
__device__ __forceinline__ void ph_scan1(Frame& F, const Args& a, int l) {
    const int h = F.vcu & 7, cs = F.G >> 3; int c = F.vcu >> 3;
    if (c >= NCHUNK) return;
    ScanPref pf; scan_prefetch<2>(pf, (const bf16*)(F.ws + WS_P), c, h, F.tid);
    for (; c < NCHUNK; c += cs) { const int cn = c + cs < NCHUNK ? c + cs : -1; scan_unit(F, a, l, c, cn, h, pf); }
}
__device__ __forceinline__ void ph_scan2(Frame& F) {
    const int tid = F.tid, lane = F.lane, w = F.wave, l15 = lane & 15, g = lane >> 4;
    unsigned char* ws = F.ws; LAS unsigned char* lds = F.lds;
    const int h = F.vcu & 7, cs = F.G >> 3; const int chl = 16 * w + l15, ch = 128 * h + chl;
    const float* CARRY = (const float*)(ws + WS_AGG + 2 * AGG_BYTES); bf16* RECG = (bf16*)(ws + WS_RECG);
    int par = 0;
    for (int c = F.vcu >> 3; c < NCHUNK; c += cs, par ^= 1) {
        const u32x4* blk = (const u32x4*)(ws + WS_SCAB) + ((size_t)((c * 8 + h) * 8 + w) * 10) * 64 + lane;
        u32x4 q[10];
#pragma unroll
        for (int k = 0; k < 10; ++k) q[k] = blk[k * 64];
        const float cin0 = CARRY[((size_t)0 * NCHUNK + c) * D + ch], cin1 = CARRY[((size_t)1 * NCHUNK + c) * D + ch];
        float hs[16];
#pragma unroll
        for (int d = 0; d < 2; ++d) {
            float av[16], bv[16];
#pragma unroll
            for (int hf = 0; hf < 2; ++hf) { const u32x4 pa = q[4 * d + hf], pb = q[4 * d + 2 + hf];
                av[8 * hf + 0] = 1.f - bflo(pa.x); av[8 * hf + 1] = 1.f - bfhi(pa.x); av[8 * hf + 2] = 1.f - bflo(pa.y); av[8 * hf + 3] = 1.f - bfhi(pa.y);
                av[8 * hf + 4] = 1.f - bflo(pa.z); av[8 * hf + 5] = 1.f - bfhi(pa.z); av[8 * hf + 6] = 1.f - bflo(pa.w); av[8 * hf + 7] = 1.f - bfhi(pa.w);
                bv[8 * hf + 0] = bflo(pb.x); bv[8 * hf + 1] = bfhi(pb.x); bv[8 * hf + 2] = bflo(pb.y); bv[8 * hf + 3] = bfhi(pb.y);
                bv[8 * hf + 4] = bflo(pb.z); bv[8 * hf + 5] = bfhi(pb.z); bv[8 * hf + 6] = bflo(pb.w); bv[8 * hf + 7] = bfhi(pb.w); }
            float As = 1.f, Bs = 0.f;
#pragma unroll
            for (int i = 0; i < 16; ++i) { const int k = d == 0 ? i : 15 - i; Bs = av[k] * Bs + bv[k]; As = av[k] * As; }
            const int gi = d == 0 ? g : 3 - g;
            const int p1 = (d == 0 ? lane - 16 : lane + 16) & 63, p2 = (d == 0 ? lane - 32 : lane + 32) & 63;
            float Ai = As, Bi = Bs;
            { const float A1 = bperm(Ai, p1), B1 = bperm(Bi, p1); if (gi >= 1) { Bi = Ai * B1 + Bi; Ai = Ai * A1; } }
            { const float A2 = bperm(Ai, p2), B2 = bperm(Bi, p2); if (gi >= 2) { Bi = Ai * B2 + Bi; Ai = Ai * A2; } }
            float Ae = bperm(Ai, p1), Be = bperm(Bi, p1); if (gi == 0) { Ae = 1.f; Be = 0.f; }
            float hc = Ae * (d == 0 ? cin0 : cin1) + Be;
#pragma unroll
            for (int i = 0; i < 16; ++i) { const int k = d == 0 ? i : 15 - i; hc = av[k] * hc + bv[k]; hs[k] = d == 0 ? hc : hs[k] + hc; }
        }
        LAS unsigned char* ot = lds + par * 17408;
        { const u32x4 y0 = q[8], y1 = q[9];
          const float yv[16] = {bflo(y0.x), bfhi(y0.x), bflo(y0.y), bfhi(y0.y), bflo(y0.z), bfhi(y0.z), bflo(y0.w), bfhi(y0.w), bflo(y1.x), bfhi(y1.x), bflo(y1.y), bfhi(y1.y), bflo(y1.z), bfhi(y1.z), bflo(y1.w), bfhi(y1.w)};
#pragma unroll
          for (int k = 0; k < 16; ++k) *(LAS bf16*)(ot + (16 * g + k) * SC_STR + chl * 2) = f2bf(hs[k] * yv[k]); }
        __syncthreads();
#pragma unroll
        for (int i = 0; i < 2; ++i) { const int t = (tid >> 4) + 32 * i, ch8 = tid & 15;
            *(u32x4*)(RECG + (size_t)(64 * c + t) * D + 128 * h + 8 * ch8) = *(const LAS u32x4*)(ot + t * SC_STR + ch8 * 16); }
    }
}
__device__ __forceinline__ void ph_carry(Frame& F) {
    const int gw = F.vcu * NWAVES + F.wave;
    if (gw >= 64) return;
    const int idx = gw * 64 + F.lane, ch = idx & (D - 1), b = (idx >> 10) & 1, d = idx >> 11;
    const float* AGG_A = (const float*)(F.ws + WS_AGG) + (size_t)d * NCHUNK * D + ch; const float* AGG_B = (const float*)(F.ws + WS_AGG + AGG_BYTES) + (size_t)d * NCHUNK * D + ch;
    float* CARRY = (float*)(F.ws + WS_AGG + 2 * AGG_BYTES) + (size_t)d * NCHUNK * D + ch;
    float hcur = 0.f;
    {   float A[4], B[4];
#pragma unroll
        for (int i = 0; i < 4; ++i) { const int c = 256 + 4 * b + (d == 0 ? i : 3 - i); A[i] = AGG_A[(size_t)c * D]; B[i] = AGG_B[(size_t)c * D]; }
#pragma unroll
        for (int i = 0; i < 4; ++i) { const int c = 256 + 4 * b + (d == 0 ? i : 3 - i); CARRY[(size_t)c * D] = hcur; hcur = A[i] * hcur + B[i]; }
    }
    for (int i0 = 0; i0 < 128; i0 += 16) {
        float A[16], B[16];
#pragma unroll
        for (int i = 0; i < 16; ++i) { const int c = 128 * b + (d == 0 ? i0 + i : 127 - i0 - i); A[i] = AGG_A[(size_t)c * D]; B[i] = AGG_B[(size_t)c * D]; }
#pragma unroll
        for (int i = 0; i < 16; ++i) { const int c = 128 * b + (d == 0 ? i0 + i : 127 - i0 - i); CARRY[(size_t)c * D] = hcur; hcur = A[i] * hcur + B[i]; }
    }
}

__global__ void __launch_bounds__(NWAVES * 64, 2) mk_fwd(Args args) {
    extern __shared__ __attribute__((aligned(16))) unsigned char lds_raw[];
    Frame F;
    F.lds = (LAS unsigned char*)lds_raw;
    F.MISC = (volatile LAS unsigned*)(F.lds + LDSCTL_OFF);
    F.tid = threadIdx.x; F.lane = F.tid & 63; F.wave = __builtin_amdgcn_readfirstlane(F.tid >> 6);
    F.G = gridDim.x; F.bx = blockIdx.x; F.vcu = 0;
    F.ws = args.ws; F.zo = 0; F.ctl = (unsigned*)(args.ws + WS_CTL);
    for (int u = F.tid; u < (LDS_BYTES - LDSCTL_OFF) / 4; u += NWAVES * 64) ((LAS unsigned*)(F.lds + LDSCTL_OFF))[u] = 0u;
    __syncthreads();
    const int lo = args.ph_lo, hi = args.ph_hi;
    const bool multi = hi - lo > 1;
    unsigned* barw = F.ctl + CW_BAR + args.bar_idx * XCD_BAR_WORDS;
    XcdBarrier bar; bar.bar = barw; bar.x = 0; bar.st = nullptr;
    if (multi) bar = xcd_barrier_post(barw, F.MISC + 8);
#ifndef PH_MASK
#define PH_MASK 0xffff
#endif
#define SITE(s) ((PH_MASK >> (s)) & 1)
#ifndef DUP_MASK
#define DUP_MASK 0
#endif
#define REPS(s) for (int rep_ = 0; rep_ < (((DUP_MASK >> (s)) & 1) ? 2 : 1); ++rep_)
#define IN(k) (lo <= (k) && (k) < hi)
#define REFRESH() do { long zo_ = 0; int t_ = threadIdx.x, z_ = 0; asm volatile("" : "+s"(zo_), "+v"(t_), "+s"(z_)); \
    ws = args.ws + zo_; F.ws = ws; F.zo = zo_; F.ctl = (unsigned*)(ws + WS_CTL); F.tid = t_; F.lane = t_ & 63; F.wave = __builtin_amdgcn_readfirstlane(t_ >> 6); \
    F.lds = (LAS unsigned char*)lds_raw + z_; ring = F.lds + RING_OFF; \
    int bx_ = blockIdx.x, g_ = gridDim.x; asm volatile("" : "+s"(bx_), "+s"(g_)); F.bx = bx_; F.G = g_; F.vcu = (g_ % 8 == 0) ? (bx_ % 8) * (g_ / 8) + bx_ / 8 : bx_; } while (0)
#define SEAM(k) do { if (IN(k) && IN((k) + 1)) { XcdBarrier b_ = bar; unsigned* p_ = b_.bar; unsigned x_ = b_.x; asm volatile("" : "+s"(p_), "+s"(x_)); b_.bar = p_; b_.x = x_; xcd_barrier(b_); } } while (0)
    unsigned char* ws = args.ws;
    LAS unsigned char* ring = F.lds + RING_OFF;

    if (SITE(0) && IN(0)) { REFRESH(); REPS(0) { ph_prologue(F, args); } SEAM(0); }
    for (int l = 0; l < DEPTH; ++l) {
        const int pb = 1 + 11 * l;
        const bool moe = l & 1, last = l == DEPTH - 1;
        const int Mrows = last ? ML : MT;
        if (SITE(1) && IN(pb + 0)) { REFRESH(); ph_rows<0>(F, args, l, (args.flags & 4) && l > 0 && ((l - 1) & 1)); SEAM(pb + 0); }
        if (SITE(2) && IN(pb + 1)) { REFRESH(); REPS(2) {
            pg8::Gemm g{(const bf16*)(ws + WS_XN), (const bf16*)(ws + WS_WIN) + (size_t)l * INC * D, MT, INC, D}; pg8::StaticOrder S; S.init(MT, INC, F.G, F.bx);
            pg8::EpiInProj E{(bf16*)(ws + WS_P), (const f32x4*)(ws + WS_ROPE)};
            pg8::gemm_phase<pg8::EpiInProj, pg8::StaticOrder, true, true>(ring, g, S, E);
            } SEAM(pb + 1);
        }
        if (SITE(3) && IN(pb + 2)) { REFRESH(); REPS(3) {
            const int fl = args.flags & 3;
            if (fl == 0 || (fl & 1)) { for (int u = F.vcu; u < 528; u += F.G) attn_unit(F, args.in[9] + F.zo + l * NH, u); __syncthreads(); }
            if (fl == 0 || (fl & 2)) { ph_scan1(F, args, l); }
            } SEAM(pb + 2);
        }
        if (SITE(4) && IN(pb + 3)) { REFRESH(); REPS(4) { ph_carry(F); } SEAM(pb + 3); }
        if (SITE(5) && IN(pb + 4)) { REFRESH(); REPS(5) { ph_scan2(F); } SEAM(pb + 4); }
        if (SITE(6) && IN(pb + 5)) { REFRESH(); REPS(6) {
            const bf16* WO = (const bf16*)(ws + WS_WO) + (size_t)l * 3 * D * D;
            pg8::StaticOrder S; S.init(MT, D, F.G, F.bx);
            { pg8::Gemm g{(const bf16*)(ws + WS_ATT), WO, MT, D, D}; pg8::EpiMerge E{(const bf16*)(ws + WS_P), (bf16*)(ws + WS_T1), (bf16*)(ws + WS_MM), 0};
              pg8::gemm_phase<pg8::EpiMerge, pg8::StaticOrder, true, true>(ring, g, S, E); }
            asm volatile("s_waitcnt vmcnt(0)" ::: "memory");
            if (F.tid == 0) { __builtin_amdgcn_fence(__ATOMIC_ACQUIRE, "agent"); asm volatile("s_waitcnt vmcnt(0)" ::: "memory"); }
            __syncthreads();
            { pg8::Gemm g{(const bf16*)(ws + WS_RECG), WO + (size_t)D * D, MT, D, D}; pg8::EpiMerge E{(const bf16*)(ws + WS_P), (bf16*)(ws + WS_T1), (bf16*)(ws + WS_MM), 1};
              pg8::gemm_phase<pg8::EpiMerge, pg8::StaticOrder, true, true>(ring, g, S, E); }
            } SEAM(pb + 5);
        }
        if (SITE(7) && IN(pb + 6)) { REFRESH();
            pg8::Gemm g{(const bf16*)(ws + WS_MM), (const bf16*)(ws + WS_WO) + (size_t)(l * 3 + 2) * D * D, Mrows, D, D}; pg8::StaticOrder S; S.init(Mrows, D, F.G, F.bx);
            pg8::EpiResid E{(float*)(ws + WS_H), (const float*)(ws + WS_MOD) + (size_t)l * 18 * D + 2 * D};
            pg8::gemm_phase<pg8::EpiResid, pg8::StaticOrder, true, true>(ring, g, S, E);
            SEAM(pb + 6);
        }
        if (SITE(8) && IN(pb + 7)) { REFRESH(); ph_rows<1>(F, args, l, false); SEAM(pb + 7); }
        if (SITE(9) && IN(pb + 8) && moe) { REFRESH(); ph_lists(F, l); SEAM(pb + 8); }
        if (SITE(10) && IN(pb + 9)) { REFRESH(); REPS(10) {
            if (!moe) {
                pg8::Gemm g{(const bf16*)(ws + WS_XN), (const bf16*)(ws + WS_FF + (l >> 1) * FF_STRIDE), Mrows, 2 * DFF, D}; pg8::ExpertOrder S; S.init(Mrows, 2 * DFF, F.G, F.bx); S.panel_e = (const int*)(ws + WS_PANELE); S.estride = 0;
                pg8::EpiSwiGLU E{(bf16*)(ws + WS_HID), DFF};
                pg8::gemm_phase<pg8::EpiSwiGLU, pg8::ExpertOrder, true, true>(ring, g, S, E);
            } else {
                const int np = __builtin_amdgcn_readfirstlane(((const int*)(ws + WS_PANELE))[256]);
                pg8::Gemm g{(const bf16*)(ws + WS_XS), (const bf16*)(ws + WS_EXP + (l >> 1) * EXP_STRIDE), np * 256, 2 * DFE, D}; pg8::ExpertOrder S; S.init(np * 256, 2 * DFE, F.G, F.bx); S.panel_e = (const int*)(ws + WS_PANELE); S.estride = (size_t)2 * DFE * D * 2;
                pg8::EpiSwiGLU E{(bf16*)(ws + WS_HID), DFE};
                pg8::gemm_phase<pg8::EpiSwiGLU, pg8::ExpertOrder, true, true>(ring, g, S, E);
            }
            } SEAM(pb + 9);
        }
        if (SITE(11) && IN(pb + 10)) { REFRESH();
            if (!moe) {
                pg8::Gemm g{(const bf16*)(ws + WS_HID), (const bf16*)(ws + WS_FF + (l >> 1) * FF_STRIDE) + (size_t)2 * DFF * D, Mrows, D, DFF}; pg8::StaticOrder S; S.init(Mrows, D, F.G, F.bx);
                pg8::EpiResid E{(float*)(ws + WS_H), (const float*)(ws + WS_MOD) + (size_t)l * 18 * D + 5 * D};
                pg8::gemm_phase<pg8::EpiResid, pg8::StaticOrder, true, true>(ring, g, S, E);
            } else {
                const int np = __builtin_amdgcn_readfirstlane(((const int*)(ws + WS_PANELE))[256]);
                pg8::Gemm g{(const bf16*)(ws + WS_HID), (const bf16*)(ws + WS_EXP + (l >> 1) * EXP_STRIDE) + (size_t)NE * 2 * DFE * D, np * 256, D, DFE}; pg8::ExpertOrder S; S.init(np * 256, D, F.G, F.bx); S.panel_e = (const int*)(ws + WS_PANELE); S.estride = (size_t)D * DFE * 2;
                pg8::EpiPlain E{(bf16*)(ws + WS_FS), D};
                pg8::gemm_phase<pg8::EpiPlain, pg8::ExpertOrder, true, true>(ring, g, S, E);
            }
            SEAM(pb + 10);
        }
    }
    if (SITE(12) && IN(45)) { REFRESH(); ph_rows<2>(F, args, DEPTH, (args.flags & 4) != 0); }
#undef IN
#undef SEAM
}

static int g_bar_idx = 0;
static void opt_launch(void* const* d_in, void* d_out, void* d_ws, hipStream_t stream, int ph_lo, int ph_hi, int flags) {
    static int grid = 0;
    if (grid == 0) {
        int dev = 0, cus = 0, per_cu = 0;
        if (hipGetDevice(&dev) != hipSuccess || hipDeviceGetAttribute(&cus, hipDeviceAttributeMultiprocessorCount, dev) != hipSuccess) { fprintf(stderr, "opt_launch: device query failed\n"); grid = -1; return; }
        if (hipFuncSetAttribute((const void*)mk_fwd, hipFuncAttributeMaxDynamicSharedMemorySize, LDS_BYTES) != hipSuccess) { fprintf(stderr, "opt_launch: hipFuncSetAttribute failed\n"); grid = -1; return; }
        if (hipOccupancyMaxActiveBlocksPerMultiprocessor(&per_cu, (const void*)mk_fwd, NWAVES * 64, LDS_BYTES) != hipSuccess || per_cu < 1) { fprintf(stderr, "opt_launch: occupancy query says %d blocks per CU\n", per_cu); }
        (void)hipGetLastError();
        grid = cus;
        if (grid % 8 != 0 || grid < 64) fprintf(stderr, "opt_launch: unexpected CU count %d\n", grid);
    }
    if (grid < 0) return;
    Args a{};
    for (int i = 0; i < 28; ++i) a.in[i] = (const float*)d_in[i];
    a.out = (float*)d_out; a.ws = (unsigned char*)d_ws; a.ph_lo = ph_lo; a.ph_hi = ph_hi; a.flags = flags; a.bar_idx = (ph_hi - ph_lo > 1) ? g_bar_idx++ : 0;
    hipLaunchKernelGGL(mk_fwd, dim3(grid), dim3(NWAVES * 64), LDS_BYTES, stream, a);
    const hipError_t le = hipPeekAtLastError();
    if (le != hipSuccess) fprintf(stderr, "opt_launch: launch [%d,%d) failed: %s\n", ph_lo, ph_hi, hipGetErrorName(le));
}


extern "C" void kernel_launch(void* const* d_in, const int* in_sizes, int n_in, void* d_out, int out_size, void* d_ws, size_t ws_size, hipStream_t stream) {
    if (n_in != 28 || ws_size < WS_END) { fprintf(stderr, "kernel_launch: unexpected n_in %d or ws_size %zu (need %zu)\n", n_in, ws_size, (size_t)WS_END); return; }
    const float* x = (const float*)d_in[0]; const float* c = (const float*)d_in[1]; const float* ctx = (const float*)d_in[2]; const float* c_ctx = (const float*)d_in[3];
    const float* w_mod = (const float*)d_in[4]; const float* b_mod = (const float*)d_in[5]; const float* norm1_g = (const float*)d_in[6]; const float* norm2_g = (const float*)d_in[7];
    const float* w_in = (const float*)d_in[8]; const float* attn_sink = (const float*)d_in[9]; const float* conv_w = (const float*)d_in[10]; const float* conv_b = (const float*)d_in[11];
    const float* gate_a_w = (const float*)d_in[12]; const float* gate_a_b = (const float*)d_in[13]; const float* gate_x_w = (const float*)d_in[14]; const float* gate_x_b = (const float*)d_in[15];
    const float* lru_lambda = (const float*)d_in[16]; const float* w_o_attn = (const float*)d_in[17]; const float* w_o_lru = (const float*)d_in[18]; const float* w_out = (const float*)d_in[19];
    const float* ff_w_gate = (const float*)d_in[20]; const float* ff_w_up = (const float*)d_in[21]; const float* ff_w_down = (const float*)d_in[22]; const float* router_w = (const float*)d_in[23];
    const float* exp_w_gate = (const float*)d_in[24]; const float* exp_w_up = (const float*)d_in[25]; const float* exp_w_down = (const float*)d_in[26]; const float* final_g = (const float*)d_in[27];
    char* ws = (char*)d_ws;
    float* MOD = (float*)(ws + WS_MOD);
    int* te = (int*)(ws + WS_TE); float* tw = (float*)(ws + WS_TW); int* slot_tok = (int*)(ws + WS_SLOTTOK); int* tok_slot = (int*)(ws + WS_TOKSLOT); int* tile_e = (int*)(ws + WS_PANELE);
    float* H = (float*)(ws + WS_H); bf16* XN = (bf16*)(ws + WS_XN); bf16* P = (bf16*)(ws + WS_P); bf16* ATT = (bf16*)(ws + WS_ATT); bf16* RECG = (bf16*)(ws + WS_RECG);
    bf16* MM = (bf16*)(ws + WS_MM); bf16* HID = (bf16*)(ws + WS_HID); bf16* FS = (bf16*)(ws + WS_FS);
    float* XC = (float*)(ws + NV_XC); float* RG = (float*)(ws + NV_RG); float* IG = (float*)(ws + NV_IG); float* REC = (float*)(ws + NV_REC); float* PF = (float*)(ws + NV_PF32);
    const int EB = (int)(((long)MT * D + 255) / 256);
    (void)out_size; (void)in_sizes;

    (void)hipMemsetAsync(ws + WS_CTL, 0, CTL_ZERO_BYTES, stream);
    g_bar_idx = 0;
    const int CF = OPT_STEP >= 6 ? 4 : 0;
#if OPT_STEP >= 8
    opt_launch(d_in, d_out, d_ws, stream, 0, 46, 4);
    return;
#endif
#if OPT_STEP >= 1
    opt_launch(d_in, d_out, d_ws, stream, 0, 1, 0);
#else
    (void)hipMemcpyAsync(H, x, (size_t)ML * D * 4, hipMemcpyDeviceToDevice, stream);
    (void)hipMemcpyAsync(H + (size_t)ML * D, ctx, (size_t)MC * D * 4, hipMemcpyDeviceToDevice, stream);
    hipLaunchKernelGGL(nv::k_mod, dim3(6 * D / 256, DEPTH), dim3(256), 0, stream, c, c_ctx, w_mod, b_mod, MOD);
#endif
    for (int l = 0; l < DEPTH; ++l) {
        const float* MODl = MOD + (size_t)l * 3 * 6 * D;
        const int pb = 1 + 11 * l;
#if OPT_STEP >= 1
        opt_launch(d_in, d_out, d_ws, stream, pb + 0, pb + 2, CF);
#else
        hipLaunchKernelGGL((nv::k_norm_mod<bf16>), dim3(MT / 4), dim3(256), 0, stream, H, norm1_g + l * D, MODl, 0, D, XN, MT);
        ngemm(stream, XN, D, nullptr, w_in + (size_t)l * D * INC, INC, PF, INC, MT, INC, D);
        hipLaunchKernelGGL(nv::k_rope, dim3((ML * 640 + 255) / 256), dim3(256), 0, stream, PF);
        hipLaunchKernelGGL(nv::k_pfmt, dim3((int)(((long)MT * INC + 255) / 256)), dim3(256), 0, stream, PF, P);
#endif
#if OPT_STEP >= 2
        opt_launch(d_in, d_out, d_ws, stream, pb + 2, pb + 3, 1);
#else
        hipLaunchKernelGGL(nv::k_attn, dim3(MT * NH / 4), dim3(256), 0, stream, P, attn_sink + l * NH, ATT);
#endif
#if OPT_STEP >= 3
        opt_launch(d_in, d_out, d_ws, stream, pb + 2, pb + 3, 2);
        opt_launch(d_in, d_out, d_ws, stream, pb + 3, pb + 5, 0);
#else
        hipLaunchKernelGGL(nv::k_conv, dim3(EB), dim3(256), 0, stream, P, conv_w + (size_t)l * 4 * D, conv_b + l * D, XC);
        for (int d = 0; d < 2; ++d) {
            const size_t go = ((size_t)l * 2 + d) * 8 * 128 * 128, vo = ((size_t)l * 2 + d) * D;
            ngemm(stream, XC, D, nullptr, gate_a_w + go, 128, RG, D, MT, 128, 128, 8, 128, 128 * 128, 128);
            ngemm(stream, XC, D, nullptr, gate_x_w + go, 128, IG, D, MT, 128, 128, 8, 128, 128 * 128, 128);
            hipLaunchKernelGGL(nv::k_scan, dim3(BATCH * D / 64), dim3(64), 0, stream, XC, RG, IG, gate_a_b + vo, gate_x_b + vo, lru_lambda + vo, d, REC);
        }
        hipLaunchKernelGGL(nv::k_recgate, dim3(EB), dim3(256), 0, stream, REC, P, RECG);
#endif
#if OPT_STEP >= 4
        opt_launch(d_in, d_out, d_ws, stream, pb + 5, pb + 7, 0);
#else
        ngemm(stream, ATT, D, nullptr, w_o_attn + (size_t)l * D * D, D, RG, D, MT, D, D);
        ngemm(stream, RECG, D, nullptr, w_o_lru + (size_t)l * D * D, D, IG, D, MT, D, D);
        hipLaunchKernelGGL(nv::k_merge, dim3(EB), dim3(256), 0, stream, RG, IG, P, MM);
        ngemm(stream, MM, D, nullptr, w_out + (size_t)l * D * D, D, XC, D, MT, D, D);
        hipLaunchKernelGGL(nv::k_resid, dim3(EB), dim3(256), 0, stream, H, XC, MODl, 2 * D);
#endif
        const int i = l / 2;
        if (l % 2 == 0) {
#if OPT_STEP >= 5
            opt_launch(d_in, d_out, d_ws, stream, pb + 7, pb + 11, 0);
#else
            hipLaunchKernelGGL((nv::k_norm_mod<bf16>), dim3(MT / 4), dim3(256), 0, stream, H, norm2_g + l * D, MODl, 3 * D, 4 * D, XN, MT);
            ngemm(stream, XN, D, nullptr, ff_w_gate + (size_t)i * D * DFF, DFF, HID, DFF, MT, DFF, D);
            ngemm(stream, XN, D, nullptr, ff_w_up + (size_t)i * D * DFF, DFF, HID, DFF, MT, DFF, D, 1, 0, 0, 0, nullptr, 0, 1);
            ngemm(stream, HID, DFF, nullptr, ff_w_down + (size_t)i * DFF * D, D, IG, D, MT, D, DFF);
            hipLaunchKernelGGL(nv::k_resid, dim3(EB), dim3(256), 0, stream, H, IG, MODl, 5 * D);
#endif
        } else {
#if OPT_STEP >= 6
            opt_launch(d_in, d_out, d_ws, stream, pb + 7, pb + 11, 0);
#if OPT_STEP == 6
            if (l == DEPTH - 1) hipLaunchKernelGGL(nv::k_moe_combine, dim3(EB), dim3(256), 0, stream, H, FS, tok_slot, tw, MODl, 5 * D);
#endif
#else
            hipLaunchKernelGGL((nv::k_norm_mod<bf16>), dim3(MT / 4), dim3(256), 0, stream, H, norm2_g + l * D, MODl, 3 * D, 4 * D, XN, MT);
            hipLaunchKernelGGL(nv::k_route, dim3(MT / 4), dim3(256), 0, stream, XN, router_w + (size_t)i * D * NE, te, tw);
            hipLaunchKernelGGL(nv::k_moe_lists, dim3(1), dim3(1024), 0, stream, te, slot_tok, tok_slot, tile_e);
            const size_t eo = (size_t)i * NE * D * DFE;
            ngemm(stream, XN, D, slot_tok, exp_w_gate + eo, DFE, HID, DFE, NSLOT, DFE, D, 1, 0, 0, 0, tile_e, (long)D * DFE, 0);
            ngemm(stream, XN, D, slot_tok, exp_w_up + eo, DFE, HID, DFE, NSLOT, DFE, D, 1, 0, 0, 0, tile_e, (long)D * DFE, 1);
            ngemm(stream, HID, DFE, nullptr, exp_w_down + eo, D, FS, D, NSLOT, D, DFE, 1, 0, 0, 0, tile_e, (long)DFE * D, 0);
            hipLaunchKernelGGL(nv::k_moe_combine, dim3(EB), dim3(256), 0, stream, H, FS, tok_slot, tw, MODl, 5 * D);
#endif
        }
    }
#if OPT_STEP >= 7
    opt_launch(d_in, d_out, d_ws, stream, 45, 46, CF);
#else
    hipLaunchKernelGGL(nv::k_final, dim3(ML / 4), dim3(256), 0, stream, H, final_g, (float*)d_out);
#endif
}
```

```cpp
#include <hip/hip_runtime.h>
#include <cstdio>
#include <cstdint>

#define ADUP 0
#define A3_PRIO 1
#define A3_NOSBAR 1
#define A3_LATEDMA 1
#ifndef OPT_STEP
#define OPT_STEP 8
#endif

constexpr int D = 1024, BATCH = 2, SEQ = 8192, DEPTH = 4, CTX = 256, GRIDW = 64;
constexpr int NH = 8, NKV = 2, HD = 128, WIN = 128;
constexpr int DFF = 2816, NE = 8, DFE = 3584;
constexpr int INC = 5632;
constexpr int OFF_Q = 0, OFF_K = 1024, OFF_V = 1280, OFF_X = 1536, OFF_Y = 2560, OFF_GA = 3584, OFF_GR = 4608;
constexpr int ML = BATCH * SEQ, MC = BATCH * CTX, MT = ML + MC;
constexpr int NSLOT = 35840;
constexpr int NCHUNK = MT / 64;
constexpr float EPS = 1e-6f;
constexpr size_t MiB = 1u << 20;

typedef unsigned short bf16;
typedef float f32x4 __attribute__((ext_vector_type(4)));
typedef float f32x2 __attribute__((ext_vector_type(2)));
typedef float f32x16 __attribute__((ext_vector_type(16)));
typedef unsigned u32x4 __attribute__((ext_vector_type(4)));
typedef unsigned u32x2 __attribute__((ext_vector_type(2)));
typedef short bf16x8 __attribute__((ext_vector_type(8)));
typedef __bf16 bf2_t __attribute__((ext_vector_type(2)));
#define LAS __attribute__((address_space(3)))
#define GAS __attribute__((address_space(1)))
typedef GAS unsigned gu32;

__device__ __forceinline__ unsigned pk2(float lo, float hi) { f32x2 v = {lo, hi}; return __builtin_bit_cast(unsigned, __builtin_convertvector(v, bf2_t)); }
#ifndef WT_STORES
#define WT_STORES 0
#endif
template <int BIT = 0> __device__ __forceinline__ void st16w(void* p, u32x4 v) { if ((WT_STORES >> BIT) & 1) asm volatile("global_store_dwordx4 %0, %1, off sc1\n\ts_nop 1" :: "v"(p), "v"(v) : "memory"); else *(u32x4*)p = v; }
template <int BIT = 0> __device__ __forceinline__ void st8w(void* p, u32x2 v) { if ((WT_STORES >> BIT) & 1) asm volatile("global_store_dwordx2 %0, %1, off sc1\n\ts_nop 1" :: "v"(p), "v"(v) : "memory"); else *(u32x2*)p = v; }
__device__ __forceinline__ bf16 f2bf(float f) { return (bf16)(pk2(f, 0.f) & 0xffffu); }
__device__ __forceinline__ float bf2f(bf16 b) { return __uint_as_float(((unsigned)b) << 16); }
__device__ __forceinline__ float bflo(unsigned u) { return __uint_as_float(u << 16); }
__device__ __forceinline__ float bfhi(unsigned u) { return __uint_as_float(u & 0xffff0000u); }
__device__ __forceinline__ float ldf(const float* p) { return *p; }
__device__ __forceinline__ float ldf(const bf16* p) { return bf2f(*p); }
__device__ __forceinline__ void stf(float* p, float v) { *p = v; }
__device__ __forceinline__ void stf(bf16* p, float v) { *p = f2bf(v); }

__device__ __forceinline__ float sigm(float x) { return 1.f / (1.f + expf(-x)); }
__device__ __forceinline__ float silu_f(float x) { return x * sigm(x); }
__device__ __forceinline__ float gelu_tanh(float x) { return 0.5f * x * (1.f + tanhf(0.7978845608028654f * (x + 0.044715f * x * x * x))); }
__device__ __forceinline__ float fsigm(float x) { return __builtin_amdgcn_rcpf(1.f + __builtin_amdgcn_exp2f(-1.4426950408889634f * x)); }
__device__ __forceinline__ float fsilu(float x) { return x * fsigm(x); }
__device__ __forceinline__ float fgelu(float x) { return x * __builtin_amdgcn_rcpf(1.f + __builtin_amdgcn_exp2f(-2.302208198f * (x + 0.044715f * x * x * x))); }
__device__ __forceinline__ float wave_sum(float v) {
#pragma unroll
    for (int o = 1; o < 64; o <<= 1) v += __shfl_xor(v, o);
    return v;
}
__device__ __forceinline__ float wave_max(float v) {
#pragma unroll
    for (int o = 1; o < 64; o <<= 1) v = fmaxf(v, __shfl_xor(v, o));
    return v;
}
__device__ __forceinline__ int row_vec(int m) { return m < ML ? m / SEQ : 2; }
__host__ __device__ __forceinline__ int qk_orig(int ni) { return (ni >> 6) * 64 + (ni & 1) * 32 + ((ni & 63) >> 1); }

constexpr size_t WS_CTL = 0, CTL_ZERO_BYTES = 1 * MiB;
constexpr size_t WS_MOD = 2 * MiB, WS_ROPE = WS_MOD + 320 * 1024, WS_TE = WS_MOD + 384 * 1024, WS_TW = WS_MOD + 576 * 1024, WS_TOKSLOT = WS_MOD + 768 * 1024, WS_PANELE = WS_MOD + 960 * 1024;
constexpr size_t WS_SLOTTOK = 3 * MiB, WS_WCNT = 3 * MiB + 704 * 1024  , WS_SPT = 3 * MiB + 512 * 1024;
constexpr size_t WS_AGG = 4 * MiB;
constexpr size_t AGG_BYTES = (size_t)2 * NCHUNK * D * 4;
constexpr size_t WS_GT = 12 * MiB;
constexpr size_t WS_WIN = 16 * MiB;
constexpr size_t WS_WO = 60 * MiB;
constexpr size_t WS_FF = 84 * MiB, FF_STRIDE = (size_t)(2 * DFF * D + D * DFF) * 2;
constexpr size_t WS_EXP = 117 * MiB, EXP_STRIDE = (size_t)NE * (2 * DFE * D + D * DFE) * 2;
constexpr size_t WS_H = 453 * MiB, WS_XN = 519 * MiB, WS_P = 552 * MiB, WS_ATT = 734 * MiB, WS_RECG = 767 * MiB, WS_T1 = 800 * MiB, WS_MM = 833 * MiB, WS_XS = 866 * MiB, WS_END = 966 * MiB;
constexpr size_t WS_HID = WS_P, WS_FS = WS_XS;
constexpr size_t WS_SCAB = WS_T1;
static_assert(WS_SCAB + (size_t)NCHUNK * 8 * 8 * 10 * 1024 <= WS_END, "scan block area");
static_assert(WS_FF + 2 * FF_STRIDE <= WS_EXP && WS_EXP + 2 * EXP_STRIDE <= WS_H && WS_HID + (size_t)NSLOT * DFE * 2 <= WS_T1 && WS_AGG + 3 * AGG_BYTES <= WS_GT, "ws map");
constexpr size_t NV_XC = WS_EXP, NV_RG = WS_EXP + 66 * MiB, NV_IG = WS_EXP + 132 * MiB, NV_REC = WS_EXP + 198 * MiB, NV_PF32 = 16 * MiB;
constexpr int CW_TMO = 0, CW_Q = 1024, CW_CNT = 2048, CW_CUR = 2048 + 256, CW_BAR = 4096, CW_RDY = 131072;

namespace nv {
__global__ __launch_bounds__(256) void k_mod(const float* c, const float* c_ctx, const float* w_mod, const float* b_mod, float* MOD) {
    __shared__ float s[3][D];
    const int l = blockIdx.y, n = blockIdx.x * 256 + threadIdx.x;
    for (int i = threadIdx.x; i < 3 * D; i += 256) { const int v = i / D, k = i % D; const float x = v < 2 ? c[v * D + k] : c_ctx[k]; s[v][k] = silu_f(x); }
    __syncthreads();
    const float* w = w_mod + (size_t)l * D * 6 * D + n;
    float a0 = 0.f, a1 = 0.f, a2 = 0.f;
    for (int k = 0; k < D; ++k) { const float wv = w[(size_t)k * 6 * D]; a0 += s[0][k] * wv; a1 += s[1][k] * wv; a2 += s[2][k] * wv; }
    const float b = b_mod[l * 6 * D + n];
    float* o = MOD + (size_t)l * 3 * 6 * D + n;
    o[0] = a0 + b; o[6 * D] = a1 + b; o[12 * D] = a2 + b;
}
template <class TO> __global__ __launch_bounds__(256) void k_norm_mod(const float* H, const float* g, const float* MODl, int sh_off, int sc_off, TO* XN, int nrows) {
    const int m = (blockIdx.x * 256 + threadIdx.x) >> 6, lane = threadIdx.x & 63;
    if (m >= nrows) return;
    const float* h = H + (size_t)m * D;
    float v[16]; float ss = 0.f;
#pragma unroll
    for (int j = 0; j < 16; ++j) { v[j] = h[lane + 64 * j]; ss += v[j] * v[j]; }
    ss = wave_sum(ss);
    const float r = rsqrtf(ss * (1.f / D) + EPS);
    const float* mv = MODl + (size_t)row_vec(m) * 6 * D;
#pragma unroll
    for (int j = 0; j < 16; ++j) { const int n = lane + 64 * j; stf(XN + (size_t)m * D + n, (v[j] * r * g[n]) * (1.f + mv[sc_off + n]) + mv[sh_off + n]); }
}
template <class TA, class TC> struct NGemm {
    const TA* A; int lda; const int* arow;
    const float* B; int ldb; TC* C; int ldc; int K;
    long sA, sB, sC;
    const int* tile_e; long sBe;
    int mode;
};
template <class TA, class TC> __global__ __launch_bounds__(256) void k_gemm(NGemm<TA, TC> g) {
    const int z = blockIdx.z, tm = blockIdx.y, tn = blockIdx.x;
    const TA* A = g.A + (long)z * g.sA; const float* B = g.B + (long)z * g.sB; TC* C = g.C + (long)z * g.sC;
    if (g.tile_e) { const int e = g.tile_e[tm]; if (e < 0) return; B += (long)e * g.sBe; }
    const int wave = threadIdx.x >> 6, lane = threadIdx.x & 63, lr = lane & 15, lk = lane >> 4;
    const int m0 = tm * 128 + (wave >> 1) * 64, n0 = tn * 128 + (wave & 1) * 64;
    const TA* ap0; const TA* ap1; const TA* ap2; const TA* ap3;
    {
        int r0 = m0 + lr, r1 = r0 + 16, r2 = r0 + 32, r3 = r0 + 48;
        if (g.arow) { r0 = g.arow[r0]; r1 = g.arow[r1]; r2 = g.arow[r2]; r3 = g.arow[r3]; r0 = r0 < 0 ? 0 : r0; r1 = r1 < 0 ? 0 : r1; r2 = r2 < 0 ? 0 : r2; r3 = r3 < 0 ? 0 : r3; }
        ap0 = A + (long)r0 * g.lda + lk; ap1 = A + (long)r1 * g.lda + lk; ap2 = A + (long)r2 * g.lda + lk; ap3 = A + (long)r3 * g.lda + lk;
    }
    const float* bp = B + (long)lk * g.ldb + n0 + lr;
    f32x4 acc[4][4];
#pragma unroll
    for (int i = 0; i < 4; ++i)
#pragma unroll
        for (int j = 0; j < 4; ++j) acc[i][j] = (f32x4){0.f, 0.f, 0.f, 0.f};
    const long ldb = g.ldb;
    for (int k = 0; k < g.K; k += 4) {
        float a[4], b[4];
        a[0] = ldf(ap0 + k); a[1] = ldf(ap1 + k); a[2] = ldf(ap2 + k); a[3] = ldf(ap3 + k);
        const float* bk = bp + (long)k * ldb;
        b[0] = bk[0]; b[1] = bk[16]; b[2] = bk[32]; b[3] = bk[48];
#pragma unroll
        for (int i = 0; i < 4; ++i)
#pragma unroll
            for (int j = 0; j < 4; ++j) acc[i][j] = __builtin_amdgcn_mfma_f32_16x16x4f32(a[i], b[j], acc[i][j], 0, 0, 0);
    }
#pragma unroll
    for (int i = 0; i < 4; ++i)
#pragma unroll
        for (int j = 0; j < 4; ++j)
#pragma unroll
            for (int r = 0; r < 4; ++r) {
                TC* cp = C + (long)(m0 + 16 * i + 4 * lk + r) * g.ldc + n0 + 16 * j + lr;
                const float v = acc[i][j][r];
                stf(cp, g.mode == 1 ? silu_f(ldf(cp)) * v : v);
            }
}
__global__ __launch_bounds__(256) void k_rope(float* P) {
    const long idx = (long)blockIdx.x * 256 + threadIdx.x;
    if (idx >= (long)ML * 10 * 64) return;
    const int pi = (int)(idx & 63), slot = (int)((idx >> 6) % 10), m = (int)(idx / 640);
    const int t = m % SEQ, half = pi >> 5, i = pi & 31;
    const int base = (slot < 8 ? OFF_Q + slot * HD : OFF_K + (slot - 8) * HD) + half * 64;
    const float pos = half == 0 ? (float)(t / GRIDW) : (float)(t % GRIDW);
    const float inv = powf(10000.f, -(float)i / 32.f);
    const float ang = pos * inv, cs = cosf(ang), sn = sinf(ang);
    float* p = P + (size_t)m * INC + base;
    const float x1 = p[i], x2 = p[32 + i];
    p[i] = x1 * cs - x2 * sn; p[32 + i] = x2 * cs + x1 * sn;
}
__global__ __launch_bounds__(256) void k_pfmt(const float* Pf, bf16* P) {
    const long idx = (long)blockIdx.x * 256 + threadIdx.x; if (idx >= (long)MT * INC) return;
    const int n = (int)(idx % INC); const long m = idx / INC;
    float v;
    if (n < OFF_V) { const int hb = n & ~127; v = Pf[m * INC + hb + qk_orig(n & 127)]; }
    else { v = Pf[idx]; if (n >= OFF_Y && n < OFF_GA) v = gelu_tanh(v); else if (n >= OFF_GA) v = sigm(v); }
    P[idx] = f2bf(v);
}
__global__ __launch_bounds__(256) void k_attn(const bf16* P, const float* sink, bf16* O) {
    __shared__ float ps[4][576];
    __shared__ int prow[4][576];
    const int w = threadIdx.x >> 6, lane = threadIdx.x & 63;
    const int gw = blockIdx.x * 4 + w;
    const int m = gw >> 3, h = gw & 7, kvh = h >> 2;
    const bool lat = m < ML;
    const int b = lat ? m / SEQ : (m - ML) / CTX, t = lat ? m % SEQ : 0;
    const int lo = lat ? (t - WIN < 0 ? 0 : t - WIN) : 0, hi = lat ? (t + WIN > SEQ - 1 ? SEQ - 1 : t + WIN) : -1;
    const int nlat = lat ? hi - lo + 1 : 0, nk = nlat + CTX;
    const bf16* q = P + (size_t)m * INC + OFF_Q + h * HD;
    const float scale = 0.08838834764831845f;
    const float sk = sink[h];
    float sc[9]; float mx = sk;
#pragma unroll
    for (int i = 0; i < 9; ++i) {
        const int j = lane + 64 * i; float s = -INFINITY;
        if (j < nk) {
            const int row = j < nlat ? b * SEQ + lo + j : ML + b * CTX + (j - nlat);
            const bf16* kp = P + (size_t)row * INC + OFF_K + kvh * HD;
            float d = 0.f;
            for (int e = 0; e < 128; ++e) d += bf2f(q[e]) * bf2f(kp[e]);
            s = d * scale; prow[w][j] = row;
        }
        sc[i] = s; mx = fmaxf(mx, s);
    }
    mx = wave_max(mx);
    float sum = 0.f;
#pragma unroll
    for (int i = 0; i < 9; ++i) { const int j = lane + 64 * i; if (j < nk) { const float p = expf(sc[i] - mx); ps[w][j] = p; sum += p; } }
    sum = wave_sum(sum) + expf(sk - mx);
    const float rs = 1.f / sum;
    __syncthreads();
    float o0 = 0.f, o1 = 0.f;
    for (int j = 0; j < nk; ++j) { const float p = ps[w][j]; const bf16* vp = P + (size_t)prow[w][j] * INC + OFF_V + kvh * HD; o0 += p * bf2f(vp[lane]); o1 += p * bf2f(vp[lane + 64]); }
    bf16* op = O + (size_t)m * D + h * HD;
    op[lane] = f2bf(o0 * rs); op[lane + 64] = f2bf(o1 * rs);
}
__global__ __launch_bounds__(256) void k_conv(const bf16* P, const float* cw, const float* cb, float* XC) {
    const long idx = (long)blockIdx.x * 256 + threadIdx.x;
    if (idx >= (long)MT * D) return;
    const int ch = (int)(idx & (D - 1)), m = (int)(idx >> 10);
    const bool lat = m < ML; const int L = lat ? SEQ : CTX, t = lat ? m % SEQ : (m - ML) % CTX;
    float y = 0.f;
#pragma unroll
    for (int j = 0; j < 4; ++j) { const int tt = t + j - 2; if (tt >= 0 && tt < L) y += bf2f(P[(size_t)(m + j - 2) * INC + OFF_X + ch]) * cw[j * D + ch]; }
    XC[idx] = y + cb[ch];
}
__device__ __forceinline__ void scan_seq(const float* XC, const float* RG, const float* IG, float* REC, int mbase, int L, int dir, int ch, float sp, float bav, float bxv, float& h) {
    for (int s0 = 0; s0 < L; s0 += 8) {
        float x[8], r[8], g[8], pr[8];
#pragma unroll
        for (int u = 0; u < 8; ++u) { const int t = dir == 0 ? s0 + u : L - 1 - (s0 + u); const size_t o = (size_t)(mbase + t) * D + ch; x[u] = XC[o]; r[u] = RG[o]; g[u] = IG[o]; pr[u] = dir == 0 ? 0.f : REC[o]; }
#pragma unroll
        for (int u = 0; u < 8; ++u) { const int t = dir == 0 ? s0 + u : L - 1 - (s0 + u); const size_t o = (size_t)(mbase + t) * D + ch;
            const float rr = sigm(r[u] + bav), ig = sigm(g[u] + bxv);
            const float la = -8.f * rr * sp, a = expf(la), bc = sqrtf(-expm1f(2.f * la)) * (ig * x[u]);
            h = a * h + bc; REC[o] = pr[u] + h; }
    }
}
__global__ __launch_bounds__(64) void k_scan(const float* XC, const float* RG, const float* IG, const float* ba, const float* bx, const float* lam, int dir, float* REC) {
    const int idx = blockIdx.x * 64 + threadIdx.x;
    const int b = idx >> 10, ch = idx & (D - 1);
    const float sp = log1pf(expf(-lam[ch])), bav = ba[ch], bxv = bx[ch];
    float h = 0.f;
    scan_seq(XC, RG, IG, REC, ML + b * CTX, CTX, dir, ch, sp, bav, bxv, h);
    scan_seq(XC, RG, IG, REC, b * SEQ, SEQ, dir, ch, sp, bav, bxv, h);
}
__global__ __launch_bounds__(256) void k_recgate(const float* REC, const bf16* P, bf16* RECG) {
    const long idx = (long)blockIdx.x * 256 + threadIdx.x; if (idx >= (long)MT * D) return;
    const int ch = (int)(idx & (D - 1)), m = (int)(idx >> 10);
    RECG[idx] = f2bf(REC[idx] * bf2f(P[(size_t)m * INC + OFF_Y + ch]));
}
__global__ __launch_bounds__(256) void k_merge(const float* T1, const float* T2, const bf16* P, bf16* MM) {
    const long idx = (long)blockIdx.x * 256 + threadIdx.x; if (idx >= (long)MT * D) return;
    const int ch = (int)(idx & (D - 1)), m = (int)(idx >> 10);
    const bf16* p = P + (size_t)m * INC;
    MM[idx] = f2bf(bf2f(p[OFF_GA + ch]) * T1[idx] + bf2f(p[OFF_GR + ch]) * T2[idx]);
}
__global__ __launch_bounds__(256) void k_resid(float* H, const float* Y, const float* MODl, int g_off) {
    const long idx = (long)blockIdx.x * 256 + threadIdx.x; if (idx >= (long)MT * D) return;
    const int n = (int)(idx & (D - 1)), m = (int)(idx >> 10);
    H[idx] += MODl[(size_t)row_vec(m) * 6 * D + g_off + n] * Y[idx];
}
__global__ __launch_bounds__(256) void k_route(const bf16* XN, const float* wr, int* te, float* tw) {
    const int m = (blockIdx.x * 256 + threadIdx.x) >> 6, lane = threadIdx.x & 63;
    if (m >= MT) return;
    float lg[NE];
#pragma unroll
    for (int e = 0; e < NE; ++e) lg[e] = 0.f;
    for (int j = 0; j < 16; ++j) { const int k = lane + 64 * j; const float x = bf2f(XN[(size_t)m * D + k]); const float* w = wr + (size_t)k * NE;
#pragma unroll
        for (int e = 0; e < NE; ++e) lg[e] += x * w[e]; }
#pragma unroll
    for (int e = 0; e < NE; ++e) lg[e] = wave_sum(lg[e]);
    if (lane == 0) {
        int i0 = 0; float v0 = lg[0];
#pragma unroll
        for (int e = 1; e < NE; ++e) if (lg[e] > v0) { v0 = lg[e]; i0 = e; }
        int i1 = -1; float v1 = -INFINITY;
#pragma unroll
        for (int e = 0; e < NE; ++e) if (e != i0 && lg[e] > v1) { v1 = lg[e]; i1 = e; }
        const float e1 = expf(v1 - v0), w0 = 1.f / (1.f + e1), w1 = e1 / (1.f + e1);
        te[2 * m] = i0; te[2 * m + 1] = i1; tw[2 * m] = w0; tw[2 * m + 1] = w1;
    }
}
__global__ __launch_bounds__(1024) void k_moe_lists(const int* te, int* slot_tok, int* tok_slot, int* tile_e) {
    __shared__ int cnt[NE], off[NE + 1], cur[NE];
    const int tid = threadIdx.x;
    if (tid < NE) { cnt[tid] = 0; cur[tid] = 0; }
    for (int i = tid; i < NSLOT; i += 1024) slot_tok[i] = -1;
    __syncthreads();
    for (int i = tid; i < 2 * MT; i += 1024) atomicAdd(&cnt[te[i]], 1);
    __syncthreads();
    if (tid == 0) { int o = 0; for (int e = 0; e < NE; ++e) { off[e] = o; o += (cnt[e] + 255) / 256 * 256; } off[NE] = o; }
    __syncthreads();
    for (int i = tid; i < NSLOT / 128; i += 1024) { int e = -1; for (int x = 0; x < NE; ++x) if (i * 128 >= off[x] && i * 128 < off[x + 1]) e = x; tile_e[i] = e; }
    for (int i = tid; i < 2 * MT; i += 1024) { const int e = te[i]; const int pos = atomicAdd(&cur[e], 1); const int s = off[e] + pos; slot_tok[s] = i >> 1; tok_slot[i] = s; }
}
__global__ __launch_bounds__(256) void k_moe_combine(float* H, const bf16* FS, const int* tok_slot, const float* tw, const float* MODl, int g_off) {
    const long idx = (long)blockIdx.x * 256 + threadIdx.x; if (idx >= (long)MT * D) return;
    const int n = (int)(idx & (D - 1)), m = (int)(idx >> 10);
    const float f = tw[2 * m] * bf2f(FS[(size_t)tok_slot[2 * m] * D + n]) + tw[2 * m + 1] * bf2f(FS[(size_t)tok_slot[2 * m + 1] * D + n]);
    H[idx] += MODl[(size_t)row_vec(m) * 6 * D + g_off + n] * f;
}
__global__ __launch_bounds__(256) void k_final(const float* H, const float* g, float* out) {
    const int m = (blockIdx.x * 256 + threadIdx.x) >> 6, lane = threadIdx.x & 63;
    if (m >= ML) return;
    const float* h = H + (size_t)m * D;
    float v[16]; float ss = 0.f;
#pragma unroll
    for (int j = 0; j < 16; ++j) { v[j] = h[lane + 64 * j]; ss += v[j] * v[j]; }
    ss = wave_sum(ss);
    const float r = rsqrtf(ss * (1.f / D) + EPS);
#pragma unroll
    for (int j = 0; j < 16; ++j) { const int n = lane + 64 * j; out[(size_t)m * D + n] = v[j] * r * g[n]; }
}
}

template <class TA, class TC>
static void ngemm(hipStream_t st, const TA* A, int lda, const int* arow, const float* B, int ldb, TC* C, int ldc, int M, int N, int K,
                  int nz = 1, long sA = 0, long sB = 0, long sC = 0, const int* tile_e = nullptr, long sBe = 0, int mode = 0) {
    nv::NGemm<TA, TC> g{}; g.A = A; g.lda = lda; g.arow = arow; g.B = B; g.ldb = ldb; g.C = C; g.ldc = ldc; g.K = K; g.sA = sA; g.sB = sB; g.sC = sC; g.tile_e = tile_e; g.sBe = sBe; g.mode = mode;
    hipLaunchKernelGGL((nv::k_gemm<TA, TC>), dim3(N / 128, M / 128, nz), dim3(256), 0, st, g);
}

#ifndef PG8_WGM
#define PG8_WGM 4
#endif
namespace pg8 {
#define PG8_LAS __attribute__((address_space(3)))
typedef unsigned short bf16_t;
typedef short bf16x8 __attribute__((ext_vector_type(8)));
typedef float f32x4 __attribute__((ext_vector_type(4)));
typedef unsigned u32x4 __attribute__((ext_vector_type(4)));
constexpr int BM = 256, BK = 64, HALF = 128, HTB = HALF * BK * 2  , STAGE_BYTES = 8 * HTB, NXCD = 8, WGM = PG8_WGM;

__host__ __device__ __forceinline__ int lds_byte(int r, int c) { const int st = (r >> 4) * 2 + (c >> 5), rr = r & 15, cc = c & 31, ob = rr * 64 + cc * 2; return st * 1024 + (ob ^ (((ob >> 9) & 1) << 5)); }
__host__ __device__ __forceinline__ void stage_rc(int b, int& R, int& C) { const int st = b / 1024, sb = b % 1024, swz = sb ^ (((sb >> 9) & 1) << 5); R = (st >> 1) * 16 + swz / 64; C = (st & 1) * 32 + (swz % 64) / 2; }
__host__ __device__ __forceinline__ int perm32(int rho) { const int n = rho >> 4, i = rho & 15; return 8 * (i >> 2) + 4 * n + (i & 3); }

struct Unit { int pm, pn; };
struct Gemm { const bf16_t* A; const bf16_t* Bt; int M, N, K; };

struct StaticOrder {
    static constexpr bool GATHER = false;
    int nM, nN, nwg, G, c, rev, wgm;
    __host__ __device__ void init(int M, int N, int G_, int c_, int rev_ = 0) { nM = M / BM; nN = N / BM; nwg = nM * nN; G = G_; c = c_; rev = rev_; wgm = WGM; }
    __host__ __device__ bool next(int i, Unit& u) const {
        const long L = (long)i * G + c; if (L >= nwg) return false;
        int wgid = (int)L; { const int q = nwg / NXCD, r = nwg % NXCD, xcd = wgid % NXCD; int off = wgid / NXCD; if (rev & 2) off = (xcd < r ? q + 1 : q) - 1 - off;
            wgid = (xcd < r ? xcd * (q + 1) : r * (q + 1) + (xcd - r) * q) + off; }
        const int nig = wgm * nN, gid = wgid / nig, fm = gid * wgm, gsz = (nM - fm) < wgm ? (nM - fm) : wgm;
        u.pm = fm + ((wgid % nig) % gsz); u.pn = (wgid % nig) / gsz; if (rev & 1) u.pn = nN - 1 - u.pn; return true;
    }
    __device__ __forceinline__ void a_ready(const Unit&) const {}
    __device__ __forceinline__ size_t boff(const Unit&) const { return 0; }
    __device__ __forceinline__ void done(const Unit&) const {}
};


struct ExpertOrder : StaticOrder {
    const int* panel_e; size_t estride;
    unsigned* pub; const unsigned* ready; unsigned need; unsigned* tmo;
    __device__ __forceinline__ size_t boff(const Unit& u) const { return (size_t)__builtin_amdgcn_readfirstlane(panel_e[u.pm]) * estride; }
    mutable int pend;
    __device__ __forceinline__ void done(const Unit& u) const {
        if (pub) { if (pend >= 0 && (threadIdx.x & 63) == 0) __hip_atomic_fetch_add(pub + 64 * pend, 1u, __ATOMIC_RELAXED, __HIP_MEMORY_SCOPE_AGENT); pend = u.pm; }
    }
    __device__ __forceinline__ void flush() const {
        if (pub && pend >= 0) { asm volatile("s_waitcnt vmcnt(0)" ::: "memory"); if ((threadIdx.x & 63) == 0) __hip_atomic_fetch_add(pub + 64 * pend, 1u, __ATOMIC_RELAXED, __HIP_MEMORY_SCOPE_AGENT); pend = -1; }
    }
    __device__ __forceinline__ void a_ready(const Unit& u) const {
        if (!ready) return;
        if (threadIdx.x < 64) {
            const unsigned long long t0 = __builtin_amdgcn_s_memrealtime(); unsigned polls = 0;
            while ((unsigned)__builtin_amdgcn_readfirstlane(__hip_atomic_load(ready + 64 * u.pm, __ATOMIC_RELAXED, __HIP_MEMORY_SCOPE_AGENT)) < need) {
                if ((++polls & 255u) == 0u && __builtin_amdgcn_readfirstlane(__hip_atomic_load(tmo, __ATOMIC_RELAXED, __HIP_MEMORY_SCOPE_AGENT)) != 0u) break;
                if (__builtin_amdgcn_s_memrealtime() - t0 > 2000000ull) { if (threadIdx.x == 0) __hip_atomic_store(tmo, 1u, __ATOMIC_RELAXED, __HIP_MEMORY_SCOPE_AGENT); break; }
                __builtin_amdgcn_s_sleep(2); }
            __builtin_amdgcn_fence(__ATOMIC_ACQUIRE, "agent");
            asm volatile("s_waitcnt vmcnt(0)" ::: "memory");
        }
        asm volatile("" ::: "memory"); __builtin_amdgcn_s_barrier(); asm volatile("" ::: "memory");
    }
};
struct GatherOrder : ExpertOrder { static constexpr bool GATHER = true; const int* arow; };
struct EpiInProj {
    static constexpr bool PERM = true, AFTER_DRAIN = false;
    bf16* P; const f32x4* rope;
    __device__ __forceinline__ void operator()(const f32x4 (&acc)[2][2][4][2], const Unit& u, int wr, int wc, int fr, int fq) const {
        const int pn = u.pn;
        const int kind = pn < 5 ? 0 : (pn < 10 ? 1 : (pn < 14 ? 2 : 3));
        const bool rope_on = kind == 0 && u.pm < 64;
        const int row0 = u.pm * BM + wr * 64 + fr, col0 = pn * BM + wc * 32 + 8 * fq;
#pragma unroll
        for (int ai = 0; ai < 2; ++ai)
#pragma unroll
            for (int m = 0; m < 4; ++m) {
                const int row = row0 + ai * HALF + m * 16;
                bf16* rowp = P + (size_t)row * INC + col0;
                f32x4 cs0 = {1.f, 0.f, 1.f, 0.f}, cs1 = {1.f, 0.f, 1.f, 0.f};
                if (rope_on) { const int t = row & (SEQ - 1); const int pos = (wc >> 1) ? (t & 63) : (t >> 6); const f32x4* rp = rope + pos * 16 + 8 * (wc & 1) + 2 * fq; cs0 = rp[0]; cs1 = rp[1]; }
#pragma unroll
                for (int bj = 0; bj < 2; ++bj) {
                    f32x4 v0 = acc[ai][bj][m][0], v1 = acc[ai][bj][m][1];
                    if (kind == 0) {
                        const f32x4 a = v0, b = v1;
                        v0[0] = a[0] * cs0[0] - a[1] * cs0[1]; v0[1] = a[1] * cs0[0] + a[0] * cs0[1];
                        v0[2] = a[2] * cs0[2] - a[3] * cs0[3]; v0[3] = a[3] * cs0[2] + a[2] * cs0[3];
                        v1[0] = b[0] * cs1[0] - b[1] * cs1[1]; v1[1] = b[1] * cs1[0] + b[0] * cs1[1];
                        v1[2] = b[2] * cs1[2] - b[3] * cs1[3]; v1[3] = b[3] * cs1[2] + b[2] * cs1[3];
                    } else if (kind == 2) {
#pragma unroll
                        for (int j = 0; j < 4; ++j) { v0[j] = fgelu(v0[j]); v1[j] = fgelu(v1[j]); }
                    } else if (kind == 3) {
#pragma unroll
                        for (int j = 0; j < 4; ++j) { v0[j] = fsigm(v0[j]); v1[j] = fsigm(v1[j]); }
                    }
                    u32x4 w; w.x = pk2(v0[0], v0[1]); w.y = pk2(v0[2], v0[3]); w.z = pk2(v1[0], v1[1]); w.w = pk2(v1[2], v1[3]);
                    st16w(rowp + bj * HALF, w);
                }
            }
    }
};
struct EpiMerge {
    static constexpr bool PERM = true, AFTER_DRAIN = false;
    const bf16* P; bf16* T1; bf16* MM; int mode; int goff;
    __device__ __forceinline__ void operator()(const f32x4 (&acc)[2][2][4][2], const Unit& u, int wr, int wc, int fr, int fq) const {
        const int row0 = u.pm * BM + wr * 64 + fr, col0 = u.pn * BM + wc * 32 + 8 * fq;
#pragma unroll
        for (int ai = 0; ai < 2; ++ai)
#pragma unroll
            for (int m = 0; m < 4; ++m) {
                const size_t row = (size_t)(row0 + ai * HALF + m * 16);
#pragma unroll
                for (int bj = 0; bj < 2; ++bj) {
                    const int col = col0 + bj * HALF;
                    const u32x4 g = *(const u32x4*)(P + row * INC + goff + col);
                    const f32x4 a0 = acc[ai][bj][m][0], a1 = acc[ai][bj][m][1];
                    float o[8] = {bflo(g.x) * a0[0], bfhi(g.x) * a0[1], bflo(g.y) * a0[2], bfhi(g.y) * a0[3], bflo(g.z) * a1[0], bfhi(g.z) * a1[1], bflo(g.w) * a1[2], bfhi(g.w) * a1[3]};
                    if (mode) { const u32x4 t = *(const u32x4*)(T1 + row * D + col);
                        o[0] += bflo(t.x); o[1] += bfhi(t.x); o[2] += bflo(t.y); o[3] += bfhi(t.y); o[4] += bflo(t.z); o[5] += bfhi(t.z); o[6] += bflo(t.w); o[7] += bfhi(t.w); }
                    u32x4 w; w.x = pk2(o[0], o[1]); w.y = pk2(o[2], o[3]); w.z = pk2(o[4], o[5]); w.w = pk2(o[6], o[7]);
                    if (mode) st16w(MM + row * D + col, w); else *(u32x4*)(T1 + row * D + col) = w;
                }
            }
    }
};
struct EpiResid {
    static constexpr bool PERM = true, AFTER_DRAIN = false;
    bf16* H; const float* gate; const bf16* base; const float* base32;
    __device__ __forceinline__ void operator()(const f32x4 (&acc)[2][2][4][2], const Unit& u, int wr, int wc, int fr, int fq) const {
        const int row0 = u.pm * BM + wr * 64 + fr, col0 = u.pn * BM + wc * 32 + 8 * fq;
        const float* gv = gate + (size_t)(u.pm < 32 ? 0 : (u.pm < 64 ? 1 : 2)) * 6 * D;
        f32x4 g4[2][2];
#pragma unroll
        for (int bj = 0; bj < 2; ++bj)
#pragma unroll
            for (int n = 0; n < 2; ++n) g4[bj][n] = *(const f32x4*)(gv + col0 + bj * HALF + 4 * n);
#pragma unroll
        for (int ai = 0; ai < 2; ++ai)
#pragma unroll
            for (int m = 0; m < 4; ++m) { const size_t ro = (size_t)(row0 + ai * HALF + m * 16) * D + col0;
#pragma unroll
                for (int bj = 0; bj < 2; ++bj) { const size_t off = ro + bj * HALF;
                    f32x4 b0, b1;
                    if (base32) { b0 = *(const f32x4*)(base32 + off); b1 = *(const f32x4*)(base32 + off + 4); }
                    else { const u32x4 hb = *(const u32x4*)(base + off); b0 = (f32x4){bflo(hb.x), bfhi(hb.x), bflo(hb.y), bfhi(hb.y)}; b1 = (f32x4){bflo(hb.z), bfhi(hb.z), bflo(hb.w), bfhi(hb.w)}; }
                    const f32x4 o0 = b0 + g4[bj][0] * acc[ai][bj][m][0], o1 = b1 + g4[bj][1] * acc[ai][bj][m][1];
                    u32x4 w; w.x = pk2(o0[0], o0[1]); w.y = pk2(o0[2], o0[3]); w.z = pk2(o1[0], o1[1]); w.w = pk2(o1[2], o1[3]);
                    st16w(H + off, w); } }
    }
};
struct EpiSwiGLU {
    static constexpr bool PERM = true, AFTER_DRAIN = false;
    bf16* HID; int ldh; int wt;
    __device__ __forceinline__ void operator()(const f32x4 (&acc)[2][2][4][2], const Unit& u, int wr, int wc, int fr, int fq) const {
        const int row0 = u.pm * BM + wr * 64 + fr, col0 = u.pn * HALF + wc * 32 + 8 * fq;
#pragma unroll
        for (int ai = 0; ai < 2; ++ai)
#pragma unroll
            for (int m = 0; m < 4; ++m) {
                const f32x4 g0 = acc[ai][0][m][0], g1 = acc[ai][0][m][1], u0 = acc[ai][1][m][0], u1 = acc[ai][1][m][1];
                u32x4 w; w.x = pk2(fsilu(g0[0]) * u0[0], fsilu(g0[1]) * u0[1]); w.y = pk2(fsilu(g0[2]) * u0[2], fsilu(g0[3]) * u0[3]);
                w.z = pk2(fsilu(g1[0]) * u1[0], fsilu(g1[1]) * u1[1]); w.w = pk2(fsilu(g1[2]) * u1[2], fsilu(g1[3]) * u1[3]);
                bf16* dst = HID + (size_t)(row0 + ai * HALF + m * 16) * ldh + col0;
                if (wt) asm volatile("global_store_dwordx4 %0, %1, off sc1\n\ts_nop 1" :: "v"(dst), "v"(w) : "memory");
                else st16w(dst, w);
            }
    }
};
struct EpiPlain {
    static constexpr bool PERM = true, AFTER_DRAIN = false;
    bf16* O; int ldc;
    __device__ __forceinline__ void operator()(const f32x4 (&acc)[2][2][4][2], const Unit& u, int wr, int wc, int fr, int fq) const {
        const int row0 = u.pm * BM + wr * 64 + fr, col0 = u.pn * BM + wc * 32 + 8 * fq;
#pragma unroll
        for (int ai = 0; ai < 2; ++ai)
#pragma unroll
            for (int m = 0; m < 4; ++m) { bf16* rowp = O + (size_t)(row0 + ai * HALF + m * 16) * ldc + col0;
#pragma unroll
                for (int bj = 0; bj < 2; ++bj) { const f32x4 v0 = acc[ai][bj][m][0], v1 = acc[ai][bj][m][1];
                    u32x4 w; w.x = pk2(v0[0], v0[1]); w.y = pk2(v0[2], v0[3]); w.z = pk2(v1[0], v1[1]); w.w = pk2(v1[2], v1[3]);
                    st16w(rowp + bj * HALF, w); } }
    }
};
#ifndef PG8_B_AUX
#define PG8_B_AUX 0
#endif
#ifndef PG8_A_AUX
#define PG8_A_AUX 0
#endif
template <class Epi, class Sched, bool ALIGN_EPI = false, bool SP2 = false>
__device__ __forceinline__ void gemm_phase(PG8_LAS unsigned char* lds, const Gemm g, const Sched& S, const Epi& E) {
    int tid_ = threadIdx.x; asm volatile("" : "+v"(tid_));
    const int tid = tid_, wid = __builtin_amdgcn_readfirstlane(tid >> 6), lane = tid & 63, wr = wid >> 2, wc = wid & 3, fr = lane & 15, fq = lane >> 4;
    const int K = g.K, nt = K / BK;
    unsigned voffA[2], voffB[2];
#pragma unroll
    for (int i = 0; i < 2; ++i) { int R, C; stage_rc(tid * 16 + i * 8192, R, C); const int Rb = Epi::PERM ? ((R & ~31) + perm32(R & 31)) : R;
        voffA[i] = (unsigned)(R * K + C) * 2u; voffB[i] = (unsigned)(Rb * K + C) * 2u; }
    unsigned vAc[2][2] = {{0u, 0u}, {0u, 0u}}, vAn[2][2] = {{0u, 0u}, {0u, 0u}};
#define PG8_SETA(v, u) do { if constexpr (Sched::GATHER) { _Pragma("unroll") for (int h_ = 0; h_ < 2; ++h_) _Pragma("unroll") for (int i_ = 0; i_ < 2; ++i_) { \
        int R_, C_; stage_rc(tid * 16 + i_ * 8192, R_, C_); int tok_ = S.arow[(u).pm * BM + h_ * HALF + R_]; tok_ = tok_ < 0 ? 0 : tok_; (v)[h_][i_] = (unsigned)(tok_ * K + C_) * 2u; } } } while (0)
#define PG8_STAGE_A(bufoff, h, ptr, nsel) do { if constexpr (Sched::GATHER) { if (nsel) PG8_STAGE_X(bufoff, ptr, vAn[h], PG8_A_AUX); else PG8_STAGE_X(bufoff, ptr, vAc[h], PG8_A_AUX); } \
        else PG8_STAGE_X(bufoff, (ptr) + (h) * hstep, voffA, PG8_A_AUX); } while (0)
    const size_t kstep = (size_t)(BK * 2);
    const size_t hstep = (size_t)HALF * K * 2;
    const size_t tstep = 2 * hstep;
    const unsigned ldsw = (unsigned)wid * 1024u;
    const int aoff = lds_byte(wr * 64 + fr, fq * 8), boff = lds_byte(wc * 32 + fr, fq * 8);
#define PG8_SA(b, h) (((b) * 2 + (h)) * HTB)
#define PG8_SB(b, h) ((4 + (b) * 2 + (h)) * HTB)
#define PG8_STAGE_X(bufoff, gbase, voff, aux) do { _Pragma("unroll") for (int _i = 0; _i < 2; ++_i) \
        __builtin_amdgcn_global_load_lds((const unsigned*)((const char*)(gbase) + (voff)[_i]), (PG8_LAS unsigned*)(lds + (bufoff) + ldsw + _i * 8192), 16, 0, aux); } while (0)
#define PG8_STAGE(bufoff, gbase, voff) PG8_STAGE_X(bufoff, gbase, voff, PG8_B_AUX)
#define PG8_LDA(dst, b, h) do { _Pragma("unroll") for (int m = 0; m < 4; ++m) _Pragma("unroll") for (int k = 0; k < 2; ++k) dst[m][k] = *(const PG8_LAS bf16x8*)(lds + PG8_SA(b, h) + aoff + m * 2048 + k * 1024); } while (0)
#define PG8_LDB(dst, b, h) do { _Pragma("unroll") for (int n = 0; n < 2; ++n) _Pragma("unroll") for (int k = 0; k < 2; ++k) dst[n][k] = *(const PG8_LAS bf16x8*)(lds + PG8_SB(b, h) + boff + n * 2048 + k * 1024); } while (0)
#define PG8_MMA(ai, bj, At, Bt) do { __builtin_amdgcn_s_setprio(1); _Pragma("unroll") for (int m = 0; m < 4; ++m) _Pragma("unroll") for (int n = 0; n < 2; ++n) _Pragma("unroll") for (int k = 0; k < 2; ++k) \
        acc[ai][bj][m][n] = __builtin_amdgcn_mfma_f32_16x16x32_bf16(Bt[n][k], At[m][k], acc[ai][bj][m][n], 0, 0, 0); __builtin_amdgcn_s_setprio(0); } while (0)
#define PG8_WAIT_V(n) asm volatile("s_waitcnt vmcnt(" #n ")" ::: "memory")
#define PG8_WAIT_L(n) asm volatile("s_waitcnt lgkmcnt(" #n ")" ::: "memory")
#define PG8_BAR __builtin_amdgcn_s_barrier()
#define PG8_SCHED __builtin_amdgcn_sched_barrier(0)
    Unit cur, nxt; int ui = 0;
    if (!S.next(0, cur)) return;
    f32x4 acc[2][2][4][2];
#pragma unroll
    for (int a = 0; a < 2; ++a)
#pragma unroll
        for (int b = 0; b < 2; ++b)
#pragma unroll
            for (int m = 0; m < 4; ++m)
#pragma unroll
                for (int n = 0; n < 2; ++n) acc[a][b][m][n] = (f32x4){0.f, 0.f, 0.f, 0.f};
    bf16x8 At[4][2], B0[2][2], B1[2][2];
    const char* cA = Sched::GATHER ? (const char*)g.A : (const char*)g.A + (size_t)cur.pm * tstep; PG8_SETA(vAc, cur); const char* cB = (const char*)g.Bt + S.boff(cur) + (size_t)cur.pn * tstep;
    S.a_ready(cur);
    if constexpr (SP2) {
        PG8_STAGE(PG8_SB(0, 0), cB, voffB); PG8_STAGE(PG8_SB(0, 1), cB + hstep, voffB); PG8_STAGE_A(PG8_SA(0, 0), 0, cA, false); PG8_STAGE_A(PG8_SA(0, 1), 1, cA, false);
        if (wr == 1) PG8_BAR;
        PG8_WAIT_V(2); PG8_BAR;
        PG8_STAGE(PG8_SB(1, 0), cB + kstep, voffB); PG8_STAGE_A(PG8_SA(1, 0), 0, cA + kstep, false); PG8_STAGE(PG8_SB(1, 1), cB + hstep + kstep, voffB);
        PG8_WAIT_V(6); PG8_BAR;
    } else {
        PG8_STAGE(PG8_SB(0, 0), cB, voffB); PG8_STAGE_A(PG8_SA(0, 0), 0, cA, false); PG8_STAGE(PG8_SB(0, 1), cB + hstep, voffB); PG8_STAGE_A(PG8_SA(0, 1), 1, cA, false);
        if (wr == 1) PG8_BAR;
        PG8_WAIT_V(4); PG8_BAR;
        PG8_STAGE(PG8_SB(1, 0), cB + kstep, voffB); PG8_STAGE_A(PG8_SA(1, 0), 0, cA + kstep, false); PG8_STAGE(PG8_SB(1, 1), cB + hstep + kstep, voffB);
        PG8_WAIT_V(6); PG8_BAR;
    }
    for (;;) {
        const bool has_next = S.next(ui + 1, nxt);
        const char* nA = Sched::GATHER ? (const char*)g.A : (has_next ? (const char*)g.A + (size_t)nxt.pm * tstep : cA);
        if constexpr (Sched::GATHER) { if (has_next) PG8_SETA(vAn, nxt); else { _Pragma("unroll") for (int h_ = 0; h_ < 2; ++h_) { vAn[h_][0] = vAc[h_][0]; vAn[h_][1] = vAc[h_][1]; } }
            *(PG8_LAS u32x4*)(lds + STAGE_BYTES + tid * 16) = (u32x4){vAn[0][0], vAn[0][1], vAn[1][0], vAn[1][1]}; }     const char* nB = has_next ? (const char*)g.Bt + S.boff(nxt) + (size_t)nxt.pn * tstep : cB;
        for (int t = 0; t < nt; t += 2) {
            const bool last = (t == nt - 2);
            const char* a1 = cA + (size_t)(t + 1) * kstep;
            const char* a2 = last ? nA : cA + (size_t)(t + 2) * kstep; const char* b2 = last ? nB : cB + (size_t)(t + 2) * kstep;
            const char* a3 = a2 + kstep; const char* b3 = b2 + kstep;
            if (last && has_next) S.a_ready(nxt);
            if constexpr (Sched::GATHER) { if (last) { const u32x4 pv_ = *(const PG8_LAS u32x4*)(lds + STAGE_BYTES + tid * 16); vAn[0][0] = pv_.x; vAn[0][1] = pv_.y; vAn[1][0] = pv_.z; vAn[1][1] = pv_.w; } }
            if constexpr (SP2) {
            PG8_LDB(B0, 0, 0); PG8_LDB(B1, 0, 1); PG8_SCHED; PG8_LDA(At, 0, 0); PG8_STAGE_A(PG8_SA(1, 1), 1, a1, false);
            PG8_WAIT_V(8); PG8_WAIT_L(0); PG8_BAR; PG8_MMA(0, 0, At, B0); PG8_MMA(0, 1, At, B1); PG8_BAR; PG8_SCHED;
            PG8_LDA(At, 0, 1); PG8_STAGE(PG8_SB(0, 0), b2, voffB); PG8_STAGE(PG8_SB(0, 1), b2 + hstep, voffB); PG8_STAGE_A(PG8_SA(0, 0), 0, a2, last);
            PG8_WAIT_V(8); PG8_WAIT_L(0); PG8_BAR; PG8_MMA(1, 0, At, B0); PG8_MMA(1, 1, At, B1); PG8_BAR; PG8_SCHED;
            PG8_LDB(B0, 1, 0); PG8_LDB(B1, 1, 1); PG8_SCHED; PG8_LDA(At, 1, 0); PG8_STAGE_A(PG8_SA(0, 1), 1, a2, last);
            PG8_WAIT_V(8); PG8_WAIT_L(0); PG8_BAR; PG8_MMA(0, 0, At, B0); PG8_MMA(0, 1, At, B1); PG8_BAR; PG8_SCHED;
            PG8_LDA(At, 1, 1); PG8_STAGE(PG8_SB(1, 0), b3, voffB); PG8_STAGE(PG8_SB(1, 1), b3 + hstep, voffB); PG8_STAGE_A(PG8_SA(1, 0), 0, a3, last);
            PG8_WAIT_V(8); PG8_WAIT_L(0); PG8_BAR; PG8_MMA(1, 0, At, B0); PG8_MMA(1, 1, At, B1); PG8_BAR; PG8_SCHED;
            } else {
            PG8_LDB(B0, 0, 0); PG8_SCHED; PG8_LDA(At, 0, 0); PG8_STAGE_A(PG8_SA(1, 1), 1, a1, false);
            PG8_WAIT_L(8); PG8_BAR; PG8_WAIT_L(0); PG8_MMA(0, 0, At, B0); PG8_BAR; PG8_SCHED;
            PG8_LDB(B1, 0, 1); PG8_STAGE(PG8_SB(0, 0), b2, voffB);
            PG8_BAR; PG8_WAIT_L(0); PG8_MMA(0, 1, At, B1); PG8_BAR;
            PG8_LDA(At, 0, 1); PG8_STAGE_A(PG8_SA(0, 0), 0, a2, last);
            PG8_BAR; PG8_WAIT_L(0); PG8_MMA(1, 0, At, B0); PG8_BAR; PG8_SCHED;
            PG8_STAGE(PG8_SB(0, 1), b2 + hstep, voffB);
            PG8_WAIT_V(6); PG8_BAR; PG8_MMA(1, 1, At, B1); PG8_BAR;
            PG8_LDB(B0, 1, 0); PG8_SCHED; PG8_LDA(At, 1, 0); PG8_STAGE_A(PG8_SA(0, 1), 1, a2, last);
            PG8_WAIT_L(8); PG8_BAR; PG8_WAIT_L(0); PG8_MMA(0, 0, At, B0); PG8_BAR; PG8_SCHED;
            PG8_LDB(B1, 1, 1); PG8_STAGE(PG8_SB(1, 0), b3, voffB);
            PG8_BAR; PG8_WAIT_L(0); PG8_MMA(0, 1, At, B1); PG8_BAR;
            PG8_LDA(At, 1, 1); PG8_STAGE_A(PG8_SA(1, 0), 0, a3, last);
            PG8_BAR; PG8_WAIT_L(0); PG8_MMA(1, 0, At, B0); PG8_BAR; PG8_SCHED;
            PG8_STAGE(PG8_SB(1, 1), b3 + hstep, voffB);
            PG8_WAIT_V(6); PG8_BAR; PG8_MMA(1, 1, At, B1); PG8_BAR;
            }
        }
        if constexpr (ALIGN_EPI) { if (wr == 0) PG8_BAR; }
        if constexpr (!Epi::AFTER_DRAIN) { E(acc, cur, wr, wc, fr, fq); S.done(cur); }
        if (!has_next) break;
#pragma unroll
        for (int a = 0; a < 2; ++a)
#pragma unroll
            for (int b = 0; b < 2; ++b)
#pragma unroll
                for (int m = 0; m < 4; ++m)
#pragma unroll
                    for (int n = 0; n < 2; ++n) acc[a][b][m][n] = (f32x4){0.f, 0.f, 0.f, 0.f};
        cur = nxt; cA = nA; cB = nB; ++ui;
        if constexpr (Sched::GATHER) { const u32x4 pv_ = *(const PG8_LAS u32x4*)(lds + STAGE_BYTES + tid * 16); vAc[0][0] = pv_.x; vAc[0][1] = pv_.y; vAc[1][0] = pv_.z; vAc[1][1] = pv_.w; }
        if constexpr (ALIGN_EPI) { if (wr == 1) PG8_BAR; }
    }
    PG8_WAIT_V(0);
    if constexpr (!ALIGN_EPI) { if (wr == 0) PG8_BAR; }
    PG8_BAR;
    if constexpr (Epi::AFTER_DRAIN) { E.fused(acc, cur, wr, wc, fr, fq, lds, wid, lane); S.done(cur); }
#undef PG8_SA
#undef PG8_SB
#undef PG8_STAGE
#undef PG8_STAGE_A
#undef PG8_SETA
#undef PG8_LDA
#undef PG8_LDB
#undef PG8_MMA
#undef PG8_WAIT_V
#undef PG8_WAIT_L
#undef PG8_BAR
#undef PG8_SCHED
}

}

constexpr int NWAVES = 8;
constexpr int RING_OFF = 0;
constexpr int TR_WAVE_BYTES = 64 * 65 * 4;
constexpr int SVEC_OFF = NWAVES * TR_WAVE_BYTES;
constexpr int LDSCTL_OFF = 147456 - 512, LDS_BYTES = 147456;
static_assert(SVEC_OFF + 3 * D * 4 <= LDSCTL_OFF, "LDS map");

#define RLX_AGENT __ATOMIC_RELAXED, __HIP_MEMORY_SCOPE_AGENT
#define XB_TMO      128
#define XB_XCNT(j)  (256  + 64 * (j))
#define XB_XSUB(j)  (1280 + 64 * (j))
#define XB_XGEN(j)  (2304 + 64 * (j))
#define XB_TOP      3328
#define XB_TOPGEN   3392
#define XCD_BAR_WORDS 3456
#define XB_SPIN_CAP (1u << 18)
#ifndef XB_EARLYWB
#define XB_EARLYWB 0
#endif

__device__ __forceinline__ unsigned xb_ld(unsigned* p)              { return __hip_atomic_load(p, __ATOMIC_RELAXED, __HIP_MEMORY_SCOPE_AGENT); }
__device__ __forceinline__ unsigned xb_add(unsigned* p, unsigned v) {
    unsigned one; asm volatile("v_mov_b32 %0, 1" : "=v"(one)); (void)v;
    return __hip_atomic_fetch_add(p, one, __ATOMIC_RELAXED, __HIP_MEMORY_SCOPE_AGENT); }
__device__ __forceinline__ unsigned xb_xcc_id() { return (unsigned)__builtin_amdgcn_s_getreg((3 << 11) | 20) & 0xFu; }
#define XB_SPIN(cond, bar) do { unsigned _sp = 0; while (cond) { __builtin_amdgcn_s_sleep(1); \
    if ((++_sp & 255u) == 0u) { if (xb_ld(&(bar)[XB_TMO])) break; if (_sp > XB_SPIN_CAP) { (void)xb_add(&(bar)[XB_TMO], 1u); break; } } } } while (0)

struct XcdBarrier {
    unsigned* bar; unsigned x;
    volatile LAS unsigned* st;
};

__device__ __forceinline__ XcdBarrier xcd_barrier_post(unsigned* bar, volatile LAS unsigned* st) {
    XcdBarrier b; b.bar = bar; b.x = xb_xcc_id(); b.st = st;
    if (threadIdx.x == 0) (void)xb_add(&bar[XB_XCNT(b.x)], 1u);
    return b;
}
__device__ __forceinline__ void xcd_barrier_complete(unsigned* bar, unsigned x, unsigned& nloc, unsigned& nx) {
    const unsigned G = gridDim.x * gridDim.y * gridDim.z;
    unsigned sum, cnt, mine, sp = 0u;
    for (;;) {
        sum = 0u; cnt = 0u; mine = 0u;
#pragma unroll
        for (unsigned j = 0; j < 16; ++j) { const unsigned c = xb_ld(&bar[XB_XCNT(j)]); sum += c; cnt += (c > 0u) ? 1u : 0u; mine = (j == x) ? c : mine; }
        if (sum == G) break;
        __builtin_amdgcn_s_sleep(1);
        if ((++sp & 255u) == 0u) { if (xb_ld(&bar[XB_TMO])) break; if (sp > XB_SPIN_CAP) { (void)xb_add(&bar[XB_TMO], 1u); break; } }
    }
    nloc = mine > 0u ? mine : 1u; nx = cnt > 0u ? cnt : 1u;
}

__device__ __forceinline__ void xcd_barrier(const XcdBarrier& b) {
    asm volatile("s_waitcnt vmcnt(0)" ::: "memory");
    __syncthreads();
    if (threadIdx.x == 0) {
        unsigned* bar = b.bar;
        __builtin_amdgcn_s_waitcnt(0);
        unsigned nloc = b.st[0], nx = b.st[1];
        if (nloc == 0u) { xcd_barrier_complete(bar, b.x, nloc, nx); b.st[0] = nloc; b.st[1] = nx; }
#if XB_EARLYWB
        __builtin_amdgcn_fence(__ATOMIC_RELEASE, "agent");
        asm volatile("s_waitcnt vmcnt(0)" ::: "memory");
#endif
        const unsigned old = xb_add(&bar[XB_XSUB(b.x)], 1u);
        const unsigned gen = old / nloc;
        if (old + 1u == (gen + 1u) * nloc) {
            __builtin_amdgcn_fence(__ATOMIC_RELEASE, "agent");
            asm volatile("s_waitcnt vmcnt(0)" ::: "memory");
            const unsigned og = xb_add(&bar[XB_TOP], 1u);
            const unsigned tg = og / nx;
            if (og + 1u == (tg + 1u) * nx) xb_add(&bar[XB_TOPGEN], 1u);
            else XB_SPIN(xb_ld(&bar[XB_TOPGEN]) == tg, bar);
            __builtin_amdgcn_fence(__ATOMIC_ACQUIRE, "agent");
            xb_add(&bar[XB_XGEN(b.x)], 1u);
            asm volatile("s_waitcnt vmcnt(0)" ::: "memory");
        } else {
            XB_SPIN(xb_ld(&bar[XB_XGEN(b.x)]) == gen, bar);
            __builtin_amdgcn_fence(__ATOMIC_ACQUIRE, "agent");
            asm volatile("s_waitcnt vmcnt(0)" ::: "memory");
        }
    }
    __syncthreads();
}


__device__ __forceinline__ float bperm(float v, int src) { return __builtin_bit_cast(float, __builtin_amdgcn_ds_bpermute(src << 2, __builtin_bit_cast(int, v))); }
__device__ __forceinline__ int bpermi(int v, int src) { return __builtin_amdgcn_ds_bpermute(src << 2, v); }
__device__ __forceinline__ float wsum(float v, int lane) {
#pragma unroll
    for (int o = 1; o < 64; o <<= 1) v += bperm(v, lane ^ o);
    return v;
}
struct Args { const float* in[28]; float* out; unsigned char* ws; int ph_lo, ph_hi, flags, bar_idx; };
typedef const __attribute__((address_space(4))) Args CArgs;
struct Frame {
    LAS unsigned char* lds; volatile LAS unsigned* MISC;
    unsigned* ctl; unsigned char* ws;
    int tid, lane, wave, vcu, G, bx; long zo;
};

__device__ __forceinline__ void tr_item(const float* src, int ld, int k0, int c0, bf16* dst, int Kd, int n0, bool qkperm, LAS float* scr, int lane, float scale = 1.f) {
    const float* s = src + (size_t)k0 * ld + c0;
    const int kr = lane >> 4, nq = lane & 15;
#pragma unroll 4
    for (int i = 0; i < 16; ++i) { const int k = 4 * i + kr; const f32x4 v = __builtin_nontemporal_load((const f32x4*)(s + (size_t)k * ld + 4 * nq));
        LAS float* d = scr + k * 65 + 4 * nq; d[0] = v[0]; d[1] = v[1]; d[2] = v[2]; d[3] = v[3]; }
    asm volatile("s_waitcnt lgkmcnt(0)" ::: "memory");
    const int c = lane & 7;
#pragma unroll
    for (int j = 0; j < 8; ++j) { const int n = (lane >> 3) + 8 * j; const int sc_ = qkperm ? ((n & 1) * 32 + (n >> 1)) : n; const LAS float* p = scr + (8 * c) * 65 + sc_;
        u32x4 o; o.x = pk2(p[0] * scale, p[65] * scale); o.y = pk2(p[130] * scale, p[195] * scale); o.z = pk2(p[260] * scale, p[325] * scale); o.w = pk2(p[390] * scale, p[455] * scale);
        __builtin_nontemporal_store(o, (u32x4*)(dst + (size_t)(n0 + n) * Kd + k0 + 8 * c)); }
    asm volatile("s_waitcnt lgkmcnt(0)" ::: "memory");
}
constexpr int TI_WIN = 4 * 16 * 88, TI_GT = 4 * 2 * 2 * 8 * 4, TI_WO = 4 * 3 * 256, TI_FGU = 2 * 16 * 88, TI_FD = 2 * 44 * 16, TI_EGU = 16 * 16 * 112, TI_ED = 16 * 56 * 16;
constexpr int TI_TOTAL = TI_WIN + TI_GT + TI_WO + TI_FGU + TI_FD + TI_EGU + TI_ED, MOD_ITEMS = 4 * 96;

__device__ __forceinline__ void conv_item(Frame& F, const Args& a, int it, LAS float* scr, int lane) {
    unsigned char* ws = F.ws;
    int r = it;
    do {
        if (r < TI_WIN) { const int l = r / (16 * 88), q = r % (16 * 88), kt = q / 88, nt = q % 88;
            tr_item((a.in[8] + F.zo) + (size_t)l * D * INC, INC, 64 * kt, 64 * nt, (bf16*)(ws + WS_WIN) + (size_t)l * INC * D, D, 64 * nt, nt < 20, scr, lane); break; }
        r -= TI_WIN;
        if (r < TI_GT) { const int tl = r & 3, m = r >> 2, h = m & 7, gx = (m >> 3) & 1, d = (m >> 4) & 1, l = m >> 5;
            const float* src = (gx ? (a.in[14] + F.zo) : (a.in[12] + F.zo)) + (size_t)((l * 2 + d) * 8 + h) * 128 * 128;
            bf16* dst = (bf16*)(ws + WS_GT) + (size_t)((l * 8 + h) * 4 + 2 * d + gx) * 128 * 128;
            tr_item(src, 128, 64 * (tl >> 1), 64 * (tl & 1), dst, 128, 64 * (tl & 1), false, scr, lane, -1.4426950408889634f); break; }
        r -= TI_GT;
        if (r < TI_WO) { const int mi = r / 256, q = r % 256, kt = q / 16, nt = q % 16, l = mi / 3, w = mi % 3;
            const float* src = (w == 0 ? (a.in[17] + F.zo) : (w == 1 ? (a.in[18] + F.zo) : (a.in[19] + F.zo))) + (size_t)l * D * D;
            tr_item(src, D, 64 * kt, 64 * nt, (bf16*)(ws + WS_WO) + (size_t)mi * D * D, D, 64 * nt, false, scr, lane); break; }
        r -= TI_WO;
        if (r < TI_FGU) { const int i = r / (16 * 88), q = r % (16 * 88), kt = q / 88, nt = q % 88;
            const int pn = nt >> 2, bj = (nt >> 1) & 1, hf = nt & 1;
            const float* src = (bj ? (a.in[21] + F.zo) : (a.in[20] + F.zo)) + (size_t)i * D * DFF;
            tr_item(src, DFF, 64 * kt, 128 * pn + 64 * hf, (bf16*)(ws + WS_FF + i * FF_STRIDE), D, 64 * nt, false, scr, lane); break; }
        r -= TI_FGU;
        if (r < TI_FD) { const int i = r / (44 * 16), q = r % (44 * 16), kt = q / 16, nt = q % 16;
            tr_item((a.in[22] + F.zo) + (size_t)i * DFF * D, D, 64 * kt, 64 * nt, (bf16*)(ws + WS_FF + i * FF_STRIDE) + (size_t)2 * DFF * D, DFF, 64 * nt, false, scr, lane); break; }
        r -= TI_FD;
        if (r < TI_EGU) { const int ie = r / (16 * 112), q = r % (16 * 112), kt = q / 112, nt = q % 112, i = ie >> 3, e = ie & 7;
            const int pn = nt >> 2, bj = (nt >> 1) & 1, hf = nt & 1;
            const float* src = (bj ? (a.in[25] + F.zo) : (a.in[24] + F.zo)) + (size_t)ie * D * DFE;
            tr_item(src, DFE, 64 * kt, 128 * pn + 64 * hf, (bf16*)(ws + WS_EXP + i * EXP_STRIDE) + (size_t)e * 2 * DFE * D, D, 64 * nt, false, scr, lane); break; }
        r -= TI_EGU;
        { const int ie = r / (56 * 16), q = r % (56 * 16), kt = q / 16, nt = q % 16, i = ie >> 3, e = ie & 7;
            tr_item((a.in[26] + F.zo) + (size_t)ie * DFE * D, D, 64 * kt, 64 * nt, (bf16*)(ws + WS_EXP + i * EXP_STRIDE) + (size_t)NE * 2 * DFE * D + (size_t)e * D * DFE, DFE, 64 * nt, false, scr, lane); }
    } while (0);
}
#ifndef DEFER_CONV
#define DEFER_CONV 0
#endif
constexpr int TI_DEF_GU = DEFER_CONV ? 8 * 16 * 112 : 0, TI_DEF_D = DEFER_CONV ? 8 * 56 * 16 : 0, TI_DEF = TI_DEF_GU + TI_DEF_D;
constexpr int TI_B_EGU = TI_WIN + TI_GT + TI_WO + TI_FGU + TI_FD, TI_B_ED = TI_B_EGU + TI_EGU;
__device__ __forceinline__ void conv_drain(Frame& F, const Args& a, int quota) {
    if (!DEFER_CONV) return;
    LAS float* scr = (LAS float*)(F.lds + F.wave * TR_WAVE_BYTES);
    for (int n = 0; n < quota; ++n) {
        unsigned q = 0;
        if (F.lane == 0) q = __hip_atomic_fetch_add(F.ctl + CW_Q, 1u, __ATOMIC_RELAXED, __HIP_MEMORY_SCOPE_AGENT);
        q = (unsigned)__builtin_amdgcn_readfirstlane((int)q);
        if (q >= (unsigned)TI_DEF) break;
        conv_item(F, a, (int)q < TI_DEF_GU ? TI_B_EGU + TI_DEF_GU + (int)q : TI_B_ED + TI_DEF_D + ((int)q - TI_DEF_GU), scr, F.lane);
    }
}
__device__ __forceinline__ void ph_prologue(Frame& F, const Args& a) {
    LAS float* scr = (LAS float*)(F.lds + F.wave * TR_WAVE_BYTES);
    LAS float* sv = (LAS float*)(F.lds + SVEC_OFF);
    for (int i = F.tid; i < 3 * D; i += NWAVES * 64) { const int v = i >> 10, k = i & (D - 1); const float x = v < 2 ? (a.in[1] + F.zo)[v * D + k] : (a.in[3] + F.zo)[k]; sv[i] = x * fsigm(x); }
    __syncthreads();
    const int gw = F.vcu * NWAVES + F.wave, NGW = F.G * NWAVES, lane = F.lane;
    unsigned char* ws = F.ws;
    if (gw == NGW - 1) { f32x2* rt = (f32x2*)(ws + WS_ROPE);
        for (int e = lane; e < 128 * 32; e += 64) { const int pos = e >> 5, i = e & 31; const float ang = (float)pos * powf(10000.f, -(float)i / 32.f); rt[e] = (f32x2){cosf(ang), sinf(ang)}; } }
    for (int it = NGW - 2 - gw; it >= 0 && it < MOD_ITEMS; it += NGW) {
        const int l = it / 96, n = (it % 96) * 64 + lane;
        const float* w = (a.in[4] + F.zo) + (size_t)l * D * 6 * D + n;
        float a0 = 0.f, a1 = 0.f, a2 = 0.f;
#pragma unroll 8
        for (int k = 0; k < D; ++k) { const float wv = w[(size_t)k * 6 * D]; a0 += sv[k] * wv; a1 += sv[D + k] * wv; a2 += sv[2 * D + k] * wv; }
        const float b = (a.in[5] + F.zo)[l * 6 * D + n];
        float* o = (float*)(ws + WS_MOD) + (size_t)l * 18 * D + n;
        o[0] = a0 + b; o[6 * D] = a1 + b; o[12 * D] = a2 + b;
    }
    for (int i = gw * 64 + lane; i < DEPTH * 2 * D; i += NGW * 64) ((f32x4*)(ws + WS_SPT))[i] = (f32x4){-1.4426950408889634f * (a.in[13] + F.zo)[i], -1.4426950408889634f * (a.in[15] + F.zo)[i], -8.f * 1.4426950408889634f * log1pf(expf(-(a.in[16] + F.zo)[i])), 0.f};
    for (int jt = gw; jt < TI_TOTAL - TI_DEF; jt += NGW) conv_item(F, a, jt < TI_B_EGU + TI_DEF_GU ? jt : jt + TI_DEF_GU, scr, lane);

}

__device__ __forceinline__ int rows_per_wave(int NGW) { return ML / NGW; }
template <int KIND, int NR> __device__ __forceinline__ void rows_block(Frame& F, const Args& a, int l, bool combine, bool moe, int m0, const f32x4 (&gm)[2][2], const f32x4 (&shv)[2][2], LAS const float* wr_l, LAS int* lcnt) {
    const int lane = F.lane; unsigned char* ws = F.ws;
    bf16* H = (bf16*)(ws + WS_H); bf16* XN = (bf16*)(ws + WS_XN);
    const int cbase = 8 * lane;
    f32x4 v[NR][2][2]; u32x4 q0[NR][2], q1[NR][2]; int sl0[NR], sl1[NR]; float tw0[NR], tw1[NR];
#pragma unroll
    for (int i = 0; i < NR; ++i) { const int m = m0 + i;
        if (KIND == 0 && l == 0) { const float* src = m < ML ? (a.in[0] + F.zo) + (size_t)m * D : (a.in[2] + F.zo) + (size_t)(m - ML) * D;
#pragma unroll
            for (int j = 0; j < 2; ++j) { v[i][j][0] = *(const f32x4*)(src + cbase + 512 * j); v[i][j][1] = *(const f32x4*)(src + cbase + 512 * j + 4); } }
        else {
#pragma unroll
            for (int j = 0; j < 2; ++j) { const u32x4 hb = *(const u32x4*)(H + (size_t)m * D + cbase + 512 * j);
                v[i][j][0] = (f32x4){bflo(hb.x), bfhi(hb.x), bflo(hb.y), bfhi(hb.y)}; v[i][j][1] = (f32x4){bflo(hb.z), bfhi(hb.z), bflo(hb.w), bfhi(hb.w)}; } }
        if (combine) { sl0[i] = ((const int*)(ws + WS_TOKSLOT))[2 * m]; sl1[i] = ((const int*)(ws + WS_TOKSLOT))[2 * m + 1]; tw0[i] = ((const float*)(ws + WS_TW))[2 * m]; tw1[i] = ((const float*)(ws + WS_TW))[2 * m + 1]; } }
    if (combine) {
#pragma unroll
        for (int i = 0; i < NR; ++i) { const bf16* f0 = (const bf16*)(ws + WS_FS) + (size_t)sl0[i] * D + cbase; const bf16* f1 = (const bf16*)(ws + WS_FS) + (size_t)sl1[i] * D + cbase;
#pragma unroll
            for (int j = 0; j < 2; ++j) { q0[i][j] = *(const u32x4*)(f0 + 512 * j); q1[i][j] = *(const u32x4*)(f1 + 512 * j); } }
        const int lp = KIND == 0 ? l - 1 : DEPTH - 1;
        const float* g2 = (const float*)(ws + WS_MOD) + (size_t)lp * 18 * D + (size_t)row_vec(m0) * 6 * D + 5 * D + cbase;
        f32x4 gg[2][2];
#pragma unroll
        for (int j = 0; j < 2; ++j) { gg[j][0] = *(const f32x4*)(g2 + 512 * j); gg[j][1] = *(const f32x4*)(g2 + 512 * j + 4); }
#pragma unroll
        for (int i = 0; i < NR; ++i) { const float w0 = tw0[i], w1 = tw1[i];
#pragma unroll
            for (int j = 0; j < 2; ++j) { const u32x4 p0 = q0[i][j], p1 = q1[i][j];
                v[i][j][0][0] += gg[j][0][0] * (w0 * bflo(p0.x) + w1 * bflo(p1.x)); v[i][j][0][1] += gg[j][0][1] * (w0 * bfhi(p0.x) + w1 * bfhi(p1.x));
                v[i][j][0][2] += gg[j][0][2] * (w0 * bflo(p0.y) + w1 * bflo(p1.y)); v[i][j][0][3] += gg[j][0][3] * (w0 * bfhi(p0.y) + w1 * bfhi(p1.y));
                v[i][j][1][0] += gg[j][1][0] * (w0 * bflo(p0.z) + w1 * bflo(p1.z)); v[i][j][1][1] += gg[j][1][1] * (w0 * bfhi(p0.z) + w1 * bfhi(p1.z));
                v[i][j][1][2] += gg[j][1][2] * (w0 * bflo(p0.w) + w1 * bflo(p1.w)); v[i][j][1][3] += gg[j][1][3] * (w0 * bfhi(p0.w) + w1 * bfhi(p1.w)); }
            if (KIND != 2) {
#pragma unroll
                for (int j = 0; j < 2; ++j) { u32x4 hw; hw.x = pk2(v[i][j][0][0], v[i][j][0][1]); hw.y = pk2(v[i][j][0][2], v[i][j][0][3]); hw.z = pk2(v[i][j][1][0], v[i][j][1][1]); hw.w = pk2(v[i][j][1][2], v[i][j][1][3]); st16w<3>(H + (size_t)(m0 + i) * D + cbase + 512 * j, hw); }
            } }
    }
#pragma unroll
    for (int i = 0; i < NR; ++i) { const int m = m0 + i;
        float ss = 0.f;
#pragma unroll
        for (int j = 0; j < 2; ++j)
#pragma unroll
            for (int hf = 0; hf < 2; ++hf) { const f32x4 x = v[i][j][hf]; ss += (x[0] * x[0] + x[1] * x[1]) + (x[2] * x[2] + x[3] * x[3]); }
        ss = wsum(ss, lane);
        const float r = rsqrtf(ss * (1.f / D) + EPS);
        if (KIND == 2) {
#pragma unroll
            for (int j = 0; j < 2; ++j) { *(f32x4*)((a.out + F.zo) + (size_t)m * D + cbase + 512 * j) = v[i][j][0] * r * gm[j][0]; *(f32x4*)((a.out + F.zo) + (size_t)m * D + cbase + 512 * j + 4) = v[i][j][1] * r * gm[j][1]; }
        } else {
            float lg[NE];
#pragma unroll
            for (int e = 0; e < NE; ++e) lg[e] = 0.f;
#pragma unroll
            for (int j = 0; j < 2; ++j) {
                const f32x4 y0 = v[i][j][0] * (gm[j][0] * r) + shv[j][0], y1 = v[i][j][1] * (gm[j][1] * r) + shv[j][1];
                u32x4 ob; ob.x = pk2(y0[0], y0[1]); ob.y = pk2(y0[2], y0[3]); ob.z = pk2(y1[0], y1[1]); ob.w = pk2(y1[2], y1[3]);
                st16w<3>(XN + (size_t)m * D + cbase + 512 * j, ob);
                if (moe) {
#pragma unroll
                    for (int e = 0; e < NE; ++e) { const f32x4 w0 = *(const LAS f32x4*)(wr_l + ((e * 2 + j) * 2 + 0) * 256 + 4 * lane), w1 = *(const LAS f32x4*)(wr_l + ((e * 2 + j) * 2 + 1) * 256 + 4 * lane);
                        lg[e] += ((y0[0] * w0[0] + y0[1] * w0[1]) + (y0[2] * w0[2] + y0[3] * w0[3])) + ((y1[0] * w1[0] + y1[1] * w1[1]) + (y1[2] * w1[2] + y1[3] * w1[3])); }
                }
            }
            if (moe) {
#pragma unroll
                for (int e = 0; e < NE; ++e) lg[e] = wsum(lg[e], lane);
                int i0 = 0; float v0 = lg[0];
#pragma unroll
                for (int e = 1; e < NE; ++e) if (lg[e] > v0) { v0 = lg[e]; i0 = e; }
                int i1 = -1; float v1 = -INFINITY;
#pragma unroll
                for (int e = 0; e < NE; ++e) if (e != i0 && lg[e] > v1) { v1 = lg[e]; i1 = e; }
                if (lane == 0) {
                    const float e1 = expf(v1 - v0), w0 = 1.f / (1.f + e1), w1 = e1 / (1.f + e1);
                    int* te = (int*)(ws + WS_TE); float* tw = (float*)(ws + WS_TW);
                    te[2 * m] = i0; te[2 * m + 1] = i1; tw[2 * m] = w0; tw[2 * m + 1] = w1;
                    lcnt[F.wave * 8 + i0] += 1; lcnt[F.wave * 8 + i1] += 1;
                }
            }
        }
    }
}
template <int KIND> __device__ __forceinline__ void ph_rows(Frame& F, const Args& a, int l, bool combine) {
    const int gw = F.vcu * NWAVES + F.wave, NGW = F.G * NWAVES, lane = F.lane;
    unsigned char* ws = F.ws;
    const float* MOD = (const float*)(ws + WS_MOD);
    const bool moe = KIND == 1 && (l & 1);
    LAS float* wr_l = (LAS float*)(F.lds);
    LAS int* lcnt = (LAS int*)(F.lds + 32768);
    if (moe) {
        const float* wr = (a.in[23] + F.zo) + (size_t)(l >> 1) * D * NE;
        for (int i = F.tid; i < D * NE; i += NWAVES * 64) { const int k = i >> 3, e = i & 7; wr_l[((e * 2 + (k >> 9)) * 2 + ((k >> 2) & 1)) * 256 + ((k & 511) >> 3) * 4 + (k & 3)] = wr[i]; }
        if (F.tid < 64) lcnt[F.tid] = 0;
        __syncthreads();
    }
    const bool with_ctx = !(KIND == 2 || (KIND == 1 && l == DEPTH - 1));
    const float* gvec = (KIND == 0 ? (a.in[6] + F.zo) + l * D : (KIND == 1 ? (a.in[7] + F.zo) + l * D : (a.in[27] + F.zo))) + 8 * lane;
    const int RPW = rows_per_wave(NGW);
#pragma unroll 1
    for (int part = 0; part < 2; ++part) {
        if (part == 1 && !(with_ctx && gw < MC)) break;
        const int mfirst = part == 0 ? gw * RPW : ML + gw, vec = part == 0 ? mfirst / SEQ : 2;
        f32x4 gm[2][2], shv[2][2];
        const float* mv = MOD + (size_t)(KIND == 2 ? 0 : l) * 18 * D + (size_t)vec * 6 * D + (KIND == 0 ? 0 : 3 * D) + 8 * lane;
#pragma unroll
        for (int j = 0; j < 2; ++j)
#pragma unroll
            for (int hf = 0; hf < 2; ++hf) { const f32x4 g = *(const f32x4*)(gvec + 512 * j + 4 * hf);
                if (KIND == 2) { gm[j][hf] = g; shv[j][hf] = (f32x4){0.f, 0.f, 0.f, 0.f}; }
                else { gm[j][hf] = g * (*(const f32x4*)(mv + D + 512 * j + 4 * hf) + 1.f); shv[j][hf] = *(const f32x4*)(mv + 512 * j + 4 * hf); } }
        if (part == 0) { for (int r0 = 0; r0 < RPW; r0 += 4) rows_block<KIND, 4>(F, a, l, combine, moe, mfirst + r0, gm, shv, wr_l, lcnt); }
        else rows_block<KIND, 1>(F, a, l, combine, moe, mfirst, gm, shv, wr_l, lcnt);
    }
    if (moe) {
        asm volatile("s_waitcnt lgkmcnt(0)" ::: "memory");
        if (lane < NE) ((int*)(ws + WS_WCNT))[gw * 8 + lane] = lcnt[F.wave * 8 + lane];
    }
}

__device__ __forceinline__ void ph_lists(Frame& F, int l) {
    const int gw = F.vcu * NWAVES + F.wave, NGW = F.G * NWAVES, lane = F.lane;
    unsigned char* ws = F.ws;
    const int nrows = l == DEPTH - 1 ? ML : MT;
    const int* te = (const int*)(ws + WS_TE); int* tok_slot = (int*)(ws + WS_TOKSLOT); int* panel_e = (int*)(ws + WS_PANELE);
    int* slot_tok = (int*)(ws + WS_SLOTTOK);
    LAS int* wc = (LAS int*)(F.lds); LAS int* blk = wc + 16384; LAS int* segs = blk + 2048; LAS int* segp = segs + 64; LAS int* bb = segp + 64; LAS int* tot = bb + 8; LAS int* wpos = tot + 8;
    if (NGW * 8 == 8 * NWAVES * 64 * 4) {
        const u32x4* WC4 = (const u32x4*)(ws + WS_WCNT); u32x4 v[8];
#pragma unroll
        for (int j = 0; j < 8; ++j) v[j] = WC4[F.tid + NWAVES * 64 * j];
#pragma unroll
        for (int j = 0; j < 8; ++j) ((LAS u32x4*)wc)[F.tid + NWAVES * 64 * j] = v[j];
    } else { const int* WC = (const int*)(ws + WS_WCNT); for (int i = F.tid; i < NGW * 8; i += NWAVES * 64) wc[i] = WC[i]; }
    __syncthreads();
    for (int i = F.tid; i < F.G * 8; i += NWAVES * 64) { const int b = i >> 3, e = i & 7; int s = 0;
#pragma unroll
        for (int w = 0; w < 8; ++w) s += wc[(b * 8 + w) * 8 + e];
        blk[i] = s; }
    __syncthreads();
    if (F.tid < 64) { const int sg = F.tid >> 3, e = F.tid & 7; int s = 0, p = 0;
        for (int b = 32 * sg; b < 32 * sg + 32 && b < F.G; ++b) { const int v = blk[b * 8 + e]; s += v; p += b < F.vcu ? v : 0; }
        segs[F.tid] = s; segp[F.tid] = p; }
    __syncthreads();
    if (F.tid < NE) { int t = 0, bs = 0; const int ms = F.vcu >> 5;
#pragma unroll
        for (int sg = 0; sg < 8; ++sg) { const int v = segs[sg * 8 + F.tid]; t += v; bs += sg < ms ? v : (sg == ms ? segp[sg * 8 + F.tid] : 0); }
        tot[F.tid] = t; bb[F.tid] = bs; }
    __syncthreads();
    if (F.tid < 64) { const int w = F.tid >> 3, e = F.tid & 7; int s = bb[e]; for (int w2 = 0; w2 < w; ++w2) s += wc[((F.vcu * 8 + w2) * 8) + e]; wpos[F.tid] = s; }
    int cnt[NE], off[NE + 1];
    { int o = 0;
#pragma unroll
      for (int e = 0; e < NE; ++e) { cnt[e] = tot[e]; off[e] = o; o += (cnt[e] + 255) & ~255; }
      off[NE] = o; }
    __syncthreads();
    const int RPW = rows_per_wave(NGW), nmine = RPW + ((nrows == MT && gw < MC) ? 1 : 0);
    int tev = 0;
    if (lane < 2 * RPW) tev = te[2 * (gw * RPW) + lane]; else if (lane < 2 * RPW + 2 && nmine > RPW) tev = te[2 * (ML + gw) + (lane - 2 * RPW)];
    for (int ri = 0; ri < nmine; ++ri) { const int m = ri < RPW ? gw * RPW + ri : ML + gw;
        int s0 = 0, s1 = 0;
        const int e0_ = __builtin_amdgcn_readlane(tev, 2 * ri), e1_ = __builtin_amdgcn_readlane(tev, 2 * ri + 1);
        if (lane == 0) {
#pragma unroll
            for (int k = 0; k < 2; ++k) { const int e = k == 0 ? e0_ : e1_; const int pos = wpos[F.wave * 8 + e]; wpos[F.wave * 8 + e] = pos + 1; int o = 0;
#pragma unroll
                for (int x = 0; x < NE; ++x) o = (x == e) ? off[x] : o;
                const int slot = o + pos; tok_slot[2 * m + k] = slot; if (k == 0) s0 = slot; else s1 = slot; }
        }
        if (lane == 0) { slot_tok[s0] = m; slot_tok[s1] = m; }
    }
#pragma unroll
    for (int e = 0; e < NE; ++e) { const int base = off[e] + cnt[e], npad = off[e + 1] - base;
        for (int i = gw * 64 + lane; i < npad; i += NGW * 64) slot_tok[base + i] = -1; }
    if (F.bx == 0) { for (int p = F.tid; p < 256; p += NWAVES * 64) { int e = 0;
#pragma unroll
            for (int x = 1; x < NE; ++x) if (p * 256 >= off[x]) e = x;
            panel_e[p] = e; }
        if (F.tid == 0) panel_e[256] = off[NE] / 256; }
}

#ifndef ATT2
#define ATT2 2
#endif
#if ATT2 == 1
#ifndef A2_SD
#define A2_SD 2
#endif
#define A2_SO (A2_SD - 1)
constexpr int A2_V = 0, A2_K = 32768, A2_TILE = 16384;
typedef short s16x4 __attribute__((ext_vector_type(4)));
#define A2_SBAR() __builtin_amdgcn_sched_barrier(0)
__device__ __forceinline__ int a2_crow(int r, int hi) { return (r & 3) + 8 * (r >> 2) + 4 * hi; }
template <int OFF> __device__ __forceinline__ s16x4 a2_tr(unsigned vb) { s16x4 r; asm volatile("ds_read_b64_tr_b16 %0, %1 offset:%2" : "=&v"(r) : "v"(vb), "i"(OFF) : "memory"); return r; }
constexpr float A2_SCALE = 0.08838834764831845f, A2_C = 0.08838834764831845f * 1.4426950408889634f, A2_THR = 8.f / 0.08838834764831845f;
__device__ __forceinline__ void a2_qkt(f32x16& p0, f32x16& p1, const LAS unsigned char* Ks, const bf16x8 (&qr)[8], int r32, int hi) {
#pragma unroll
    for (int r = 0; r < 16; ++r) { p0[r] = 0.f; p1[r] = 0.f; }
    const int base = r32 * 256 + ((16 * hi) ^ ((r32 & 7) << 4));
#pragma unroll
    for (int d0 = 0; d0 < 8; ++d0) {
        const bf16x8 b0 = *(const LAS bf16x8*)(Ks + (base ^ (32 * d0))), b1 = *(const LAS bf16x8*)(Ks + (base ^ (32 * d0)) + 8192);
        p0 = __builtin_amdgcn_mfma_f32_32x32x16_bf16(b0, qr[d0], p0, 0, 0, 0);
        p1 = __builtin_amdgcn_mfma_f32_32x32x16_bf16(b1, qr[d0], p1, 0, 0, 0);
    }
}
__device__ __forceinline__ void a2_psm(f32x16& p0, f32x16& p1, float& m_reg, float& alpha, bool need_mask, int kd, int hi) {
    if (need_mask) {
#pragma unroll
        for (int r = 0; r < 16; ++r) { const int d0 = kd + a2_crow(r, hi), d1 = d0 + 32;
            if (d0 > WIN || d0 < -WIN) p0[r] = -INFINITY; if (d1 > WIN || d1 < -WIN) p1[r] = -INFINITY; }
    }
    float pmax = p0[0];
#pragma unroll
    for (int r = 1; r < 16; ++r) pmax = fmaxf(pmax, p0[r]);
#pragma unroll
    for (int r = 0; r < 16; ++r) pmax = fmaxf(pmax, p1[r]);
    { auto rr = __builtin_amdgcn_permlane32_swap(__float_as_uint(pmax), __float_as_uint(pmax), false, false);
      pmax = fmaxf(__uint_as_float(rr[0]), __uint_as_float(rr[1])); }
    float mn;
    if (__builtin_amdgcn_ballot_w64(pmax - m_reg > A2_THR) == 0ull) { mn = m_reg; alpha = 1.f; }
    else { mn = fmaxf(m_reg, pmax); alpha = __builtin_amdgcn_exp2f((m_reg - mn) * A2_C); m_reg = mn; }
    const float mnC = -mn * A2_C;
#pragma unroll
    for (int r = 0; r < 16; ++r) { p0[r] = fmaf(p0[r], A2_C, mnC); p1[r] = fmaf(p1[r], A2_C, mnC); }
#pragma unroll
    for (int r = 0; r < 16; ++r) p0[r] = __builtin_amdgcn_exp2f(p0[r]);
}
__device__ __forceinline__ void a2_fsm(f32x16& p0, f32x16& p1, float alpha, float& l_reg, bf16x8 (&pf)[4]) {
#pragma unroll
    for (int r = 0; r < 16; ++r) p1[r] = __builtin_amdgcn_exp2f(p1[r]);
    float ps = 0.f;
#pragma unroll
    for (int r = 0; r < 16; ++r) ps += p0[r];
#pragma unroll
    for (int r = 0; r < 16; ++r) ps += p1[r];
    l_reg = l_reg * alpha + ps;
#pragma unroll
    for (int s = 0; s < 2; ++s) {
        u32x4 x0, x1;
        x0.x = pk2(p0[8 * s + 0], p0[8 * s + 1]); x0.y = pk2(p0[8 * s + 2], p0[8 * s + 3]); x0.z = pk2(p0[8 * s + 4], p0[8 * s + 5]); x0.w = pk2(p0[8 * s + 6], p0[8 * s + 7]);
        x1.x = pk2(p1[8 * s + 0], p1[8 * s + 1]); x1.y = pk2(p1[8 * s + 2], p1[8 * s + 3]); x1.z = pk2(p1[8 * s + 4], p1[8 * s + 5]); x1.w = pk2(p1[8 * s + 6], p1[8 * s + 7]);
        pf[s] = __builtin_bit_cast(bf16x8, x0); pf[2 + s] = __builtin_bit_cast(bf16x8, x1);
    }
}
template <int DT> __device__ __forceinline__ void a2_pv_one(f32x16& od, unsigned vb, const bf16x8 (&pf)[4]) {
    const s16x4 l0 = a2_tr<DT * 512 + 0 * 4096>(vb), h0 = a2_tr<DT * 512 + 0 * 4096 + 2048>(vb), l1 = a2_tr<DT * 512 + 1 * 4096>(vb), h1 = a2_tr<DT * 512 + 1 * 4096 + 2048>(vb);
    const s16x4 l2 = a2_tr<DT * 512 + 2 * 4096>(vb), h2 = a2_tr<DT * 512 + 2 * 4096 + 2048>(vb), l3 = a2_tr<DT * 512 + 3 * 4096>(vb), h3 = a2_tr<DT * 512 + 3 * 4096 + 2048>(vb);
    asm volatile("s_waitcnt lgkmcnt(0)" ::: "memory"); A2_SBAR();
#define A2_PK(L, H) (bf16x8){L[0], L[1], L[2], L[3], H[0], H[1], H[2], H[3]}
    od = __builtin_amdgcn_mfma_f32_32x32x16_bf16(A2_PK(l0, h0), pf[0], od, 0, 0, 0);
    od = __builtin_amdgcn_mfma_f32_32x32x16_bf16(A2_PK(l1, h1), pf[1], od, 0, 0, 0);
    od = __builtin_amdgcn_mfma_f32_32x32x16_bf16(A2_PK(l2, h2), pf[2], od, 0, 0, 0);
    od = __builtin_amdgcn_mfma_f32_32x32x16_bf16(A2_PK(l3, h3), pf[3], od, 0, 0, 0);
#undef A2_PK
}
__device__ __forceinline__ void a2_pv(f32x16 (&o)[4], unsigned vb, const bf16x8 (&pf)[4]) {
    a2_pv_one<0>(o[0], vb, pf); a2_pv_one<1>(o[1], vb, pf); a2_pv_one<2>(o[2], vb, pf); a2_pv_one<3>(o[3], vb, pf);
}
__device__ __forceinline__ void attn_unit(Frame& F, const float* sinkl, int unit) {
    const int tid = F.tid, lane = F.lane, w = F.wave, r32 = lane & 31, hi = lane >> 5;
    const bf16* P = (const bf16*)(F.ws + WS_P); bf16* ATT = (bf16*)(F.ws + WS_ATT);
    LAS unsigned char* lds = F.lds;
    const bool lat = unit < 512;
    int b, kvh, t0;
    if (lat) { b = unit >> 8; kvh = (unit >> 7) & 1; t0 = (unit & 127) * 64; } else { const int u = unit - 512; b = u >> 3; kvh = (u >> 2) & 1; t0 = (u & 3) * 64; }
    const int hh = kvh * 4 + (w >> 1), qlo = t0 + 32 * (w & 1), qt = qlo + r32;
    const size_t mq = lat ? (size_t)b * SEQ + qt : (size_t)ML + b * CTX + qt;
    const int ti_lo = lat ? (t0 >= 128 ? 0 : (128 - t0) >> 6) : 0, ti_hi = lat ? ((SEQ + 128 - t0) >> 6 < 5 ? (SEQ + 128 - t0) >> 6 : 5) : 0;
    const int nl = ti_hi - ti_lo, NT = nl + 4;
    const int ks0 = t0 - 128 + 64 * ti_lo;
    const int wrow0 = b * SEQ + ks0, crow0 = ML + b * CTX;
    const int sr = tid >> 4, sc = (tid & 15) * 8;
    const bf16* Pk0 = P + (size_t)sr * INC + OFF_K + kvh * HD + sc;
    const int vst0 = ((sr >> 3) * 4 + (sc >> 5)) * 512 + ((sr & 7) * 32 + (sc & 31)) * 2, kst0 = sr * 256 + ((sc * 2) ^ ((sr & 7) << 4));
    const unsigned vb0 = (unsigned)(size_t)(lds + A2_V) + (((lane & 3) << 3) | (((lane >> 2) & 3) << 6) | (((lane >> 4) & 1) << 5) | (((lane >> 5) & 1) << 8));
    u32x4 sg[A2_SD][4];
#define A2_ROW(n) ((n) < nl ? wrow0 + 64 * (n) : crow0 + 64 * ((n) - nl))
#define A2_LOAD(i, n) do { const bf16* p_ = Pk0 + (size_t)A2_ROW(n) * INC; sg[i][0] = *(const u32x4*)(p_ + (OFF_V - OFF_K)); sg[i][1] = *(const u32x4*)(p_ + (OFF_V - OFF_K) + (size_t)32 * INC); \
        sg[i][2] = *(const u32x4*)(p_); sg[i][3] = *(const u32x4*)(p_ + (size_t)32 * INC); } while (0)
#define A2_WRITE(bf, i) do { *(LAS u32x4*)(lds + A2_V + (bf) * A2_TILE + vst0) = sg[i][0]; *(LAS u32x4*)(lds + A2_V + (bf) * A2_TILE + vst0 + 8192) = sg[i][1]; \
        *(LAS u32x4*)(lds + A2_K + (bf) * A2_TILE + kst0) = sg[i][2]; *(LAS u32x4*)(lds + A2_K + (bf) * A2_TILE + kst0 + 8192) = sg[i][3]; } while (0)
#define A2_WAIT() do { if (A2_SD == 2) asm volatile("s_waitcnt vmcnt(4)" ::: "memory"); else asm volatile("s_waitcnt vmcnt(0)" ::: "memory"); } while (0)
#define A2_MASKED(n) ((n) < nl && ((ks0 + 64 * (n) + 63 - qlo > WIN) || (qlo + 31 - (ks0 + 64 * (n)) > WIN)))
#define A2_PSM(p0_, p1_, al_, n) a2_psm(p0_, p1_, m_reg, al_, A2_MASKED(n), ks0 + 64 * (n) - qt, hi)
#define A2_RESC(al_) do { if (__builtin_amdgcn_ballot_w64((al_) < 1.f) != 0ull) { _Pragma("unroll") for (int d_ = 0; d_ < 4; ++d_) _Pragma("unroll") for (int r_ = 0; r_ < 16; ++r_) o[d_][r_] *= (al_); } } while (0)
    bf16x8 qr[8];
    { const bf16* qp = P + mq * INC + OFF_Q + hh * HD + 8 * hi;
#pragma unroll
      for (int kk = 0; kk < 8; ++kk) qr[kk] = *(const bf16x8*)(qp + 16 * kk); }
    f32x16 o[4];
#pragma unroll
    for (int dt = 0; dt < 4; ++dt)
#pragma unroll
        for (int r = 0; r < 16; ++r) o[dt][r] = 0.f;
    float m_reg = sinkl[hh] * (1.f / A2_SCALE), l_reg = hi == 0 ? 1.f : 0.f;
    f32x16 pA0, pA1, pB0, pB1; float alA, alB; bf16x8 pf[4];
    const LAS unsigned char* K0 = lds + A2_K; const LAS unsigned char* K1 = lds + A2_K + A2_TILE;
    __syncthreads();
    A2_LOAD(0, 0); A2_WRITE(0, 0); __syncthreads();
    a2_qkt(pA0, pA1, K0, qr, r32, hi); A2_PSM(pA0, pA1, alA, 0);
    A2_LOAD(A2_SO, 1); if (A2_SD == 2) A2_LOAD(0, 2);
    A2_WAIT(); A2_WRITE(1, A2_SO); __syncthreads();
    int j = 1;
    for (; j + 1 < NT; j += 2) {
        A2_SBAR(); a2_qkt(pB0, pB1, K1, qr, r32, hi);
        a2_fsm(pA0, pA1, alA, l_reg, pf); A2_SBAR();
        if (j + A2_SD < NT) A2_LOAD(A2_SO, j + A2_SD); A2_SBAR();
        a2_pv(o, vb0, pf); A2_PSM(pB0, pB1, alB, j);
        __syncthreads(); A2_WAIT(); A2_WRITE(0, 0);
        A2_RESC(alB); __syncthreads();
        A2_SBAR(); a2_qkt(pA0, pA1, K0, qr, r32, hi);
        a2_fsm(pB0, pB1, alB, l_reg, pf); A2_SBAR();
        if (j + 1 + A2_SD < NT) A2_LOAD(0, j + 1 + A2_SD); A2_SBAR();
        a2_pv(o, vb0 + A2_TILE, pf); A2_PSM(pA0, pA1, alA, j + 1);
        __syncthreads(); A2_WAIT(); if (j + 2 < NT) A2_WRITE(1, A2_SO);
        A2_RESC(alA); __syncthreads();
    }
    if (j < NT) {
        A2_SBAR(); a2_qkt(pB0, pB1, K1, qr, r32, hi);
        a2_fsm(pA0, pA1, alA, l_reg, pf); A2_SBAR();
        a2_pv(o, vb0, pf); A2_PSM(pB0, pB1, alB, j);
        A2_RESC(alB);
        a2_fsm(pB0, pB1, alB, l_reg, pf); A2_SBAR();
        a2_pv(o, vb0 + A2_TILE, pf);
    } else {
        a2_fsm(pA0, pA1, alA, l_reg, pf); A2_SBAR();
        a2_pv(o, vb0, pf);
    }
#undef A2_ROW
#undef A2_LOAD
#undef A2_WRITE
#undef A2_WAIT
#undef A2_MASKED
#undef A2_PSM
#undef A2_RESC
    const float ltot = l_reg + bperm(l_reg, lane ^ 32), inv = 1.f / ltot;
    bf16* op = ATT + mq * D + hh * HD + 4 * hi;
#pragma unroll
    for (int dt = 0; dt < 4; ++dt)
#pragma unroll
        for (int rg = 0; rg < 4; ++rg) { u32x2 wv; wv.x = pk2(o[dt][4 * rg] * inv, o[dt][4 * rg + 1] * inv); wv.y = pk2(o[dt][4 * rg + 2] * inv, o[dt][4 * rg + 3] * inv);
            *(u32x2*)(op + 32 * dt + 8 * rg) = wv; }
}
#elif ATT2 == 2
constexpr int A3_BUF = 32768, A3_K = 16384;
#ifndef A3_PRIO
#define A3_PRIO 0
#endif
#ifndef A3_LATEDMA
#define A3_LATEDMA 0
#endif
#ifndef A3_TRALL
#define A3_TRALL 0
#endif
#ifndef A3_NOSBAR
#define A3_NOSBAR 0
#endif
typedef short s16x4 __attribute__((ext_vector_type(4)));
#define A2_SBAR() __builtin_amdgcn_sched_barrier(0)
#define A3_SB() do { if (!A3_NOSBAR) __builtin_amdgcn_sched_barrier(0); } while (0)
__device__ __forceinline__ int a2_crow(int r, int hi) { return (r & 3) + 8 * (r >> 2) + 4 * hi; }
template <int OFF> __device__ __forceinline__ s16x4 a2_tr(unsigned vb) { s16x4 r; asm volatile("ds_read_b64_tr_b16 %0, %1 offset:%2" : "=&v"(r) : "v"(vb), "i"(OFF) : "memory"); return r; }
constexpr float A2_SCALE = 0.08838834764831845f, A2_C = 0.08838834764831845f * 1.4426950408889634f, A2_THR = 8.f / 0.08838834764831845f;
__device__ __forceinline__ void a3_qk(f32x16& p, const LAS unsigned char* Kh, const bf16x8 (&qr)[8], int base) {
#pragma unroll
    for (int r = 0; r < 16; ++r) p[r] = 0.f;
#pragma unroll
    for (int d0 = 0; d0 < 8; ++d0) { const bf16x8 b = *(const LAS bf16x8*)(Kh + (base ^ (32 * d0))); if (A3_PRIO) __builtin_amdgcn_s_setprio(1); p = __builtin_amdgcn_mfma_f32_32x32x16_bf16(b, qr[d0], p, 0, 0, 0); if (A3_PRIO) __builtin_amdgcn_s_setprio(0); }
}
__device__ __forceinline__ void a3_psm(f32x16& p, float& m_reg, float& alpha, bool need_mask, int kd, int hi) {
    if (need_mask) {
#pragma unroll
        for (int r = 0; r < 16; ++r) { const int d = kd + a2_crow(r, hi); if (d > WIN || d < -WIN) p[r] = -INFINITY; }
    }
    float pmax = p[0];
#pragma unroll
    for (int r = 1; r < 16; ++r) pmax = fmaxf(pmax, p[r]);
    { auto rr = __builtin_amdgcn_permlane32_swap(__float_as_uint(pmax), __float_as_uint(pmax), false, false);
      pmax = fmaxf(__uint_as_float(rr[0]), __uint_as_float(rr[1])); }
    float mn;
    if (__builtin_amdgcn_ballot_w64(pmax - m_reg > A2_THR) == 0ull) { mn = m_reg; alpha = 1.f; }
    else { mn = fmaxf(m_reg, pmax); alpha = __builtin_amdgcn_exp2f((m_reg - mn) * A2_C); m_reg = mn; }
    const float mnC = -mn * A2_C;
#pragma unroll
    for (int r = 0; r < 16; ++r) p[r] = fmaf(p[r], A2_C, mnC);
#pragma unroll
    for (int r = 0; r < 8; ++r) p[r] = __builtin_amdgcn_exp2f(p[r]);
}
__device__ __forceinline__ void a3_fsm(f32x16& p, float alpha, float& l_reg, bf16x8 (&pf)[2]) {
#pragma unroll
    for (int r = 8; r < 16; ++r) p[r] = __builtin_amdgcn_exp2f(p[r]);
    float ps = 0.f;
#pragma unroll
    for (int r = 0; r < 16; ++r) ps += p[r];
    l_reg = l_reg * alpha + ps;
#pragma unroll
    for (int s = 0; s < 2; ++s) { u32x4 x; x.x = pk2(p[8 * s + 0], p[8 * s + 1]); x.y = pk2(p[8 * s + 2], p[8 * s + 3]); x.z = pk2(p[8 * s + 4], p[8 * s + 5]); x.w = pk2(p[8 * s + 6], p[8 * s + 7]); pf[s] = __builtin_bit_cast(bf16x8, x); }
}
template <int DT, int KH> __device__ __forceinline__ void a3_pv2(f32x16& oa, f32x16& ob, unsigned vb, const bf16x8 (&pf)[2]) {
    constexpr int B0 = DT * 512 + (2 * KH) * 4096, B1 = B0 + 512;
    const s16x4 al0 = a2_tr<B0>(vb), ah0 = a2_tr<B0 + 2048>(vb), al1 = a2_tr<B0 + 4096>(vb), ah1 = a2_tr<B0 + 4096 + 2048>(vb);
    const s16x4 bl0 = a2_tr<B1>(vb), bh0 = a2_tr<B1 + 2048>(vb), bl1 = a2_tr<B1 + 4096>(vb), bh1 = a2_tr<B1 + 4096 + 2048>(vb);
    asm volatile("s_waitcnt lgkmcnt(0)" ::: "memory"); A2_SBAR();
#define A2_PK(L, H) (bf16x8){L[0], L[1], L[2], L[3], H[0], H[1], H[2], H[3]}
    oa = __builtin_amdgcn_mfma_f32_32x32x16_bf16(A2_PK(al0, ah0), pf[0], oa, 0, 0, 0);
    ob = __builtin_amdgcn_mfma_f32_32x32x16_bf16(A2_PK(bl0, bh0), pf[0], ob, 0, 0, 0);
    oa = __builtin_amdgcn_mfma_f32_32x32x16_bf16(A2_PK(al1, ah1), pf[1], oa, 0, 0, 0);
    ob = __builtin_amdgcn_mfma_f32_32x32x16_bf16(A2_PK(bl1, bh1), pf[1], ob, 0, 0, 0);
#undef A2_PK
}
template <int KH> __device__ __forceinline__ void a3_pv(f32x16 (&o)[4], unsigned vb, const bf16x8 (&pf)[2]) {
#if A3_TRALL
    constexpr int B0 = (2 * KH) * 4096;
#define A2_PK(L, H) (bf16x8){L[0], L[1], L[2], L[3], H[0], H[1], H[2], H[3]}
#define A3_RD(d) const s16x4 l0##d = a2_tr<B0 + d * 512>(vb), h0##d = a2_tr<B0 + d * 512 + 2048>(vb), l1##d = a2_tr<B0 + d * 512 + 4096>(vb), h1##d = a2_tr<B0 + d * 512 + 4096 + 2048>(vb)
    A3_RD(0); A3_RD(1); A3_RD(2); A3_RD(3);
    asm volatile("s_waitcnt lgkmcnt(0)" ::: "memory"); A2_SBAR();
    if (A3_PRIO) __builtin_amdgcn_s_setprio(1);
    o[0] = __builtin_amdgcn_mfma_f32_32x32x16_bf16(A2_PK(l00, h00), pf[0], o[0], 0, 0, 0); o[1] = __builtin_amdgcn_mfma_f32_32x32x16_bf16(A2_PK(l01, h01), pf[0], o[1], 0, 0, 0);
    o[2] = __builtin_amdgcn_mfma_f32_32x32x16_bf16(A2_PK(l02, h02), pf[0], o[2], 0, 0, 0); o[3] = __builtin_amdgcn_mfma_f32_32x32x16_bf16(A2_PK(l03, h03), pf[0], o[3], 0, 0, 0);
    o[0] = __builtin_amdgcn_mfma_f32_32x32x16_bf16(A2_PK(l10, h10), pf[1], o[0], 0, 0, 0); o[1] = __builtin_amdgcn_mfma_f32_32x32x16_bf16(A2_PK(l11, h11), pf[1], o[1], 0, 0, 0);
    o[2] = __builtin_amdgcn_mfma_f32_32x32x16_bf16(A2_PK(l12, h12), pf[1], o[2], 0, 0, 0); o[3] = __builtin_amdgcn_mfma_f32_32x32x16_bf16(A2_PK(l13, h13), pf[1], o[3], 0, 0, 0);
    if (A3_PRIO) __builtin_amdgcn_s_setprio(0);
#undef A3_RD
#undef A2_PK
#else
    a3_pv2<0, KH>(o[0], o[1], vb, pf); a3_pv2<2, KH>(o[2], o[3], vb, pf);
#endif
}
__device__ __forceinline__ void attn_unit(Frame& F, const float* sinkl, int unit) {
    const int lane = F.lane, w = F.wave, r32 = lane & 31, hi = lane >> 5;
    const bf16* P = (const bf16*)(F.ws + WS_P); bf16* ATT = (bf16*)(F.ws + WS_ATT);
    LAS unsigned char* lds = F.lds;
    const bool lat = unit < 512;
    int b, kvh, t0;
    if (lat) { b = unit >> 8; kvh = (unit >> 7) & 1; t0 = (unit & 127) * 64; } else { const int u = unit - 512; b = u >> 3; kvh = (u >> 2) & 1; t0 = (u & 3) * 64; }
    const int hh = kvh * 4 + (w >> 1), qlo = t0 + 32 * (w & 1), qt = qlo + r32;
    const size_t mq = lat ? (size_t)b * SEQ + qt : (size_t)ML + b * CTX + qt;
    const int ti_lo = lat ? (t0 >= 128 ? 0 : (128 - t0) >> 6) : 0, ti_hi = lat ? ((SEQ + 128 - t0) >> 6 < 5 ? (SEQ + 128 - t0) >> 6 : 5) : 0;
    const int nl = ti_hi - ti_lo, NT = nl + 4;
    const int ks0 = t0 - 128 + 64 * ti_lo;
    const int wrow0 = b * SEQ + ks0, crow0 = ML + b * CTX;
    const bf16* Pt = P + kvh * HD;
    unsigned voffV[2], voffK[2];
#pragma unroll
    for (int i = 0; i < 2; ++i) { const int p = (w * 2 + i) * 64 + lane;
        voffV[i] = (unsigned)((((p >> 7) * 8 + ((p >> 2) & 7)) * INC + ((p >> 5) & 3) * 32 + (p & 3) * 8) * 2);
        voffK[i] = (unsigned)(((p >> 4) * INC + ((p & 15) ^ ((p >> 4) & 7)) * 8) * 2); }
    const unsigned vb0 = (unsigned)(size_t)lds + (((lane & 3) << 3) | (((lane >> 2) & 3) << 6) | (((lane >> 4) & 1) << 5) | (((lane >> 5) & 1) << 8));
    const int kbase = r32 * 256 + ((16 * hi) ^ ((r32 & 7) << 4));
#define A3_ROW(n) ((n) < nl ? wrow0 + 64 * (n) : crow0 + 64 * ((n) - nl))
#define A3_DMA(n) do { const int q_ = (n) & 3; const char* tb_ = (const char*)(Pt + (size_t)A3_ROW(n) * INC); \
        _Pragma("unroll") for (int i_ = 0; i_ < 2; ++i_) { \
            __builtin_amdgcn_global_load_lds((const unsigned*)(tb_ + OFF_V * 2 + voffV[i_]), (LAS unsigned*)(lds + q_ * A3_BUF + (w * 2 + i_) * 1024), 16, 0, 0); \
            __builtin_amdgcn_global_load_lds((const unsigned*)(tb_ + OFF_K * 2 + voffK[i_]), (LAS unsigned*)(lds + q_ * A3_BUF + A3_K + (w * 2 + i_) * 1024), 16, 0, 0); } } while (0)
#define A3_KB(n, h) (ks0 + 64 * (n) + 32 * (h))
#define A3_MASKED(n, h) ((n) < nl && ((A3_KB(n, h) + 31 - qlo > WIN) || (qlo + 31 - A3_KB(n, h) > WIN)))
#define A3_PSM(p_, al_, n, h) a3_psm(p_, m_reg, al_, A3_MASKED(n, h), A3_KB(n, h) - qt, hi)
#define A3_RESC(al_) do { if (__builtin_amdgcn_ballot_w64((al_) < 1.f) != 0ull) { _Pragma("unroll") for (int d_ = 0; d_ < 4; ++d_) _Pragma("unroll") for (int r_ = 0; r_ < 16; ++r_) o[d_][r_] *= (al_); } } while (0)
#define A3_BAR() do { asm volatile("s_waitcnt lgkmcnt(0)" ::: "memory"); __builtin_amdgcn_s_barrier(); asm volatile("" ::: "memory"); } while (0)
    A3_BAR();
    bf16x8 qr[8];
    { const bf16* qp = P + mq * INC + OFF_Q + hh * HD + 8 * hi;
#pragma unroll
      for (int kk = 0; kk < 8; ++kk) qr[kk] = *(const bf16x8*)(qp + 16 * kk); }
    A3_DMA(0); A3_DMA(1);
    f32x16 o[4];
#pragma unroll
    for (int dt = 0; dt < 4; ++dt)
#pragma unroll
        for (int r = 0; r < 16; ++r) o[dt][r] = 0.f;
    float m_reg = sinkl[hh] * (1.f / A2_SCALE), l_reg = hi == 0 ? 1.f : 0.f;
    f32x16 pE, pO; float alE, alO; bf16x8 pf[2];
    asm volatile("s_waitcnt vmcnt(4)" ::: "memory"); A3_BAR();
    A3_DMA(2);
    a3_qk(pE, lds + A3_K, qr, kbase); A3_PSM(pE, alE, 0, 0);
    A3_SB(); a3_qk(pO, lds + A3_K + 8192, qr, kbase);
    a3_fsm(pE, alE, l_reg, pf); A3_SB();
    a3_pv<0>(o, vb0, pf); A3_PSM(pO, alO, 0, 1);
    A3_RESC(alO);
    for (int j = 1; j < NT; ++j) {
        if (j + 1 < NT) asm volatile("s_waitcnt vmcnt(4)" ::: "memory"); else asm volatile("s_waitcnt vmcnt(0)" ::: "memory");
        A3_BAR();
        if (!A3_LATEDMA && j + 2 < NT) A3_DMA(j + 2);
        const int bc = (j & 3) * A3_BUF, bp = ((j - 1) & 3) * A3_BUF;
        A3_SB(); a3_qk(pE, lds + bc + A3_K, qr, kbase);
        a3_fsm(pO, alO, l_reg, pf); A3_SB();
        if (A3_LATEDMA && j + 2 < NT) A3_DMA(j + 2);
        a3_pv<1>(o, vb0 + bp, pf); A3_PSM(pE, alE, j, 0);
        A3_RESC(alE);
        A3_SB(); a3_qk(pO, lds + bc + A3_K + 8192, qr, kbase);
        a3_fsm(pE, alE, l_reg, pf); A3_SB();
        a3_pv<0>(o, vb0 + bc, pf); A3_PSM(pO, alO, j, 1);
        A3_RESC(alO);
    }
    a3_fsm(pO, alO, l_reg, pf); A3_SB();
    a3_pv<1>(o, vb0 + ((NT - 1) & 3) * A3_BUF, pf);
#undef A3_ROW
#undef A3_BAR
#undef A3_DMA
#undef A3_KB
#undef A3_MASKED
#undef A3_PSM
#undef A3_RESC
    const float ltot = l_reg + bperm(l_reg, lane ^ 32), inv = 1.f / ltot;
    bf16* op = ATT + mq * D + hh * HD + 4 * hi;
#pragma unroll
    for (int dt = 0; dt < 4; ++dt)
#pragma unroll
        for (int rg = 0; rg < 4; ++rg) { u32x2 wv; wv.x = pk2(o[dt][4 * rg] * inv, o[dt][4 * rg + 1] * inv); wv.y = pk2(o[dt][4 * rg + 2] * inv, o[dt][4 * rg + 3] * inv);
            st8w<2>(op + 32 * dt + 8 * rg, wv); }
}

struct A3U { int lat, b, kvh, t0, nl, NT, ks0, wrow0, crow0; };
__device__ __forceinline__ A3U a3_decode(int unit) {
    A3U u; u.lat = unit < 512 ? 1 : 0;
    if (u.lat) { u.b = unit >> 8; u.kvh = (unit >> 7) & 1; u.t0 = (unit & 127) * 64; } else { const int x = unit - 512; u.b = x >> 3; u.kvh = (x >> 2) & 1; u.t0 = (x & 3) * 64; }
    const int ti_lo = u.lat ? (u.t0 >= 128 ? 0 : (128 - u.t0) >> 6) : 0, ti_hi = u.lat ? ((SEQ + 128 - u.t0) >> 6 < 5 ? (SEQ + 128 - u.t0) >> 6 : 5) : 0;
    u.nl = ti_hi - ti_lo; u.NT = u.nl + 4; u.ks0 = u.t0 - 128 + 64 * ti_lo; u.wrow0 = u.b * SEQ + u.ks0; u.crow0 = ML + u.b * CTX; return u;
}
__device__ __forceinline__ void attn_stream(Frame& F, const float* sinkl, int u_first, int u_stride, int n_lat, int u_extra) {
    const int nU = n_lat + (u_extra >= 0 ? 1 : 0);
    if (nU <= 0) return;
    const int lane = F.lane, w = F.wave, r32 = lane & 31, hi = lane >> 5;
    const bf16* P = (const bf16*)(F.ws + WS_P); bf16* ATT = (bf16*)(F.ws + WS_ATT);
    LAS unsigned char* lds = F.lds;
    unsigned voffV[2], voffK[2];
#pragma unroll
    for (int i = 0; i < 2; ++i) { const int p = (w * 2 + i) * 64 + lane;
        voffV[i] = (unsigned)((((p >> 7) * 8 + ((p >> 2) & 7)) * INC + ((p >> 5) & 3) * 32 + (p & 3) * 8) * 2);
        voffK[i] = (unsigned)(((p >> 4) * INC + ((p & 15) ^ ((p >> 4) & 7)) * 8) * 2); }
    const unsigned vb0 = (unsigned)(size_t)lds + (((lane & 3) << 3) | (((lane >> 2) & 3) << 6) | (((lane >> 4) & 1) << 5) | (((lane >> 5) & 1) << 8));
    const int kbase = r32 * 256 + ((16 * hi) ^ ((r32 & 7) << 4));
#define A3S_UNIT(i) ((i) < n_lat ? u_first + (i) * u_stride : u_extra)
#define A3S_ROW(U, n) ((n) < U.nl ? U.wrow0 + 64 * (n) : U.crow0 + 64 * ((n) - U.nl))
#define A3S_DMA(U, n, ring) do { const int q_ = (ring) & 3; const char* tb_ = (const char*)(P + U.kvh * HD + (size_t)A3S_ROW(U, n) * INC); \
        _Pragma("unroll") for (int i_ = 0; i_ < 2; ++i_) { \
            __builtin_amdgcn_global_load_lds((const unsigned*)(tb_ + OFF_V * 2 + voffV[i_]), (LAS unsigned*)(lds + q_ * A3_BUF + (w * 2 + i_) * 1024), 16, 0, 0); \
            __builtin_amdgcn_global_load_lds((const unsigned*)(tb_ + OFF_K * 2 + voffK[i_]), (LAS unsigned*)(lds + q_ * A3_BUF + A3_K + (w * 2 + i_) * 1024), 16, 0, 0); } } while (0)
#define A3S_QLOAD(U) do { const int hh_ = U.kvh * 4 + (w >> 1), qt_ = U.t0 + 32 * (w & 1) + r32; const size_t mq_ = U.lat ? (size_t)U.b * SEQ + qt_ : (size_t)ML + U.b * CTX + qt_; \
        const bf16* qp_ = P + mq_ * INC + OFF_Q + hh_ * HD + 8 * hi; _Pragma("unroll") for (int kk_ = 0; kk_ < 8; ++kk_) qr[kk_] = *(const bf16x8*)(qp_ + 16 * kk_); } while (0)
#define A3_KB(n, h) (cu.ks0 + 64 * (n) + 32 * (h))
#define A3_MASKED(n, h) ((n) < cu.nl && ((A3_KB(n, h) + 31 - qlo > WIN) || (qlo + 31 - A3_KB(n, h) > WIN)))
#define A3_PSM(p_, al_, n, h) a3_psm(p_, m_reg, al_, A3_MASKED(n, h), A3_KB(n, h) - qt, hi)
#define A3_RESC(al_) do { if (__builtin_amdgcn_ballot_w64((al_) < 1.f) != 0ull) { _Pragma("unroll") for (int d_ = 0; d_ < 4; ++d_) _Pragma("unroll") for (int r_ = 0; r_ < 16; ++r_) o[d_][r_] *= (al_); } } while (0)
#define A3_BAR() do { asm volatile("s_waitcnt lgkmcnt(0)" ::: "memory"); __builtin_amdgcn_s_barrier(); asm volatile("" ::: "memory"); } while (0)
    A3U cu = a3_decode(A3S_UNIT(0)); int rb = 0;
    A3_BAR();
    bf16x8 qr[8];
    A3S_QLOAD(cu);
    A3S_DMA(cu, 0, 0); A3S_DMA(cu, 1, 1);
    for (int ui = 0; ui < nU; ++ui) {
        const bool has_next = ui + 1 < nU;
        const A3U nx = a3_decode(A3S_UNIT(has_next ? ui + 1 : ui));
        const int NT = cu.NT;
        const int hh = cu.kvh * 4 + (w >> 1), qlo = cu.t0 + 32 * (w & 1), qt = qlo + r32;
        const size_t mq = cu.lat ? (size_t)cu.b * SEQ + qt : (size_t)ML + cu.b * CTX + qt;
        f32x16 o[4];
#pragma unroll
        for (int dt = 0; dt < 4; ++dt)
#pragma unroll
            for (int r = 0; r < 16; ++r) o[dt][r] = 0.f;
        float m_reg = sinkl[hh] * (1.f / A2_SCALE), l_reg = hi == 0 ? 1.f : 0.f;
        f32x16 pE, pO; float alE, alO; bf16x8 pf[2];
        if (ui == 0) asm volatile("s_waitcnt vmcnt(4)" ::: "memory");
        A3_BAR();
        A3S_DMA(cu, 2, rb + 2);
        { const int b0 = (rb & 3) * A3_BUF;
          a3_qk(pE, lds + b0 + A3_K, qr, kbase); A3_PSM(pE, alE, 0, 0);
          A3_SB(); a3_qk(pO, lds + b0 + A3_K + 8192, qr, kbase);
          a3_fsm(pE, alE, l_reg, pf); A3_SB();
          a3_pv<0>(o, vb0 + b0, pf); A3_PSM(pO, alO, 0, 1);
          A3_RESC(alO); }
        for (int j = 1; j < NT; ++j) {
            if (j + 1 < NT || has_next) asm volatile("s_waitcnt vmcnt(4)" ::: "memory"); else asm volatile("s_waitcnt vmcnt(0)" ::: "memory");
            A3_BAR();
            const int bc = ((rb + j) & 3) * A3_BUF, bp = ((rb + j - 1) & 3) * A3_BUF;
            A3_SB(); a3_qk(pE, lds + bc + A3_K, qr, kbase);
            a3_fsm(pO, alO, l_reg, pf); A3_SB();
            if (j + 2 < NT) A3S_DMA(cu, j + 2, rb + j + 2); else if (has_next) A3S_DMA(nx, j + 2 - NT, rb + j + 2);
            a3_pv<1>(o, vb0 + bp, pf); A3_PSM(pE, alE, j, 0);
            A3_RESC(alE);
            A3_SB(); a3_qk(pO, lds + bc + A3_K + 8192, qr, kbase);
            if (j == NT - 1 && has_next) A3S_QLOAD(nx);
            a3_fsm(pE, alE, l_reg, pf); A3_SB();
            a3_pv<0>(o, vb0 + bc, pf); A3_PSM(pO, alO, j, 1);
            A3_RESC(alO);
        }
        a3_fsm(pO, alO, l_reg, pf); A3_SB();
        a3_pv<1>(o, vb0 + ((rb + NT - 1) & 3) * A3_BUF, pf);
        const float ltot = l_reg + bperm(l_reg, lane ^ 32), inv = 1.f / ltot;
        bf16* op = ATT + mq * D + hh * HD + 4 * hi;
#pragma unroll
        for (int dt = 0; dt < 4; ++dt)
#pragma unroll
            for (int rg = 0; rg < 4; ++rg) { u32x2 wv; wv.x = pk2(o[dt][4 * rg] * inv, o[dt][4 * rg + 1] * inv); wv.y = pk2(o[dt][4 * rg + 2] * inv, o[dt][4 * rg + 3] * inv);
                st8w<2>(op + 32 * dt + 8 * rg, wv); }
        if (has_next) asm volatile("" : "+v"(qr[0]), "+v"(qr[1]), "+v"(qr[2]), "+v"(qr[3]), "+v"(qr[4]), "+v"(qr[5]), "+v"(qr[6]), "+v"(qr[7]) :: "memory");
        rb += NT; cu = nx;
    }
#undef A3S_UNIT
#undef A3S_ROW
#undef A3S_DMA
#undef A3S_QLOAD
#undef A3_KB
#undef A3_MASKED
#undef A3_PSM
#undef A3_RESC
#undef A3_BAR
}
#else
#ifndef ADUP
#define ADUP 0
#endif
constexpr int AT_K = 0, AT_KSTR = 272, AT_V = 64 * AT_KSTR, AT_VSTR = 144, AT_BUF = 64 * 272 + 128 * 144;
__device__ __forceinline__ void attn_unit(Frame& F, const float* sinkl, int unit) {
    const int tid = F.tid, lane = F.lane, w = F.wave, l31 = lane & 31, h5 = lane >> 5;
    const bf16* P = (const bf16*)(F.ws + WS_P); bf16* ATT = (bf16*)(F.ws + WS_ATT);
    LAS unsigned char* lds = F.lds;
    const bool lat = unit < 512;
    int b, kvh, t0;
    if (lat) { b = unit >> 8; kvh = (unit >> 7) & 1; t0 = (unit & 127) * 64; } else { const int u = unit - 512; b = u >> 3; kvh = (u >> 2) & 1; t0 = (u & 3) * 64; }
    const int hh = kvh * 4 + (w >> 1), qlo = t0 + 32 * (w & 1), qt = qlo + l31;
    const size_t mq = lat ? (size_t)b * SEQ + qt : (size_t)ML + b * CTX + qt;
    bf16x8 qf[8];
    { const bf16* qp = P + mq * INC + OFF_Q + hh * HD + 8 * h5;
#pragma unroll
      for (int kk = 0; kk < 8; ++kk) qf[kk] = *(const bf16x8*)(qp + 16 * kk); }
    f32x16 o[4];
#pragma unroll
    for (int dt = 0; dt < 4; ++dt)
#pragma unroll
        for (int r = 0; r < 16; ++r) o[dt][r] = 0.f;
    const float c2 = 0.08838834764831845f * 1.4426950408889634f;
    float mrun = sinkl[hh] * 1.4426950408889634f, lrun = h5 == 0 ? 1.f : 0.f;
    const int ti_lo = lat ? (t0 >= 128 ? 0 : (128 - t0) >> 6) : 0, ti_hi = lat ? ((SEQ + 128 - t0) >> 6 < 5 ? (SEQ + 128 - t0) >> 6 : 5) : 0;
    const int nl = ti_hi - ti_lo, ntiles = nl + 4;
    u32x4 kreg[2], vreg[2];
#define AT_LOAD(n) do { const int ti_ = (n) < nl ? ti_lo + (n) : (n) - nl; const bool il_ = (n) < nl; const int ks_ = il_ ? t0 - 128 + 64 * ti_ : 64 * ti_; \
        const size_t kr_ = il_ ? (size_t)b * SEQ + ks_ : (size_t)ML + b * CTX + ks_; \
        _Pragma("unroll") for (int p = 0; p < 2; ++p) { const int idx = tid + 512 * p; \
            kreg[p] = *(const u32x4*)(P + (kr_ + (idx >> 4)) * INC + OFF_K + kvh * HD + 8 * (idx & 15)); \
            vreg[p] = *(const u32x4*)(P + (kr_ + (idx & 63)) * INC + OFF_V + kvh * HD + 8 * (idx >> 6)); } } while (0)
#define AT_STORE(bufo) do { _Pragma("unroll") for (int p = 0; p < 2; ++p) { const int idx = tid + 512 * p; \
            *(LAS u32x4*)(lds + (bufo) + AT_K + (idx >> 4) * AT_KSTR + (idx & 15) * 16) = kreg[p]; \
            const int key = idx & 63, c = idx >> 6; const int pos = (key & 0x33) | ((key & 4) << 1) | ((key & 8) >> 1); const u32x4 v = vreg[p]; \
            LAS unsigned char* d = lds + (bufo) + AT_V + (8 * c) * AT_VSTR + 2 * pos; \
            *(LAS unsigned short*)(d + 0 * AT_VSTR) = (unsigned short)(v.x & 0xffff); *(LAS unsigned short*)(d + 1 * AT_VSTR) = (unsigned short)(v.x >> 16); \
            *(LAS unsigned short*)(d + 2 * AT_VSTR) = (unsigned short)(v.y & 0xffff); *(LAS unsigned short*)(d + 3 * AT_VSTR) = (unsigned short)(v.y >> 16); \
            *(LAS unsigned short*)(d + 4 * AT_VSTR) = (unsigned short)(v.z & 0xffff); *(LAS unsigned short*)(d + 5 * AT_VSTR) = (unsigned short)(v.z >> 16); \
            *(LAS unsigned short*)(d + 6 * AT_VSTR) = (unsigned short)(v.w & 0xffff); *(LAS unsigned short*)(d + 7 * AT_VSTR) = (unsigned short)(v.w >> 16); } } while (0)
    __syncthreads();
    AT_LOAD(0); AT_STORE(0); AT_LOAD(1);
    for (int n = 0; n < ntiles; ++n) {
        const int ti = n < nl ? ti_lo + n : n - nl; const bool islat = n < nl; const int ks = islat ? t0 - 128 + 64 * ti : 64 * ti;
        const int bo = (n & 1) * AT_BUF;
        __syncthreads();
        f32x16 s0, s1;
        for (int rs_ = 0; rs_ < ((ADUP & 2) ? 2 : 1); ++rs_) {
        if (ADUP & 2) asm volatile("" ::: "memory");
#pragma unroll
        for (int r = 0; r < 16; ++r) { s0[r] = 0.f; s1[r] = 0.f; }
        {
            const LAS unsigned char* kb0 = lds + bo + AT_K + l31 * AT_KSTR + 16 * h5;
            bf16x8 ka[2][2];
#pragma unroll
            for (int hb = 0; hb < 4; ++hb) {
#pragma unroll
                for (int kk = 0; kk < 2; ++kk) { ka[kk][0] = *(const LAS bf16x8*)(kb0 + 32 * (kk + 2 * hb)); ka[kk][1] = *(const LAS bf16x8*)(kb0 + 32 * AT_KSTR + 32 * (kk + 2 * hb)); }
#pragma unroll
                for (int kk = 0; kk < 2; ++kk) { s0 = __builtin_amdgcn_mfma_f32_32x32x16_bf16(ka[kk][0], qf[kk + 2 * hb], s0, 0, 0, 0); s1 = __builtin_amdgcn_mfma_f32_32x32x16_bf16(ka[kk][1], qf[kk + 2 * hb], s1, 0, 0, 0); }
            }
        }
        }
        if (n + 1 < ntiles) { AT_STORE(AT_BUF - bo); if (ADUP & 1) { asm volatile("" ::: "memory"); AT_STORE(AT_BUF - bo); } if (n + 2 < ntiles) AT_LOAD(n + 2); }
        const LAS unsigned char* vb0 = lds + bo + AT_V + l31 * AT_VSTR + 16 * h5;
        bf16x8 vf0[4], vf1[4];
#pragma unroll
        for (int ss = 0; ss < 4; ++ss) { vf0[ss] = *(const LAS bf16x8*)(vb0 + 32 * ss); vf1[ss] = *(const LAS bf16x8*)(vb0 + 32 * AT_VSTR + 32 * ss); }
        const bool need_mask = islat && ((ks + 63 - qlo > WIN) || (qlo + 31 - ks > WIN));
        float mt = -INFINITY;
#pragma unroll
        for (int r = 0; r < 16; ++r) {
            float a0 = s0[r] * c2, a1 = s1[r] * c2;
            if (need_mask) { const int kp = ks + (r & 3) + 8 * (r >> 2) + 4 * h5; const int d0 = kp - qt, d1 = kp + 32 - qt;
                if (d0 > WIN || d0 < -WIN) a0 = -INFINITY; if (d1 > WIN || d1 < -WIN) a1 = -INFINITY; }
            s0[r] = a0; s1[r] = a1; mt = fmaxf(mt, fmaxf(a0, a1));
        }
        mt = fmaxf(mt, bperm(mt, lane ^ 32));
        if (__builtin_amdgcn_ballot_w64(mt > mrun + 8.f) != 0ull) {
            const float mnew = fmaxf(mrun, mt), alpha = __builtin_amdgcn_exp2f(mrun - mnew);
            lrun *= alpha; mrun = mnew;
#pragma unroll
            for (int dt = 0; dt < 4; ++dt)
#pragma unroll
                for (int r = 0; r < 16; ++r) o[dt][r] *= alpha;
        }
        if (ADUP & 4) { float dm = 0.f;
#pragma unroll
            for (int r = 0; r < 16; r += 2) { float u0 = s0[r], u1 = s0[r + 1], u2 = s1[r], u3 = s1[r + 1]; asm volatile("" : "+v"(u0), "+v"(u1), "+v"(u2), "+v"(u3));
                dm += (__builtin_amdgcn_exp2f(u0 - mrun) + __builtin_amdgcn_exp2f(u1 - mrun)) + (__builtin_amdgcn_exp2f(u2 - mrun) + __builtin_amdgcn_exp2f(u3 - mrun)); }
            lrun += 0.f * dm; }
        float psum = 0.f;
#pragma unroll
        for (int r = 0; r < 16; ++r) { s0[r] = __builtin_amdgcn_exp2f(s0[r] - mrun); s1[r] = __builtin_amdgcn_exp2f(s1[r] - mrun); psum += s0[r] + s1[r]; }
        lrun += psum;
        const float PH_ = (ADUP & 8) ? 0.5f : 1.f;
        bf16x8 pf[4];
#pragma unroll
        for (int s = 0; s < 2; ++s) {
            u32x4 x0, x1;
            x0.x = pk2(PH_ * s0[8 * s + 0], PH_ * s0[8 * s + 1]); x0.y = pk2(PH_ * s0[8 * s + 2], PH_ * s0[8 * s + 3]); x0.z = pk2(PH_ * s0[8 * s + 4], PH_ * s0[8 * s + 5]); x0.w = pk2(PH_ * s0[8 * s + 6], PH_ * s0[8 * s + 7]);
            x1.x = pk2(PH_ * s1[8 * s + 0], PH_ * s1[8 * s + 1]); x1.y = pk2(PH_ * s1[8 * s + 2], PH_ * s1[8 * s + 3]); x1.z = pk2(PH_ * s1[8 * s + 4], PH_ * s1[8 * s + 5]); x1.w = pk2(PH_ * s1[8 * s + 6], PH_ * s1[8 * s + 7]);
            pf[s] = __builtin_bit_cast(bf16x8, x0); pf[2 + s] = __builtin_bit_cast(bf16x8, x1);
        }
        for (int rp_ = 0; rp_ < ((ADUP & 8) ? 2 : 1); ++rp_) {
        if (ADUP & 8) { asm volatile("" ::: "memory");
#pragma unroll
            for (int ss = 0; ss < 4; ++ss) { vf0[ss] = *(const LAS bf16x8*)(vb0 + 32 * ss); vf1[ss] = *(const LAS bf16x8*)(vb0 + 32 * AT_VSTR + 32 * ss); } }
#pragma unroll
        for (int ss = 0; ss < 4; ++ss) o[0] = __builtin_amdgcn_mfma_f32_32x32x16_bf16(vf0[ss], pf[ss], o[0], 0, 0, 0);
#pragma unroll
        for (int ss = 0; ss < 4; ++ss) vf0[ss] = *(const LAS bf16x8*)(vb0 + 64 * AT_VSTR + 32 * ss);
#pragma unroll
        for (int ss = 0; ss < 4; ++ss) o[1] = __builtin_amdgcn_mfma_f32_32x32x16_bf16(vf1[ss], pf[ss], o[1], 0, 0, 0);
#pragma unroll
        for (int ss = 0; ss < 4; ++ss) vf1[ss] = *(const LAS bf16x8*)(vb0 + 96 * AT_VSTR + 32 * ss);
#pragma unroll
        for (int ss = 0; ss < 4; ++ss) o[2] = __builtin_amdgcn_mfma_f32_32x32x16_bf16(vf0[ss], pf[ss], o[2], 0, 0, 0);
#pragma unroll
        for (int ss = 0; ss < 4; ++ss) o[3] = __builtin_amdgcn_mfma_f32_32x32x16_bf16(vf1[ss], pf[ss], o[3], 0, 0, 0);
        }
    }
#undef AT_LOAD
#undef AT_STORE
    const float ltot = lrun + bperm(lrun, lane ^ 32), inv = 1.f / ltot;
    bf16* op = ATT + mq * D + hh * HD + 4 * h5;
#pragma unroll
    for (int dt = 0; dt < 4; ++dt)
#pragma unroll
        for (int rg = 0; rg < 4; ++rg) { u32x2 wv; wv.x = pk2(o[dt][4 * rg] * inv, o[dt][4 * rg + 1] * inv); wv.y = pk2(o[dt][4 * rg + 2] * inv, o[dt][4 * rg + 3] * inv);
            *(u32x2*)(op + 32 * dt + 8 * rg) = wv; }
}

#endif
constexpr int SC_X = 0, SC_Y = 17408, SC_O = 34816, SC_STR = 272, SC_CW = 52224  , SC_PRM = SC_CW + 2560  ;
__device__ __forceinline__ int sc_rho(int t) { return (t & 3) | (((t >> 4) & 3) << 2) | (((t >> 2) & 3) << 4); }
struct ScanPref { u32x4 x[5]; };
__device__ __forceinline__ void scan_prefetch(ScanPref& pf, const bf16* P, int c, int h, int tid) {
    const int m0 = 64 * c, ch8 = tid & 15, cb = 128 * h + 8 * ch8, t0 = 2 * (tid >> 4);
    int seq_lo, seq_hi;
    if (c < 256) { seq_lo = (c >> 7) * SEQ; seq_hi = seq_lo + SEQ; } else { seq_lo = ML + ((c - 256) >> 2) * CTX; seq_hi = seq_lo + CTX; }
#pragma unroll
    for (int j = 0; j < 5; ++j) { const int mr = m0 + t0 + j - 2; pf.x[j] = (u32x4){0u, 0u, 0u, 0u};
        if (mr >= seq_lo && mr < seq_hi) pf.x[j] = *(const u32x4*)(P + (size_t)mr * INC + OFF_X + cb); }
}
#ifndef S2_ROT
#define S2_ROT 0
#endif
#ifndef S2_REV
#define S2_REV 1
#endif
#ifndef SC1_ONEBAR
#define SC1_ONEBAR 0
#endif
#ifndef SCAB_NT
#define SCAB_NT 0
#endif
#ifndef SC1_LDSTAB
#define SC1_LDSTAB 0
#endif
#ifndef SC1_VM
#define SC1_VM "0"
#endif
__device__ __forceinline__ void scan_unit(Frame& F, const Args& a, int l, int c, int cn, int h, ScanPref& pf, const bf16x8 (&bfr)[4][4], int par) {
    const int tid = F.tid, lane = F.lane, w = F.wave, l15 = lane & 15, g = lane >> 4;
    unsigned char* ws = F.ws; LAS unsigned char* lds = F.lds + par * 17408;
    const bf16* P = (const bf16*)(ws + WS_P);
    asm volatile("s_waitcnt vmcnt(" SC1_VM ")" : "+v"(pf.x[0]), "+v"(pf.x[1]), "+v"(pf.x[2]), "+v"(pf.x[3]), "+v"(pf.x[4]) :: "memory");
    const int chl = 16 * w + l15, ch = 128 * h + chl;
#if SC1_LDSTAB
    const f32x4 prm0 = ((const LAS f32x4*)(F.lds + SC_PRM))[chl], prm1 = ((const LAS f32x4*)(F.lds + SC_PRM))[128 + chl];
#else
    const f32x4* SPT = (const f32x4*)(ws + WS_SPT);
    const f32x4 prm0 = SPT[((size_t)l * 2 + 0) * D + ch], prm1 = SPT[((size_t)l * 2 + 1) * D + ch];
#endif
    {
        const int ch8 = tid & 15; const int cb = 128 * h + 8 * ch8;
        const float* cw = (a.in[10] + F.zo) + (size_t)l * 4 * D + cb; const float* cbp = (a.in[11] + F.zo) + l * D + cb;
        f32x4 w4[4][2];
#if SC1_LDSTAB
        const LAS float* cwt = (const LAS float*)(F.lds + SC_CW) + 8 * ch8; (void)cw; (void)cbp;
#pragma unroll
        for (int j = 0; j < 4; ++j) { w4[j][0] = *(const LAS f32x4*)(cwt + j * 128); w4[j][1] = *(const LAS f32x4*)(cwt + j * 128 + 4); }
        const f32x4 b0 = *(const LAS f32x4*)(cwt + 4 * 128), b1 = *(const LAS f32x4*)(cwt + 4 * 128 + 4);
#else
#pragma unroll
        for (int j = 0; j < 4; ++j) { w4[j][0] = *(const f32x4*)(cw + j * D); w4[j][1] = *(const f32x4*)(cw + j * D + 4); }
        const f32x4 b0 = *(const f32x4*)(cbp), b1 = *(const f32x4*)(cbp + 4);
#endif
#pragma unroll
        for (int i = 0; i < 2; ++i) { const int t = 2 * (tid >> 4) + i, row = sc_rho(t);
            f32x4 a0 = b0, a1 = b1;
#pragma unroll
            for (int j = 0; j < 4; ++j) { const u32x4 xv = pf.x[i + j];
                a0[0] += bflo(xv.x) * w4[j][0][0]; a0[1] += bfhi(xv.x) * w4[j][0][1]; a0[2] += bflo(xv.y) * w4[j][0][2]; a0[3] += bfhi(xv.y) * w4[j][0][3];
                a1[0] += bflo(xv.z) * w4[j][1][0]; a1[1] += bfhi(xv.z) * w4[j][1][1]; a1[2] += bflo(xv.w) * w4[j][1][2]; a1[3] += bfhi(xv.w) * w4[j][1][3]; }
            u32x4 o; o.x = pk2(a0[0], a0[1]); o.y = pk2(a0[2], a0[3]); o.z = pk2(a1[0], a1[1]); o.w = pk2(a1[2], a1[3]);
            *(LAS u32x4*)(lds + SC_X + row * SC_STR + ch8 * 16) = o;
        }
    }
    __syncthreads();
    if (cn >= 0) scan_prefetch(pf, P, cn, h, tid);
    f32x4 acc[4][4];
#pragma unroll
    for (int mt = 0; mt < 4; ++mt) {
        acc[mt][0] = (f32x4){prm0[0], prm0[0], prm0[0], prm0[0]}; acc[mt][1] = (f32x4){prm0[1], prm0[1], prm0[1], prm0[1]};
        acc[mt][2] = (f32x4){prm1[0], prm1[0], prm1[0], prm1[0]}; acc[mt][3] = (f32x4){prm1[1], prm1[1], prm1[1], prm1[1]}; }
#pragma unroll
    for (int kk = 0; kk < 4; ++kk) {
#pragma unroll
        for (int mt = 0; mt < 4; ++mt) { const bf16x8 af = *(const LAS bf16x8*)(lds + SC_X + (16 * mt + l15) * SC_STR + (32 * kk + 8 * g) * 2);
#pragma unroll
            for (int gt = 0; gt < 4; ++gt) acc[mt][gt] = __builtin_amdgcn_mfma_f32_16x16x32_bf16(af, bfr[kk][gt], acc[mt][gt], 0, 0, 0); }
    }
    float xv[16];
#pragma unroll
    for (int k = 0; k < 16; ++k) { const int row = 16 * (k >> 2) + 4 * g + (k & 3); xv[k] = bf2f(*(const LAS bf16*)(lds + SC_X + row * SC_STR + chl * 2)); }
    float* AGG_A = (float*)(ws + WS_AGG); float* AGG_B = (float*)(ws + WS_AGG + AGG_BYTES);
    u32x4* blk = (u32x4*)(ws + WS_SCAB) + ((size_t)((c * 8 + h) * 8 + w) * 8) * 64 + lane;
#pragma unroll
    for (int d = 0; d < 2; ++d) {
        const f32x4 prm = d == 0 ? prm0 : prm1;
        float av[16], bv[16];
#pragma unroll
        for (int k = 0; k < 16; ++k) {
            const float rg = __builtin_amdgcn_rcpf(1.f + __builtin_amdgcn_exp2f(acc[k >> 2][2 * d][k & 3])), ig = __builtin_amdgcn_rcpf(1.f + __builtin_amdgcn_exp2f(acc[k >> 2][2 * d + 1][k & 3]));
            const float aa = __builtin_amdgcn_exp2f(prm[2] * rg);
            av[k] = aa; bv[k] = __builtin_amdgcn_sqrtf(__builtin_fmaf(-aa, aa, 1.f)) * (ig * xv[k]);
        }
#pragma unroll
        for (int hf = 0; hf < 2; ++hf) { u32x4 pa, pb;
            pa.x = pk2(1.f - av[8 * hf + 0], 1.f - av[8 * hf + 1]); pa.y = pk2(1.f - av[8 * hf + 2], 1.f - av[8 * hf + 3]); pa.z = pk2(1.f - av[8 * hf + 4], 1.f - av[8 * hf + 5]); pa.w = pk2(1.f - av[8 * hf + 6], 1.f - av[8 * hf + 7]);
            pb.x = pk2(bv[8 * hf + 0], bv[8 * hf + 1]); pb.y = pk2(bv[8 * hf + 2], bv[8 * hf + 3]); pb.z = pk2(bv[8 * hf + 4], bv[8 * hf + 5]); pb.w = pk2(bv[8 * hf + 6], bv[8 * hf + 7]);
            if (SCAB_NT) { __builtin_nontemporal_store(pa, blk + (4 * d + hf) * 64); __builtin_nontemporal_store(pb, blk + (4 * d + 2 + hf) * 64); } else { st16w<1>(blk + (4 * d + hf) * 64, pa); st16w<1>(blk + (4 * d + 2 + hf) * 64, pb); } }
        const size_t ao = ((size_t)d * NCHUNK + c) * D + ch;
        float As = 1.f, Bs = 0.f;
#pragma unroll
        for (int i = 0; i < 16; ++i) { const int k = d == 0 ? i : 15 - i; Bs = av[k] * Bs + bv[k]; As = av[k] * As; }
        const int gi = d == 0 ? g : 3 - g;
        const int p1 = (d == 0 ? lane - 16 : lane + 16) & 63, p2 = (d == 0 ? lane - 32 : lane + 32) & 63;
        float Ai = As, Bi = Bs;
        { const float A1 = bperm(Ai, p1), B1 = bperm(Bi, p1); if (gi >= 1) { Bi = Ai * B1 + Bi; Ai = Ai * A1; } }
        { const float A2 = bperm(Ai, p2), B2 = bperm(Bi, p2); if (gi >= 2) { Bi = Ai * B2 + Bi; Ai = Ai * A2; } }
        if (gi == 3) { AGG_A[ao] = Ai; AGG_B[ao] = Bi; }
    }
#if !SC1_ONEBAR
    __syncthreads();
#endif
}
#ifndef SC1_REBAL
#define SC1_REBAL 1
#endif
#ifndef CARRY_PF
#define CARRY_PF 1
#endif
#ifndef LOCMAP
#define LOCMAP 0
#endif
__device__ __forceinline__ int sc_first(int j) { return (33 * j) >> 2; }
__device__ __forceinline__ int sc1_chunk(int v, int k, int G, bool rebal) {
    const int cs = G >> 3, base = v >> 3;
    if ((LOCMAP & 2) && G == 256) {
        const int j = base, c0 = sc_first(j), n = sc_first(j + 1) - c0;
        if (rebal) {
            if (j == 28 || j == 29) return k < 6 ? c0 + k : -1;
            if ((j <= 2 || j == 4) && k == 8) { const int r = j == 4 ? 3 : j; return sc_first(28 + (r & 1)) + 6 + (r >> 1); }
        }
        return k < n ? c0 + k : -1;
    }
    if (rebal) {
        if (v >= 240) return k < 6 ? base + 32 * k : -1;
        if (v >= 64 && v < 96 && k == 8) { const int idx = v - 64, src = 240 + (idx & 7) + 8 * ((idx >> 3) & 1), kd = 6 + (idx >> 4); return (src >> 3) + 32 * kd; }
    }
    const int c = base + cs * k; return c < NCHUNK ? c : -1;
}
__device__ __forceinline__ void ph_scan1(Frame& F, const Args& a, int l, bool rebal = false) {
    const int h = F.vcu & 7; int k = 0; int c = sc1_chunk(F.vcu, 0, F.G, rebal);
    if (c < 0) return;
    ScanPref pf; scan_prefetch(pf, (const bf16*)(F.ws + WS_P), c, h, F.tid);
    bf16x8 bfr[4][4];
    { const bf16* Wt = (const bf16*)(F.ws + WS_GT) + (size_t)(l * 8 + h) * 4 * 128 * 128 + (size_t)(16 * F.wave + (F.lane & 15)) * 128 + 8 * (F.lane >> 4);
#pragma unroll
      for (int kk = 0; kk < 4; ++kk)
#pragma unroll
        for (int gt = 0; gt < 4; ++gt) bfr[kk][gt] = *(const bf16x8*)(Wt + gt * 128 * 128 + 32 * kk); }
#if SC1_LDSTAB
    {
        LAS float* cwt = (LAS float*)(F.lds + SC_CW); LAS f32x4* prt = (LAS f32x4*)(F.lds + SC_PRM);
        for (int i = F.tid; i < 5 * 128; i += NWAVES * 64) { const int j = i >> 7, cc = 128 * h + (i & 127); cwt[i] = j < 4 ? (a.in[10] + F.zo)[(size_t)l * 4 * D + j * D + cc] : (a.in[11] + F.zo)[l * D + cc]; }
        for (int i = F.tid; i < 256; i += NWAVES * 64) prt[i] = ((const f32x4*)(F.ws + WS_SPT))[((size_t)l * 2 + (i >> 7)) * D + 128 * h + (i & 127)];
        __syncthreads();
    }
#endif
    int par = 0;
    for (; c >= 0; ++k) { const int cn = sc1_chunk(F.vcu, k + 1, F.G, rebal); scan_unit(F, a, l, c, cn, h, pf, bfr, SC1_ONEBAR ? par : 0); par ^= 1; c = cn; }
    if (SC1_ONEBAR) __syncthreads();
}
__device__ __forceinline__ int sc2_chunk(int v, int k, int G) {
    if ((LOCMAP & 4) && G == 256) { const int j = v >> 3, c0 = sc_first(j), n = sc_first(j + 1) - c0; return k < n ? c0 + k : -1; }
    if (S2_ROT) { const int cs = G >> 3, base = v >> 3, n = (NCHUNK - base + cs - 1) / cs; if (k >= n) return -1; return base + cs * ((k + base) % n); }
    return sc1_chunk(v, k, G, false);
}
__device__ __forceinline__ void ph_scan2(Frame& F) {
    const int tid = F.tid, lane = F.lane, w = F.wave, l15 = lane & 15, g = lane >> 4;
    unsigned char* ws = F.ws; LAS unsigned char* lds = F.lds;
    const int h = F.vcu & 7, cs = F.G >> 3; const int chl = 16 * w + l15, ch = 128 * h + chl;
    const float* CARRY = (const float*)(ws + WS_AGG + 2 * AGG_BYTES); bf16* RECG = (bf16*)(ws + WS_RECG);
    int par = 0;
#define S2_LOAD(Q, Y, C0, C1, cc) do { const u32x4* blk_ = (const u32x4*)(ws + WS_SCAB) + ((size_t)(((cc) * 8 + h) * 8 + w) * 8) * 64 + lane; \
        _Pragma("unroll") for (int k_ = 0; k_ < 8; ++k_) Q[k_] = SCAB_NT ? __builtin_nontemporal_load(blk_ + k_ * 64) : blk_[k_ * 64]; \
        _Pragma("unroll") for (int i_ = 0; i_ < 2; ++i_) Y[i_] = *(const u32x4*)((const bf16*)(ws + WS_P) + (size_t)(64 * (cc) + (tid >> 4) + 32 * i_) * INC + OFF_Y + 128 * h + 8 * (tid & 15)); \
        C0 = CARRY[((size_t)0 * NCHUNK + (cc)) * D + ch]; C1 = CARRY[((size_t)1 * NCHUNK + (cc)) * D + ch]; } while (0)
#define S2_PIN(n, Q, Y, C0, C1) asm volatile("s_waitcnt vmcnt(" n ")" : "+v"(Q[0]), "+v"(Q[1]), "+v"(Q[2]), "+v"(Q[3]), "+v"(Q[4]), "+v"(Q[5]), "+v"(Q[6]), "+v"(Q[7]), "+v"(Y[0]), "+v"(Y[1]), "+v"(C0), "+v"(C1) :: "memory")
    int nk2 = 0; while (sc2_chunk(F.vcu, nk2, F.G) >= 0) ++nk2;
    int k2 = S2_REV ? nk2 - 1 : 0; int c = nk2 > 0 ? sc2_chunk(F.vcu, k2, F.G) : -1;
    if (c < 0) return;
    u32x4 q[8], yq[2]; float cin0, cin1;
    S2_LOAD(q, yq, cin0, cin1, c); S2_PIN("0", q, yq, cin0, cin1);
    for (;; par ^= 1) {
        const int cn = S2_REV ? (k2 > 0 ? sc2_chunk(F.vcu, --k2, F.G) : -1) : sc2_chunk(F.vcu, ++k2, F.G); const bool has = cn >= 0;
        u32x4 qn[8], yn[2]; float cn0 = 0.f, cn1 = 0.f;
        if (has) S2_LOAD(qn, yn, cn0, cn1, cn);
        float hs[16];
#pragma unroll
        for (int d = 0; d < 2; ++d) {
            float av[16], bv[16];
#pragma unroll
            for (int hf = 0; hf < 2; ++hf) { const u32x4 pa = q[4 * d + hf], pb = q[4 * d + 2 + hf];
                av[8 * hf + 0] = 1.f - bflo(pa.x); av[8 * hf + 1] = 1.f - bfhi(pa.x); av[8 * hf + 2] = 1.f - bflo(pa.y); av[8 * hf + 3] = 1.f - bfhi(pa.y);
                av[8 * hf + 4] = 1.f - bflo(pa.z); av[8 * hf + 5] = 1.f - bfhi(pa.z); av[8 * hf + 6] = 1.f - bflo(pa.w); av[8 * hf + 7] = 1.f - bfhi(pa.w);
                bv[8 * hf + 0] = bflo(pb.x); bv[8 * hf + 1] = bfhi(pb.x); bv[8 * hf + 2] = bflo(pb.y); bv[8 * hf + 3] = bfhi(pb.y);
                bv[8 * hf + 4] = bflo(pb.z); bv[8 * hf + 5] = bfhi(pb.z); bv[8 * hf + 6] = bflo(pb.w); bv[8 * hf + 7] = bfhi(pb.w); }
            float As = 1.f, Bs = 0.f;
#pragma unroll
            for (int i = 0; i < 16; ++i) { const int k = d == 0 ? i : 15 - i; Bs = av[k] * Bs + bv[k]; As = av[k] * As; }
            const int gi = d == 0 ? g : 3 - g;
            const int p1 = (d == 0 ? lane - 16 : lane + 16) & 63, p2 = (d == 0 ? lane - 32 : lane + 32) & 63;
            float Ai = As, Bi = Bs;
            { const float A1 = bperm(Ai, p1), B1 = bperm(Bi, p1); if (gi >= 1) { Bi = Ai * B1 + Bi; Ai = Ai * A1; } }
            { const float A2 = bperm(Ai, p2), B2 = bperm(Bi, p2); if (gi >= 2) { Bi = Ai * B2 + Bi; Ai = Ai * A2; } }
            float Ae = bperm(Ai, p1), Be = bperm(Bi, p1); if (gi == 0) { Ae = 1.f; Be = 0.f; }
            float hc = Ae * (d == 0 ? cin0 : cin1) + Be;
#pragma unroll
            for (int i = 0; i < 16; ++i) { const int k = d == 0 ? i : 15 - i; hc = av[k] * hc + bv[k]; hs[k] = d == 0 ? hc : hs[k] + hc; }
        }
        LAS unsigned char* ot = lds + par * 17408;
#pragma unroll
        for (int k = 0; k < 16; ++k) *(LAS bf16*)(ot + (16 * g + k) * SC_STR + chl * 2) = f2bf(hs[k]);
        __syncthreads();
#pragma unroll
        for (int i = 0; i < 2; ++i) { const int t = (tid >> 4) + 32 * i, ch8 = tid & 15;
            const u32x4 r = *(const LAS u32x4*)(ot + t * SC_STR + ch8 * 16), y = yq[i]; u32x4 ov;
            ov.x = pk2(bflo(r.x) * bflo(y.x), bfhi(r.x) * bfhi(y.x)); ov.y = pk2(bflo(r.y) * bflo(y.y), bfhi(r.y) * bfhi(y.y));
            ov.z = pk2(bflo(r.z) * bflo(y.z), bfhi(r.z) * bfhi(y.z)); ov.w = pk2(bflo(r.w) * bflo(y.w), bfhi(r.w) * bfhi(y.w));
            st16w<1>(RECG + (size_t)(64 * c + t) * D + 128 * h + 8 * ch8, ov); }
        if (!has) break;
        S2_PIN("2", qn, yn, cn0, cn1);
#pragma unroll
        for (int k = 0; k < 8; ++k) q[k] = qn[k];
        yq[0] = yn[0]; yq[1] = yn[1]; cin0 = cn0; cin1 = cn1; c = cn;
    }
#undef S2_LOAD
#undef S2_PIN
}
__device__ __forceinline__ void ph_carry(Frame& F) {
    const int gw = F.vcu * NWAVES + F.wave;
    if (gw >= 64) return;
    const int idx = gw * 64 + F.lane, ch = idx & (D - 1), b = (idx >> 10) & 1, d = idx >> 11;
    const float* AGG_A = (const float*)(F.ws + WS_AGG) + (size_t)d * NCHUNK * D + ch; const float* AGG_B = (const float*)(F.ws + WS_AGG + AGG_BYTES) + (size_t)d * NCHUNK * D + ch;
    float* CARRY = (float*)(F.ws + WS_AGG + 2 * AGG_BYTES) + (size_t)d * NCHUNK * D + ch;
    float hcur = 0.f;
    {   float A[4], B[4];
#pragma unroll
        for (int i = 0; i < 4; ++i) { const int c = 256 + 4 * b + (d == 0 ? i : 3 - i); A[i] = AGG_A[(size_t)c * D]; B[i] = AGG_B[(size_t)c * D]; }
#pragma unroll
        for (int i = 0; i < 4; ++i) { const int c = 256 + 4 * b + (d == 0 ? i : 3 - i); CARRY[(size_t)c * D] = hcur; hcur = A[i] * hcur + B[i]; }
    }
    for (int i0 = 0; i0 < 128; i0 += 16) {
        float A[16], B[16];
#pragma unroll
        for (int i = 0; i < 16; ++i) { const int c = 128 * b + (d == 0 ? i0 + i : 127 - i0 - i); A[i] = AGG_A[(size_t)c * D]; B[i] = AGG_B[(size_t)c * D]; }
#pragma unroll
        for (int i = 0; i < 16; ++i) { const int c = 128 * b + (d == 0 ? i0 + i : 127 - i0 - i); CARRY[(size_t)c * D] = hcur; hcur = A[i] * hcur + B[i]; }
    }
}

__device__ __forceinline__ void ph_carry_par(Frame& F) {
    if (F.vcu >= 64) return;
    const int g = F.vcu, b = (g >> 4) & 1, d = g >> 5, ch = 64 * (g & 15) + F.lane, w = F.wave;
    const float* AGG_A = (const float*)(F.ws + WS_AGG) + (size_t)d * NCHUNK * D + ch; const float* AGG_B = (const float*)(F.ws + WS_AGG + AGG_BYTES) + (size_t)d * NCHUNK * D + ch;
    float* CARRY = (float*)(F.ws + WS_AGG + 2 * AGG_BYTES) + (size_t)d * NCHUNK * D + ch;
    const int s0 = w < 4 ? 17 * w : 68 + 16 * (w - 4), n = w < 4 ? 17 : 16;
#define CYP_C(s) ((s) < 4 ? 256 + 4 * b + (d == 0 ? (s) : 3 - (s)) : 128 * b + (d == 0 ? (s) - 4 : 131 - (s)))
    float A[17], B[17];
#pragma unroll
    for (int j = 0; j < 17; ++j) { A[j] = 1.f; B[j] = 0.f; if (j < n) { const int c = CYP_C(s0 + j); A[j] = AGG_A[(size_t)c * D]; B[j] = AGG_B[(size_t)c * D]; } }
    float Aw = 1.f, Bw = 0.f;
#pragma unroll
    for (int j = 0; j < 17; ++j) { Bw = A[j] * Bw + B[j]; Aw = A[j] * Aw; }
    LAS float* comp = (LAS float*)F.lds;
    comp[(w * 2 + 0) * 64 + F.lane] = Aw; comp[(w * 2 + 1) * 64 + F.lane] = Bw;
    __syncthreads();
    float h = 0.f;
    for (int w2 = 0; w2 < w; ++w2) h = comp[(w2 * 2 + 0) * 64 + F.lane] * h + comp[(w2 * 2 + 1) * 64 + F.lane];
#pragma unroll
    for (int j = 0; j < 17; ++j) { if (j < n) { const int c = CYP_C(s0 + j); CARRY[(size_t)c * D] = h; h = A[j] * h + B[j]; } }
#undef CYP_C
}

template <int NS  > __device__ __forceinline__ f32x4 ctx_tile(Frame& F, const bf16* A, const bf16* Bt, int r0, int c0) {
    constexpr int K = NS * 256;
    const int lane = F.lane, w = F.wave, l15 = lane & 15, g = lane >> 4;
    const bf16* ap = A + (size_t)(r0 + l15) * K + w * (K / 8) + 8 * g;
    const bf16* bp = Bt + (size_t)(c0 + l15) * K + w * (K / 8) + 8 * g;
    f32x4 acc[4][2];
#pragma unroll
    for (int rt = 0; rt < 4; ++rt) { acc[rt][0] = (f32x4){0.f, 0.f, 0.f, 0.f}; acc[rt][1] = (f32x4){0.f, 0.f, 0.f, 0.f}; }
#pragma unroll 4
    for (int s = 0; s < NS; ++s) {
        bf16x8 af[4], bf[2];
#pragma unroll
        for (int rt = 0; rt < 4; ++rt) af[rt] = *(const bf16x8*)(ap + (size_t)(16 * rt) * K + 32 * s);
        bf[0] = *(const bf16x8*)(bp + 32 * s); bf[1] = *(const bf16x8*)(bp + (size_t)16 * K + 32 * s);
#pragma unroll
        for (int rt = 0; rt < 4; ++rt) { acc[rt][0] = __builtin_amdgcn_mfma_f32_16x16x32_bf16(bf[0], af[rt], acc[rt][0], 0, 0, 0); acc[rt][1] = __builtin_amdgcn_mfma_f32_16x16x32_bf16(bf[1], af[rt], acc[rt][1], 0, 0, 0); }
    }
    LAS f32x4* red = (LAS f32x4*)F.lds;
    __syncthreads();
#pragma unroll
    for (int rt = 0; rt < 4; ++rt) { red[(w * 8 + 2 * rt) * 64 + lane] = acc[rt][0]; red[(w * 8 + 2 * rt + 1) * 64 + lane] = acc[rt][1]; }
    __syncthreads();
    const int tt = F.tid >> 6;
    f32x4 v = red[tt * 64 + lane];
#pragma unroll
    for (int ww = 1; ww < 8; ++ww) v = v + red[(ww * 8 + tt) * 64 + lane];
    return v;
}
__global__ void __launch_bounds__(NWAVES * 64, 2) mk_fwd(Args args) {
    extern __shared__ __attribute__((aligned(16))) unsigned char lds_raw[];
    Frame F;
    F.lds = (LAS unsigned char*)lds_raw;
    F.MISC = (volatile LAS unsigned*)(F.lds + LDSCTL_OFF);
    F.tid = threadIdx.x; F.lane = F.tid & 63; F.wave = __builtin_amdgcn_readfirstlane(F.tid >> 6);
    F.G = gridDim.x; F.bx = blockIdx.x; F.vcu = 0;
    F.ws = args.ws; F.zo = 0; F.ctl = (unsigned*)(args.ws + WS_CTL);
    for (int u = F.tid; u < (LDS_BYTES - LDSCTL_OFF) / 4; u += NWAVES * 64) ((LAS unsigned*)(F.lds + LDSCTL_OFF))[u] = 0u;
    __syncthreads();
    const int lo = args.ph_lo, hi = args.ph_hi;
    const bool multi = hi - lo > 1;
    unsigned* barw = F.ctl + CW_BAR + args.bar_idx * XCD_BAR_WORDS;
    XcdBarrier bar; bar.bar = barw; bar.x = 0; bar.st = nullptr;
    if (multi) bar = xcd_barrier_post(barw, F.MISC + 8);
#ifndef INPROJ_REV
#define INPROJ_REV 0
#endif
#ifndef UP_REV
#define UP_REV 0
#endif
#ifndef MERGE_REC_FIRST
#define MERGE_REC_FIRST 1
#endif
#ifndef ATT_SEAM
#define ATT_SEAM 1
#endif
#ifndef MOE_UP_WGM
#define MOE_UP_WGM 8
#endif
#ifndef DOWN_LIFO
#define DOWN_LIFO 1
#endif
#ifndef P2_SCAN_FIRST
#define P2_SCAN_FIRST 0
#endif
#ifndef ARPT
#define ARPT 2
#endif
#ifndef NO_SCAN1
#define NO_SCAN1 0
#endif
#ifndef PH_MASK
#define PH_MASK 0xffff
#endif
#define SITE(s) ((PH_MASK >> (s)) & 1)
#ifndef CHAIN_MOE
#define CHAIN_MOE 0
#endif
#ifndef DUP_MASK
#define DUP_MASK 0
#endif
#define REPS(s) for (int rep_ = 0; rep_ < (((DUP_MASK >> (s)) & 1) ? 2 : 1); ++rep_)
#define IN(k) (lo <= (k) && (k) < hi)
#define REFRESH() do { long zo_ = 0; int t_ = threadIdx.x, z_ = 0; asm volatile("" : "+s"(zo_), "+v"(t_), "+s"(z_)); \
    ws = args.ws + zo_; F.ws = ws; F.zo = zo_; F.ctl = (unsigned*)(ws + WS_CTL); F.tid = t_; F.lane = t_ & 63; F.wave = __builtin_amdgcn_readfirstlane(t_ >> 6); \
    F.lds = (LAS unsigned char*)lds_raw + z_; ring = F.lds + RING_OFF; \
    int bx_ = blockIdx.x, g_ = gridDim.x; asm volatile("" : "+s"(bx_), "+s"(g_)); F.bx = bx_; F.G = g_; F.vcu = (g_ % 8 == 0) ? (bx_ % 8) * (g_ / 8) + bx_ / 8 : bx_; } while (0)
#define SEAM(k) do { if (IN(k) && IN((k) + 1)) { XcdBarrier b_; unsigned* p_ = (unsigned*)(args.ws + WS_CTL) + CW_BAR + args.bar_idx * XCD_BAR_WORDS; unsigned x_ = xb_xcc_id(); asm volatile("" : "+s"(p_), "+s"(x_)); \
    b_.bar = p_; b_.x = x_; b_.st = (volatile LAS unsigned*)(lds_raw + LDSCTL_OFF) + 8; xcd_barrier(b_); } } while (0)
    unsigned char* ws = args.ws;
    LAS unsigned char* ring = F.lds + RING_OFF;

    if (SITE(0) && IN(0)) { REFRESH(); REPS(0) { ph_prologue(F, args); } if (multi && ((DUP_MASK >> 22) & 1)) { for (int xb_ = 0; xb_ < 20; ++xb_) { XcdBarrier b_ = bar; unsigned* p_ = b_.bar; unsigned x_ = b_.x; asm volatile("" : "+s"(p_), "+s"(x_)); b_.bar = p_; b_.x = x_; xcd_barrier(b_); } }
        if ((DUP_MASK >> 21) & 1) { __syncthreads(); ph_rows<1>(F, args, 0, false); ph_rows<1>(F, args, 0, false); ph_rows<1>(F, args, 0, false); ph_rows<1>(F, args, 0, false); } SEAM(0); }
    for (int l = 0; l < DEPTH; ++l) {
        const int pb = 1 + 11 * l;
        const bool moe = l & 1, last = l == DEPTH - 1;
        const int Mrows = last ? ML : MT;
        if (SITE(1) && IN(pb + 0)) { REFRESH(); for (int rn_ = 0; rn_ < ((((DUP_MASK >> 19) & 1) && l != 2) ? 2 : 1); ++rn_) ph_rows<0>(F, args, l, (args.flags & 4) && l > 0 && ((l - 1) & 1)); SEAM(pb + 0); }
        if (SITE(2) && IN(pb + 1)) { REFRESH(); REPS(2) {
            pg8::Gemm g{(const bf16*)(ws + WS_XN), (const bf16*)(ws + WS_WIN) + (size_t)l * INC * D, MT, INC, D}; pg8::StaticOrder S; S.init(MT, INC, F.G, F.bx, INPROJ_REV);
            pg8::EpiInProj E{(bf16*)(ws + WS_P), (const f32x4*)(ws + WS_ROPE)};
            pg8::gemm_phase<pg8::EpiInProj, pg8::StaticOrder, true, true>(ring, g, S, E);
            { const int rem = (MT / 256 * 22) % F.G; if (DEFER_CONV == 1 && rem && F.bx >= rem) conv_drain(F, args, 3); }
            } SEAM(pb + 1);
        }
        if (SITE(3) && IN(pb + 2)) { REFRESH(); REPS(3) {
            const int fl = args.flags & 3; const bool rebal_ = SC1_REBAL && multi && fl == 0 && F.G == 256;
            for (int ord_ = 0; ord_ < 2; ++ord_) { if ((ord_ == 0) != (P2_SCAN_FIRST != 0)) {
            if (fl == 0 || (fl & 1)) { for (int ra_ = 0; ra_ < (((DUP_MASK >> 16) & 1) ? ARPT : 1); ++ra_) { if ((LOCMAP & 1) && multi && F.G == 256) { for (int kv_ = 0; kv_ < 2; ++kv_) attn_unit(F, args.in[9] + F.zo + l * NH, (F.vcu >> 7) * 256 + kv_ * 128 + (F.vcu & 127)); }
                else if (ATT_SEAM) { const int lim_ = multi ? 512 : 528; const int nl_ = F.vcu < lim_ ? (lim_ - F.vcu + F.G - 1) / F.G : 0;
                    const int ux_ = (rebal_ && ((LOCMAP & 2) ? (F.vcu >= 224 && F.vcu < 240) : F.vcu >= 240)) ? 512 + F.vcu - ((LOCMAP & 2) ? 224 : 240) : -1;
                    attn_stream(F, args.in[9] + F.zo + l * NH, F.vcu, F.G, nl_, ux_); __syncthreads(); continue; }
                else for (int u = F.vcu; u < (multi ? 512 : 528); u += F.G) attn_unit(F, args.in[9] + F.zo + l * NH, u);
                if (rebal_ && ((LOCMAP & 2) ? (F.vcu >= 224 && F.vcu < 240) : F.vcu >= 240)) attn_unit(F, args.in[9] + F.zo + l * NH, 512 + F.vcu - ((LOCMAP & 2) ? 224 : 240)); __syncthreads(); } }
            if (DEFER_CONV == 2 && multi && l < DEPTH - 1) { conv_drain(F, args, 4); __syncthreads(); }
            } else {
            REFRESH();
            if (!NO_SCAN1 && (fl == 0 || (fl & 2))) { for (int rs_ = 0; rs_ < (((DUP_MASK >> 17) & 1) ? 2 : 1); ++rs_) { ph_scan1(F, args, l, SC1_REBAL && multi && fl == 0 && F.G == 256); __syncthreads(); } }
            } }
            } SEAM(pb + 2);
        }
        if (SITE(4) && IN(pb + 3)) { REFRESH(); if ((DUP_MASK >> 18) & 1) { ph_scan1(F, args, l); __syncthreads(); } REPS(4) { if (CARRY_PF && F.G == 256) { __syncthreads(); ph_carry_par(F); } else ph_carry(F); }
            if (multi && F.vcu >= 8 && !(SC1_REBAL && (args.flags & 3) == 0 && F.G == 256)) { for (int u = 512 + F.vcu - 8; u < 528; u += F.G) attn_unit(F, args.in[9] + F.zo + l * NH, u); }
            SEAM(pb + 3); }
        if (SITE(5) && IN(pb + 4)) { REFRESH(); REPS(5) { ph_scan2(F); } SEAM(pb + 4); }
        if (SITE(6) && IN(pb + 5)) { REFRESH(); REPS(6) {
            const bf16* WO = (const bf16*)(ws + WS_WO) + (size_t)l * 3 * D * D;
            pg8::StaticOrder S; S.init(ML, D, F.G, F.bx);
            { pg8::Gemm g{(const bf16*)(ws + (MERGE_REC_FIRST ? WS_RECG : WS_ATT)), WO + (MERGE_REC_FIRST ? (size_t)D * D : 0), ML, D, D}; pg8::EpiMerge E{(const bf16*)(ws + WS_P), (bf16*)(ws + WS_T1), (bf16*)(ws + WS_MM), 0, MERGE_REC_FIRST ? OFF_GR : OFF_GA};
              pg8::gemm_phase<pg8::EpiMerge, pg8::StaticOrder, true, true>(ring, g, S, E); }
            asm volatile("s_waitcnt vmcnt(0)" ::: "memory");
            if (F.tid == 0) { __builtin_amdgcn_fence(__ATOMIC_ACQUIRE, "agent"); asm volatile("s_waitcnt vmcnt(0)" ::: "memory"); }
            __syncthreads();
            { pg8::Gemm g{(const bf16*)(ws + (MERGE_REC_FIRST ? WS_ATT : WS_RECG)), WO + (MERGE_REC_FIRST ? 0 : (size_t)D * D), ML, D, D}; pg8::EpiMerge E{(const bf16*)(ws + WS_P), (bf16*)(ws + WS_T1), (bf16*)(ws + WS_MM), 1, MERGE_REC_FIRST ? OFF_GA : OFF_GR};
              pg8::gemm_phase<pg8::EpiMerge, pg8::StaticOrder, true, true>(ring, g, S, E); }
            if (!last) for (int tl = F.vcu; tl < 256; tl += F.G) {
                const int r0 = ML + 64 * (tl >> 5), c0 = 32 * (tl & 31);
                const int tt = F.tid >> 6; const size_t row = (size_t)(r0 + 16 * (tt >> 1) + (F.lane & 15)); const int col = c0 + 16 * (tt & 1) + 4 * (F.lane >> 4);
                const u32x2 ga = *(const u32x2*)((const bf16*)(ws + WS_P) + row * INC + OFF_GA + col), gr = *(const u32x2*)((const bf16*)(ws + WS_P) + row * INC + OFF_GR + col);
                const f32x4 s1 = ctx_tile<4>(F, (const bf16*)(ws + WS_ATT), WO, r0, c0);
                const f32x4 s2 = ctx_tile<4>(F, (const bf16*)(ws + WS_RECG), WO + (size_t)D * D, r0, c0);
                u32x2 o2; o2.x = pk2(bflo(ga.x) * s1[0] + bflo(gr.x) * s2[0], bfhi(ga.x) * s1[1] + bfhi(gr.x) * s2[1]); o2.y = pk2(bflo(ga.y) * s1[2] + bflo(gr.y) * s2[2], bfhi(ga.y) * s1[3] + bfhi(gr.y) * s2[3]);
                *(u32x2*)((bf16*)(ws + WS_MM) + row * D + col) = o2;
            }
            } SEAM(pb + 5);
        }
        if (SITE(7) && IN(pb + 6)) { REFRESH();
            const bf16* WOUT = (const bf16*)(ws + WS_WO) + (size_t)(l * 3 + 2) * D * D; const float* g1 = (const float*)(ws + WS_MOD) + (size_t)l * 18 * D + 2 * D;
            pg8::Gemm g{(const bf16*)(ws + WS_MM), WOUT, ML, D, D}; pg8::StaticOrder S; S.init(ML, D, F.G, F.bx);
            pg8::EpiResid E{(bf16*)(ws + WS_H), g1, (const bf16*)(ws + WS_H), l == 0 ? args.in[0] + F.zo : nullptr};
            pg8::gemm_phase<pg8::EpiResid, pg8::StaticOrder, true, true>(ring, g, S, E);
            if (!last) for (int tl = F.vcu; tl < 256; tl += F.G) {
                const int r0 = ML + 64 * (tl >> 5), c0 = 32 * (tl & 31);
                const int tt = F.tid >> 6; const size_t row = (size_t)(r0 + 16 * (tt >> 1) + (F.lane & 15)); const int col = c0 + 16 * (tt & 1) + 4 * (F.lane >> 4);
                bf16* hp = (bf16*)(ws + WS_H) + row * D + col; f32x4 bi;
                if (l == 0) bi = *(const f32x4*)(args.in[2] + F.zo + (row - ML) * D + col); else { const u32x2 hb = *(const u32x2*)hp; bi = (f32x4){bflo(hb.x), bfhi(hb.x), bflo(hb.y), bfhi(hb.y)}; }
                const f32x4 gv = *(const f32x4*)(g1 + 12 * D + col);
                const f32x4 s = ctx_tile<4>(F, (const bf16*)(ws + WS_MM), WOUT, r0, c0);
                const f32x4 ho = bi + gv * s; u32x2 hw; hw.x = pk2(ho[0], ho[1]); hw.y = pk2(ho[2], ho[3]); *(u32x2*)hp = hw;
            }
            SEAM(pb + 6);
        }
        if (SITE(8) && IN(pb + 7)) { REFRESH(); for (int rn_ = 0; rn_ < ((((DUP_MASK >> 20) & 1) && !moe) ? 2 : 1); ++rn_) ph_rows<1>(F, args, l, false); SEAM(pb + 7); }
        if (SITE(9) && IN(pb + 8) && moe) { REFRESH(); if (last) { conv_drain(F, args, 1 << 30); __syncthreads(); }
            ph_lists(F, l); SEAM(pb + 8); }
        if (SITE(10) && IN(pb + 9)) { REFRESH(); REPS(10) {
            if (!moe) {
                pg8::Gemm g{(const bf16*)(ws + WS_XN), (const bf16*)(ws + WS_FF + (l >> 1) * FF_STRIDE), Mrows, 2 * DFF, D}; pg8::ExpertOrder S; S.init(Mrows, 2 * DFF, F.G, F.bx, UP_REV); S.panel_e = (const int*)(ws + WS_PANELE); S.estride = 0; S.pub = nullptr; S.ready = nullptr; S.need = 0; S.tmo = nullptr; S.pend = -1;
                pg8::EpiSwiGLU E{(bf16*)(ws + WS_HID), DFF, 0};
                pg8::gemm_phase<pg8::EpiSwiGLU, pg8::ExpertOrder, true, true>(ring, g, S, E);
                { const int rem = (Mrows / 256 * 22) % F.G; if (DEFER_CONV == 1 && rem && F.bx >= rem) conv_drain(F, args, 3); }
            } else {
                const int np = __builtin_amdgcn_readfirstlane(((const int*)(ws + WS_PANELE))[256]);
                pg8::Gemm g{(const bf16*)(ws + WS_XN), (const bf16*)(ws + WS_EXP + (l >> 1) * EXP_STRIDE), np * 256, 2 * DFE, D}; pg8::GatherOrder S; S.arow = (const int*)(ws + WS_SLOTTOK);     S.init(np * 256, 2 * DFE, F.G, F.bx, UP_REV); S.wgm = MOE_UP_WGM;     S.panel_e = (const int*)(ws + WS_PANELE); S.estride = (size_t)2 * DFE * D * 2;
                S.pub = CHAIN_MOE ? F.ctl + CW_RDY + l * 16384 : nullptr; S.ready = nullptr; S.need = 0; S.tmo = nullptr; S.pend = -1;
                pg8::EpiSwiGLU E{(bf16*)(ws + WS_HID), DFE, CHAIN_MOE};
                pg8::gemm_phase<pg8::EpiSwiGLU, pg8::GatherOrder, true, true>(ring, g, S, E);
                S.flush();
                { const int rem = (np * 28) % F.G; if (DEFER_CONV == 1 && rem && F.bx >= rem) conv_drain(F, args, 3); }
            }
            } if (!moe || !CHAIN_MOE) SEAM(pb + 9);
        }
        if (SITE(11) && IN(pb + 10)) { REFRESH();
            if (!moe) {
                const bf16* WD = (const bf16*)(ws + WS_FF + (l >> 1) * FF_STRIDE) + (size_t)2 * DFF * D; const float* g2 = (const float*)(ws + WS_MOD) + (size_t)l * 18 * D + 5 * D;
                pg8::Gemm g{(const bf16*)(ws + WS_HID), WD, ML, D, DFF}; pg8::StaticOrder S; S.init(ML, D, F.G, F.bx, DOWN_LIFO ? 2 : 0);
                pg8::EpiResid E{(bf16*)(ws + WS_H), g2, (const bf16*)(ws + WS_H), nullptr};
                pg8::gemm_phase<pg8::EpiResid, pg8::StaticOrder, true, true>(ring, g, S, E);
                for (int tl = F.vcu; tl < 256; tl += F.G) {
                    const int r0 = ML + 64 * (tl >> 5), c0 = 32 * (tl & 31);
                    const int tt = F.tid >> 6; const size_t row = (size_t)(r0 + 16 * (tt >> 1) + (F.lane & 15)); const int col = c0 + 16 * (tt & 1) + 4 * (F.lane >> 4);
                    bf16* hp = (bf16*)(ws + WS_H) + row * D + col; const u32x2 hb = *(const u32x2*)hp; const f32x4 gv = *(const f32x4*)(g2 + 12 * D + col);
                    const f32x4 s = ctx_tile<11>(F, (const bf16*)(ws + WS_HID), WD, r0, c0);
                    const f32x4 ho = (f32x4){bflo(hb.x), bfhi(hb.x), bflo(hb.y), bfhi(hb.y)} + gv * s; u32x2 hw; hw.x = pk2(ho[0], ho[1]); hw.y = pk2(ho[2], ho[3]); *(u32x2*)hp = hw;
                }
            } else {
                const int np = __builtin_amdgcn_readfirstlane(((const int*)(ws + WS_PANELE))[256]);
                pg8::Gemm g{(const bf16*)(ws + WS_HID), (const bf16*)(ws + WS_EXP + (l >> 1) * EXP_STRIDE) + (size_t)NE * 2 * DFE * D, np * 256, D, DFE}; pg8::ExpertOrder S;
                const int Uup = CHAIN_MOE ? np * 28 : 0, i0 = Uup > F.bx ? (Uup - F.bx + F.G - 1) / F.G : 0;
                S.init(np * 256, D, F.G, F.bx + i0 * F.G - Uup, (DOWN_LIFO && !CHAIN_MOE) ? 2 : 0); S.panel_e = (const int*)(ws + WS_PANELE); S.estride = (size_t)D * DFE * 2;
                S.pub = nullptr; S.ready = CHAIN_MOE ? F.ctl + CW_RDY + l * 16384 : nullptr; S.need = 28u * 8u; S.tmo = F.ctl + CW_TMO; S.pend = -1;
                const int npm = CHAIN_MOE ? np : (np / (F.G / 4)) * (F.G / 4);
                S.nM = npm; S.nwg = npm * 4;
                pg8::EpiPlain E{(bf16*)(ws + WS_FS), D};
                pg8::gemm_phase<pg8::EpiPlain, pg8::ExpertOrder, true, true>(ring, g, S, E);
                for (int tl = F.vcu; tl < (np - npm) * 128; tl += F.G) {
                    const int pm = npm + (tl >> 7), r0 = 256 * pm + 64 * ((tl >> 5) & 3), c0 = 32 * (tl & 31);
                    const int e = __builtin_amdgcn_readfirstlane(((const int*)(ws + WS_PANELE))[pm]);
                    const f32x4 s = ctx_tile<14>(F, (const bf16*)(ws + WS_HID), (const bf16*)(ws + WS_EXP + (l >> 1) * EXP_STRIDE) + (size_t)NE * 2 * DFE * D + (size_t)e * D * DFE, r0, c0);
                    const int tt = F.tid >> 6; const size_t row = (size_t)(r0 + 16 * (tt >> 1) + (F.lane & 15)); const int col = c0 + 16 * (tt & 1) + 4 * (F.lane >> 4);
                    u32x2 o2; o2.x = pk2(s[0], s[1]); o2.y = pk2(s[2], s[3]);
                    *(u32x2*)((bf16*)(ws + WS_FS) + row * D + col) = o2;
                }
                if (!CHAIN_MOE && DEFER_CONV == 1) { const int rem = (np * 4) % F.G; if (rem && F.bx >= rem) conv_drain(F, args, 7); }
            }
            SEAM(pb + 10);
        }
    }
    if (SITE(12) && IN(45)) { REFRESH(); ph_rows<2>(F, args, DEPTH, (args.flags & 4) != 0); }
#undef IN
#undef SEAM
}

static int g_bar_idx = 0;
static void opt_launch(void* const* d_in, void* d_out, void* d_ws, hipStream_t stream, int ph_lo, int ph_hi, int flags) {
    static int grid = 0;
    if (grid == 0) {
        int dev = 0, cus = 0, per_cu = 0;
        if (hipGetDevice(&dev) != hipSuccess || hipDeviceGetAttribute(&cus, hipDeviceAttributeMultiprocessorCount, dev) != hipSuccess) { fprintf(stderr, "opt_launch: device query failed\n"); grid = -1; return; }
        if (hipFuncSetAttribute((const void*)mk_fwd, hipFuncAttributeMaxDynamicSharedMemorySize, LDS_BYTES) != hipSuccess) { fprintf(stderr, "opt_launch: hipFuncSetAttribute failed\n"); grid = -1; return; }
        if (hipOccupancyMaxActiveBlocksPerMultiprocessor(&per_cu, (const void*)mk_fwd, NWAVES * 64, LDS_BYTES) != hipSuccess || per_cu < 1) { fprintf(stderr, "opt_launch: occupancy query says %d blocks per CU\n", per_cu); }
        (void)hipGetLastError();
        grid = cus;
        if (grid % 8 != 0 || grid < 64) fprintf(stderr, "opt_launch: unexpected CU count %d\n", grid);
    }
    if (grid < 0) return;
    Args a{};
    for (int i = 0; i < 28; ++i) a.in[i] = (const float*)d_in[i];
    a.out = (float*)d_out; a.ws = (unsigned char*)d_ws; a.ph_lo = ph_lo; a.ph_hi = ph_hi; a.flags = flags; a.bar_idx = (ph_hi - ph_lo > 1) ? g_bar_idx++ : 0;
    hipLaunchKernelGGL(mk_fwd, dim3(grid), dim3(NWAVES * 64), LDS_BYTES, stream, a);
    const hipError_t le = hipPeekAtLastError();
    if (le != hipSuccess) fprintf(stderr, "opt_launch: launch [%d,%d) failed: %s\n", ph_lo, ph_hi, hipGetErrorName(le));
}


extern "C" void kernel_launch(void* const* d_in, const int* in_sizes, int n_in, void* d_out, int out_size, void* d_ws, size_t ws_size, hipStream_t stream) {
    if (n_in != 28 || ws_size < WS_END) { fprintf(stderr, "kernel_launch: unexpected n_in %d or ws_size %zu (need %zu)\n", n_in, ws_size, (size_t)WS_END); return; }
    const float* x = (const float*)d_in[0]; const float* c = (const float*)d_in[1]; const float* ctx = (const float*)d_in[2]; const float* c_ctx = (const float*)d_in[3];
    const float* w_mod = (const float*)d_in[4]; const float* b_mod = (const float*)d_in[5]; const float* norm1_g = (const float*)d_in[6]; const float* norm2_g = (const float*)d_in[7];
    const float* w_in = (const float*)d_in[8]; const float* attn_sink = (const float*)d_in[9]; const float* conv_w = (const float*)d_in[10]; const float* conv_b = (const float*)d_in[11];
    const float* gate_a_w = (const float*)d_in[12]; const float* gate_a_b = (const float*)d_in[13]; const float* gate_x_w = (const float*)d_in[14]; const float* gate_x_b = (const float*)d_in[15];
    const float* lru_lambda = (const float*)d_in[16]; const float* w_o_attn = (const float*)d_in[17]; const float* w_o_lru = (const float*)d_in[18]; const float* w_out = (const float*)d_in[19];
    const float* ff_w_gate = (const float*)d_in[20]; const float* ff_w_up = (const float*)d_in[21]; const float* ff_w_down = (const float*)d_in[22]; const float* router_w = (const float*)d_in[23];
    const float* exp_w_gate = (const float*)d_in[24]; const float* exp_w_up = (const float*)d_in[25]; const float* exp_w_down = (const float*)d_in[26]; const float* final_g = (const float*)d_in[27];
    char* ws = (char*)d_ws;
    float* MOD = (float*)(ws + WS_MOD);
    int* te = (int*)(ws + WS_TE); float* tw = (float*)(ws + WS_TW); int* slot_tok = (int*)(ws + WS_SLOTTOK); int* tok_slot = (int*)(ws + WS_TOKSLOT); int* tile_e = (int*)(ws + WS_PANELE);
    float* H = (float*)(ws + WS_H); bf16* XN = (bf16*)(ws + WS_XN); bf16* P = (bf16*)(ws + WS_P); bf16* ATT = (bf16*)(ws + WS_ATT); bf16* RECG = (bf16*)(ws + WS_RECG);
    bf16* MM = (bf16*)(ws + WS_MM); bf16* HID = (bf16*)(ws + WS_HID); bf16* FS = (bf16*)(ws + WS_FS);
    float* XC = (float*)(ws + NV_XC); float* RG = (float*)(ws + NV_RG); float* IG = (float*)(ws + NV_IG); float* REC = (float*)(ws + NV_REC); float* PF = (float*)(ws + NV_PF32);
    const int EB = (int)(((long)MT * D + 255) / 256);
    (void)out_size; (void)in_sizes;

    (void)hipMemsetAsync(ws + WS_CTL, 0, CTL_ZERO_BYTES, stream);
    g_bar_idx = 0;
    const int CF = OPT_STEP >= 6 ? 4 : 0;
#if OPT_STEP >= 8
    opt_launch(d_in, d_out, d_ws, stream, 0, 46, 4);
    return;
#endif
#if OPT_STEP >= 1
    opt_launch(d_in, d_out, d_ws, stream, 0, 1, 0);
#else
    (void)hipMemcpyAsync(H, x, (size_t)ML * D * 4, hipMemcpyDeviceToDevice, stream);
    (void)hipMemcpyAsync(H + (size_t)ML * D, ctx, (size_t)MC * D * 4, hipMemcpyDeviceToDevice, stream);
    hipLaunchKernelGGL(nv::k_mod, dim3(6 * D / 256, DEPTH), dim3(256), 0, stream, c, c_ctx, w_mod, b_mod, MOD);
#endif
    for (int l = 0; l < DEPTH; ++l) {
        const float* MODl = MOD + (size_t)l * 3 * 6 * D;
        const int pb = 1 + 11 * l;
#if OPT_STEP >= 1
        opt_launch(d_in, d_out, d_ws, stream, pb + 0, pb + 2, CF);
#else
        hipLaunchKernelGGL((nv::k_norm_mod<bf16>), dim3(MT / 4), dim3(256), 0, stream, H, norm1_g + l * D, MODl, 0, D, XN, MT);
        ngemm(stream, XN, D, nullptr, w_in + (size_t)l * D * INC, INC, PF, INC, MT, INC, D);
        hipLaunchKernelGGL(nv::k_rope, dim3((ML * 640 + 255) / 256), dim3(256), 0, stream, PF);
        hipLaunchKernelGGL(nv::k_pfmt, dim3((int)(((long)MT * INC + 255) / 256)), dim3(256), 0, stream, PF, P);
#endif
#if OPT_STEP >= 2
        opt_launch(d_in, d_out, d_ws, stream, pb + 2, pb + 3, 1);
#else
        hipLaunchKernelGGL(nv::k_attn, dim3(MT * NH / 4), dim3(256), 0, stream, P, attn_sink + l * NH, ATT);
#endif
#if OPT_STEP >= 3
        opt_launch(d_in, d_out, d_ws, stream, pb + 2, pb + 3, 2);
        opt_launch(d_in, d_out, d_ws, stream, pb + 3, pb + 5, 0);
#else
        hipLaunchKernelGGL(nv::k_conv, dim3(EB), dim3(256), 0, stream, P, conv_w + (size_t)l * 4 * D, conv_b + l * D, XC);
        for (int d = 0; d < 2; ++d) {
            const size_t go = ((size_t)l * 2 + d) * 8 * 128 * 128, vo = ((size_t)l * 2 + d) * D;
            ngemm(stream, XC, D, nullptr, gate_a_w + go, 128, RG, D, MT, 128, 128, 8, 128, 128 * 128, 128);
            ngemm(stream, XC, D, nullptr, gate_x_w + go, 128, IG, D, MT, 128, 128, 8, 128, 128 * 128, 128);
            hipLaunchKernelGGL(nv::k_scan, dim3(BATCH * D / 64), dim3(64), 0, stream, XC, RG, IG, gate_a_b + vo, gate_x_b + vo, lru_lambda + vo, d, REC);
        }
        hipLaunchKernelGGL(nv::k_recgate, dim3(EB), dim3(256), 0, stream, REC, P, RECG);
#endif
#if OPT_STEP >= 4
        opt_launch(d_in, d_out, d_ws, stream, pb + 5, pb + 7, 0);
#else
        ngemm(stream, ATT, D, nullptr, w_o_attn + (size_t)l * D * D, D, RG, D, MT, D, D);
        ngemm(stream, RECG, D, nullptr, w_o_lru + (size_t)l * D * D, D, IG, D, MT, D, D);
        hipLaunchKernelGGL(nv::k_merge, dim3(EB), dim3(256), 0, stream, RG, IG, P, MM);
        ngemm(stream, MM, D, nullptr, w_out + (size_t)l * D * D, D, XC, D, MT, D, D);
        hipLaunchKernelGGL(nv::k_resid, dim3(EB), dim3(256), 0, stream, H, XC, MODl, 2 * D);
#endif
        const int i = l / 2;
        if (l % 2 == 0) {
#if OPT_STEP >= 5
            opt_launch(d_in, d_out, d_ws, stream, pb + 7, pb + 11, 0);
#else
            hipLaunchKernelGGL((nv::k_norm_mod<bf16>), dim3(MT / 4), dim3(256), 0, stream, H, norm2_g + l * D, MODl, 3 * D, 4 * D, XN, MT);
            ngemm(stream, XN, D, nullptr, ff_w_gate + (size_t)i * D * DFF, DFF, HID, DFF, MT, DFF, D);
            ngemm(stream, XN, D, nullptr, ff_w_up + (size_t)i * D * DFF, DFF, HID, DFF, MT, DFF, D, 1, 0, 0, 0, nullptr, 0, 1);
            ngemm(stream, HID, DFF, nullptr, ff_w_down + (size_t)i * DFF * D, D, IG, D, MT, D, DFF);
            hipLaunchKernelGGL(nv::k_resid, dim3(EB), dim3(256), 0, stream, H, IG, MODl, 5 * D);
#endif
        } else {
#if OPT_STEP >= 6
            opt_launch(d_in, d_out, d_ws, stream, pb + 7, pb + 11, 0);
#if OPT_STEP == 6
            if (l == DEPTH - 1) hipLaunchKernelGGL(nv::k_moe_combine, dim3(EB), dim3(256), 0, stream, H, FS, tok_slot, tw, MODl, 5 * D);
#endif
#else
            hipLaunchKernelGGL((nv::k_norm_mod<bf16>), dim3(MT / 4), dim3(256), 0, stream, H, norm2_g + l * D, MODl, 3 * D, 4 * D, XN, MT);
            hipLaunchKernelGGL(nv::k_route, dim3(MT / 4), dim3(256), 0, stream, XN, router_w + (size_t)i * D * NE, te, tw);
            hipLaunchKernelGGL(nv::k_moe_lists, dim3(1), dim3(1024), 0, stream, te, slot_tok, tok_slot, tile_e);
            const size_t eo = (size_t)i * NE * D * DFE;
            ngemm(stream, XN, D, slot_tok, exp_w_gate + eo, DFE, HID, DFE, NSLOT, DFE, D, 1, 0, 0, 0, tile_e, (long)D * DFE, 0);
            ngemm(stream, XN, D, slot_tok, exp_w_up + eo, DFE, HID, DFE, NSLOT, DFE, D, 1, 0, 0, 0, tile_e, (long)D * DFE, 1);
            ngemm(stream, HID, DFE, nullptr, exp_w_down + eo, D, FS, D, NSLOT, D, DFE, 1, 0, 0, 0, tile_e, (long)DFE * D, 0);
            hipLaunchKernelGGL(nv::k_moe_combine, dim3(EB), dim3(256), 0, stream, H, FS, tok_slot, tw, MODl, 5 * D);
#endif
        }
    }
#if OPT_STEP >= 7
    opt_launch(d_in, d_out, d_ws, stream, 45, 46, CF);
#else
    hipLaunchKernelGGL(nv::k_final, dim3(ML / 4), dim3(256), 0, stream, H, final_g, (float*)d_out);
#endif
}
```

```cpp
#include <hip/hip_runtime.h>
#include <cstdio>
#include <cstdint>

#define ADUP 0
#define A3_PRIO 1
#define A3_NOSBAR 1
#define A3_LATEDMA 1
#define MOE_UP_WGM 2
#ifndef OPT_STEP
#define OPT_STEP 8
#endif

constexpr int D = 1024, BATCH = 2, SEQ = 8192, DEPTH = 4, CTX = 256, GRIDW = 64;
constexpr int NH = 8, NKV = 2, HD = 128, WIN = 128;
constexpr int DFF = 2816, NE = 8, DFE = 3584;
constexpr int INC = 5632;
constexpr int OFF_Q = 0, OFF_K = 1024, OFF_V = 1280, OFF_X = 1536, OFF_Y = 2560, OFF_GA = 3584, OFF_GR = 4608;
constexpr int ML = BATCH * SEQ, MC = BATCH * CTX, MT = ML + MC;
constexpr int NSLOT = 35840;
constexpr int NCHUNK = MT / 64;
constexpr float EPS = 1e-6f;
constexpr size_t MiB = 1u << 20;

typedef unsigned short bf16;
typedef float f32x4 __attribute__((ext_vector_type(4)));
typedef float f32x2 __attribute__((ext_vector_type(2)));
typedef float f32x16 __attribute__((ext_vector_type(16)));
typedef unsigned u32x4 __attribute__((ext_vector_type(4)));
typedef unsigned u32x2 __attribute__((ext_vector_type(2)));
typedef short bf16x8 __attribute__((ext_vector_type(8)));
typedef __bf16 bf2_t __attribute__((ext_vector_type(2)));
#define LAS __attribute__((address_space(3)))
#define GAS __attribute__((address_space(1)))
typedef GAS unsigned gu32;

__device__ __forceinline__ unsigned pk2(float lo, float hi) { f32x2 v = {lo, hi}; return __builtin_bit_cast(unsigned, __builtin_convertvector(v, bf2_t)); }
#ifndef WT_STORES
#define WT_STORES 0
#endif
template <int BIT = 0> __device__ __forceinline__ void st16w(void* p, u32x4 v) { if ((WT_STORES >> BIT) & 1) asm volatile("global_store_dwordx4 %0, %1, off sc1\n\ts_nop 1" :: "v"(p), "v"(v) : "memory"); else *(u32x4*)p = v; }
template <int BIT = 0> __device__ __forceinline__ void st8w(void* p, u32x2 v) { if ((WT_STORES >> BIT) & 1) asm volatile("global_store_dwordx2 %0, %1, off sc1\n\ts_nop 1" :: "v"(p), "v"(v) : "memory"); else *(u32x2*)p = v; }
__device__ __forceinline__ bf16 f2bf(float f) { return (bf16)(pk2(f, 0.f) & 0xffffu); }
__device__ __forceinline__ float bf2f(bf16 b) { return __uint_as_float(((unsigned)b) << 16); }
__device__ __forceinline__ float bflo(unsigned u) { return __uint_as_float(u << 16); }
__device__ __forceinline__ float bfhi(unsigned u) { return __uint_as_float(u & 0xffff0000u); }
__device__ __forceinline__ float ldf(const float* p) { return *p; }
__device__ __forceinline__ float ldf(const bf16* p) { return bf2f(*p); }
__device__ __forceinline__ void stf(float* p, float v) { *p = v; }
__device__ __forceinline__ void stf(bf16* p, float v) { *p = f2bf(v); }

__device__ __forceinline__ float sigm(float x) { return 1.f / (1.f + expf(-x)); }
__device__ __forceinline__ float silu_f(float x) { return x * sigm(x); }
__device__ __forceinline__ float gelu_tanh(float x) { return 0.5f * x * (1.f + tanhf(0.7978845608028654f * (x + 0.044715f * x * x * x))); }
__device__ __forceinline__ float fsigm(float x) { return __builtin_amdgcn_rcpf(1.f + __builtin_amdgcn_exp2f(-1.4426950408889634f * x)); }
__device__ __forceinline__ float fsilu(float x) { return x * fsigm(x); }
__device__ __forceinline__ float fgelu(float x) { return x * __builtin_amdgcn_rcpf(1.f + __builtin_amdgcn_exp2f(-2.302208198f * (x + 0.044715f * x * x * x))); }
__device__ __forceinline__ float wave_sum(float v) {
#pragma unroll
    for (int o = 1; o < 64; o <<= 1) v += __shfl_xor(v, o);
    return v;
}
__device__ __forceinline__ float wave_max(float v) {
#pragma unroll
    for (int o = 1; o < 64; o <<= 1) v = fmaxf(v, __shfl_xor(v, o));
    return v;
}
__device__ __forceinline__ int row_vec(int m) { return m < ML ? m / SEQ : 2; }
__host__ __device__ __forceinline__ int qk_orig(int ni) { return (ni >> 6) * 64 + (ni & 1) * 32 + ((ni & 63) >> 1); }

constexpr size_t WS_CTL = 0, CTL_ZERO_BYTES = 1 * MiB;
constexpr size_t WS_MOD = 2 * MiB, WS_ROPE = WS_MOD + 320 * 1024, WS_TE = WS_MOD + 384 * 1024, WS_TW = WS_MOD + 576 * 1024, WS_TOKSLOT = WS_MOD + 768 * 1024, WS_PANELE = WS_MOD + 960 * 1024;
constexpr size_t WS_SLOTTOK = 3 * MiB, WS_WCNT = 3 * MiB + 704 * 1024  , WS_SPT = 3 * MiB + 512 * 1024;
constexpr size_t WS_AGG = 4 * MiB;
constexpr size_t AGG_BYTES = (size_t)2 * NCHUNK * D * 4;
constexpr size_t WS_GT = 12 * MiB;
constexpr size_t WS_WIN = 16 * MiB;
constexpr size_t WS_WO = 60 * MiB;
constexpr size_t WS_FF = 84 * MiB, FF_STRIDE = (size_t)(2 * DFF * D + D * DFF) * 2;
constexpr size_t WS_EXP = 117 * MiB, EXP_STRIDE = (size_t)NE * (2 * DFE * D + D * DFE) * 2;
constexpr size_t WS_H = 453 * MiB, WS_XN = 519 * MiB, WS_P = 552 * MiB, WS_ATT = 734 * MiB, WS_RECG = 767 * MiB, WS_T1 = 800 * MiB, WS_MM = 833 * MiB, WS_XS = 866 * MiB, WS_END = 966 * MiB;
constexpr size_t WS_HID = WS_P, WS_FS = WS_XS;
constexpr size_t WS_SCAB = WS_T1;
static_assert(WS_SCAB + (size_t)NCHUNK * 8 * 8 * 10 * 1024 <= WS_END, "scan block area");
static_assert(WS_FF + 2 * FF_STRIDE <= WS_EXP && WS_EXP + 2 * EXP_STRIDE <= WS_H && WS_HID + (size_t)NSLOT * DFE * 2 <= WS_T1 && WS_AGG + 3 * AGG_BYTES <= WS_GT, "ws map");
constexpr size_t NV_XC = WS_EXP, NV_RG = WS_EXP + 66 * MiB, NV_IG = WS_EXP + 132 * MiB, NV_REC = WS_EXP + 198 * MiB, NV_PF32 = 16 * MiB;
constexpr int CW_TMO = 0, CW_Q = 1024, CW_CNT = 2048, CW_CUR = 2048 + 256, CW_BAR = 4096, CW_RDY = 131072;

namespace nv {
__global__ __launch_bounds__(256) void k_mod(const float* c, const float* c_ctx, const float* w_mod, const float* b_mod, float* MOD) {
    __shared__ float s[3][D];
    const int l = blockIdx.y, n = blockIdx.x * 256 + threadIdx.x;
    for (int i = threadIdx.x; i < 3 * D; i += 256) { const int v = i / D, k = i % D; const float x = v < 2 ? c[v * D + k] : c_ctx[k]; s[v][k] = silu_f(x); }
    __syncthreads();
    const float* w = w_mod + (size_t)l * D * 6 * D + n;
    float a0 = 0.f, a1 = 0.f, a2 = 0.f;
    for (int k = 0; k < D; ++k) { const float wv = w[(size_t)k * 6 * D]; a0 += s[0][k] * wv; a1 += s[1][k] * wv; a2 += s[2][k] * wv; }
    const float b = b_mod[l * 6 * D + n];
    float* o = MOD + (size_t)l * 3 * 6 * D + n;
    o[0] = a0 + b; o[6 * D] = a1 + b; o[12 * D] = a2 + b;
}
template <class TO> __global__ __launch_bounds__(256) void k_norm_mod(const float* H, const float* g, const float* MODl, int sh_off, int sc_off, TO* XN, int nrows) {
    const int m = (blockIdx.x * 256 + threadIdx.x) >> 6, lane = threadIdx.x & 63;
    if (m >= nrows) return;
    const float* h = H + (size_t)m * D;
    float v[16]; float ss = 0.f;
#pragma unroll
    for (int j = 0; j < 16; ++j) { v[j] = h[lane + 64 * j]; ss += v[j] * v[j]; }
    ss = wave_sum(ss);
    const float r = rsqrtf(ss * (1.f / D) + EPS);
    const float* mv = MODl + (size_t)row_vec(m) * 6 * D;
#pragma unroll
    for (int j = 0; j < 16; ++j) { const int n = lane + 64 * j; stf(XN + (size_t)m * D + n, (v[j] * r * g[n]) * (1.f + mv[sc_off + n]) + mv[sh_off + n]); }
}
template <class TA, class TC> struct NGemm {
    const TA* A; int lda; const int* arow;
    const float* B; int ldb; TC* C; int ldc; int K;
    long sA, sB, sC;
    const int* tile_e; long sBe;
    int mode;
};
template <class TA, class TC> __global__ __launch_bounds__(256) void k_gemm(NGemm<TA, TC> g) {
    const int z = blockIdx.z, tm = blockIdx.y, tn = blockIdx.x;
    const TA* A = g.A + (long)z * g.sA; const float* B = g.B + (long)z * g.sB; TC* C = g.C + (long)z * g.sC;
    if (g.tile_e) { const int e = g.tile_e[tm]; if (e < 0) return; B += (long)e * g.sBe; }
    const int wave = threadIdx.x >> 6, lane = threadIdx.x & 63, lr = lane & 15, lk = lane >> 4;
    const int m0 = tm * 128 + (wave >> 1) * 64, n0 = tn * 128 + (wave & 1) * 64;
    const TA* ap0; const TA* ap1; const TA* ap2; const TA* ap3;
    {
        int r0 = m0 + lr, r1 = r0 + 16, r2 = r0 + 32, r3 = r0 + 48;
        if (g.arow) { r0 = g.arow[r0]; r1 = g.arow[r1]; r2 = g.arow[r2]; r3 = g.arow[r3]; r0 = r0 < 0 ? 0 : r0; r1 = r1 < 0 ? 0 : r1; r2 = r2 < 0 ? 0 : r2; r3 = r3 < 0 ? 0 : r3; }
        ap0 = A + (long)r0 * g.lda + lk; ap1 = A + (long)r1 * g.lda + lk; ap2 = A + (long)r2 * g.lda + lk; ap3 = A + (long)r3 * g.lda + lk;
    }
    const float* bp = B + (long)lk * g.ldb + n0 + lr;
    f32x4 acc[4][4];
#pragma unroll
    for (int i = 0; i < 4; ++i)
#pragma unroll
        for (int j = 0; j < 4; ++j) acc[i][j] = (f32x4){0.f, 0.f, 0.f, 0.f};
    const long ldb = g.ldb;
    for (int k = 0; k < g.K; k += 4) {
        float a[4], b[4];
        a[0] = ldf(ap0 + k); a[1] = ldf(ap1 + k); a[2] = ldf(ap2 + k); a[3] = ldf(ap3 + k);
        const float* bk = bp + (long)k * ldb;
        b[0] = bk[0]; b[1] = bk[16]; b[2] = bk[32]; b[3] = bk[48];
#pragma unroll
        for (int i = 0; i < 4; ++i)
#pragma unroll
            for (int j = 0; j < 4; ++j) acc[i][j] = __builtin_amdgcn_mfma_f32_16x16x4f32(a[i], b[j], acc[i][j], 0, 0, 0);
    }
#pragma unroll
    for (int i = 0; i < 4; ++i)
#pragma unroll
        for (int j = 0; j < 4; ++j)
#pragma unroll
            for (int r = 0; r < 4; ++r) {
                TC* cp = C + (long)(m0 + 16 * i + 4 * lk + r) * g.ldc + n0 + 16 * j + lr;
                const float v = acc[i][j][r];
                stf(cp, g.mode == 1 ? silu_f(ldf(cp)) * v : v);
            }
}
__global__ __launch_bounds__(256) void k_rope(float* P) {
    const long idx = (long)blockIdx.x * 256 + threadIdx.x;
    if (idx >= (long)ML * 10 * 64) return;
    const int pi = (int)(idx & 63), slot = (int)((idx >> 6) % 10), m = (int)(idx / 640);
    const int t = m % SEQ, half = pi >> 5, i = pi & 31;
    const int base = (slot < 8 ? OFF_Q + slot * HD : OFF_K + (slot - 8) * HD) + half * 64;
    const float pos = half == 0 ? (float)(t / GRIDW) : (float)(t % GRIDW);
    const float inv = powf(10000.f, -(float)i / 32.f);
    const float ang = pos * inv, cs = cosf(ang), sn = sinf(ang);
    float* p = P + (size_t)m * INC + base;
    const float x1 = p[i], x2 = p[32 + i];
    p[i] = x1 * cs - x2 * sn; p[32 + i] = x2 * cs + x1 * sn;
}
__global__ __launch_bounds__(256) void k_pfmt(const float* Pf, bf16* P) {
    const long idx = (long)blockIdx.x * 256 + threadIdx.x; if (idx >= (long)MT * INC) return;
    const int n = (int)(idx % INC); const long m = idx / INC;
    float v;
    if (n < OFF_V) { const int hb = n & ~127; v = Pf[m * INC + hb + qk_orig(n & 127)]; }
    else { v = Pf[idx]; if (n >= OFF_Y && n < OFF_GA) v = gelu_tanh(v); else if (n >= OFF_GA) v = sigm(v); }
    P[idx] = f2bf(v);
}
__global__ __launch_bounds__(256) void k_attn(const bf16* P, const float* sink, bf16* O) {
    __shared__ float ps[4][576];
    __shared__ int prow[4][576];
    const int w = threadIdx.x >> 6, lane = threadIdx.x & 63;
    const int gw = blockIdx.x * 4 + w;
    const int m = gw >> 3, h = gw & 7, kvh = h >> 2;
    const bool lat = m < ML;
    const int b = lat ? m / SEQ : (m - ML) / CTX, t = lat ? m % SEQ : 0;
    const int lo = lat ? (t - WIN < 0 ? 0 : t - WIN) : 0, hi = lat ? (t + WIN > SEQ - 1 ? SEQ - 1 : t + WIN) : -1;
    const int nlat = lat ? hi - lo + 1 : 0, nk = nlat + CTX;
    const bf16* q = P + (size_t)m * INC + OFF_Q + h * HD;
    const float scale = 0.08838834764831845f;
    const float sk = sink[h];
    float sc[9]; float mx = sk;
#pragma unroll
    for (int i = 0; i < 9; ++i) {
        const int j = lane + 64 * i; float s = -INFINITY;
        if (j < nk) {
            const int row = j < nlat ? b * SEQ + lo + j : ML + b * CTX + (j - nlat);
            const bf16* kp = P + (size_t)row * INC + OFF_K + kvh * HD;
            float d = 0.f;
            for (int e = 0; e < 128; ++e) d += bf2f(q[e]) * bf2f(kp[e]);
            s = d * scale; prow[w][j] = row;
        }
        sc[i] = s; mx = fmaxf(mx, s);
    }
    mx = wave_max(mx);
    float sum = 0.f;
#pragma unroll
    for (int i = 0; i < 9; ++i) { const int j = lane + 64 * i; if (j < nk) { const float p = expf(sc[i] - mx); ps[w][j] = p; sum += p; } }
    sum = wave_sum(sum) + expf(sk - mx);
    const float rs = 1.f / sum;
    __syncthreads();
    float o0 = 0.f, o1 = 0.f;
    for (int j = 0; j < nk; ++j) { const float p = ps[w][j]; const bf16* vp = P + (size_t)prow[w][j] * INC + OFF_V + kvh * HD; o0 += p * bf2f(vp[lane]); o1 += p * bf2f(vp[lane + 64]); }
    bf16* op = O + (size_t)m * D + h * HD;
    op[lane] = f2bf(o0 * rs); op[lane + 64] = f2bf(o1 * rs);
}
__global__ __launch_bounds__(256) void k_conv(const bf16* P, const float* cw, const float* cb, float* XC) {
    const long idx = (long)blockIdx.x * 256 + threadIdx.x;
    if (idx >= (long)MT * D) return;
    const int ch = (int)(idx & (D - 1)), m = (int)(idx >> 10);
    const bool lat = m < ML; const int L = lat ? SEQ : CTX, t = lat ? m % SEQ : (m - ML) % CTX;
    float y = 0.f;
#pragma unroll
    for (int j = 0; j < 4; ++j) { const int tt = t + j - 2; if (tt >= 0 && tt < L) y += bf2f(P[(size_t)(m + j - 2) * INC + OFF_X + ch]) * cw[j * D + ch]; }
    XC[idx] = y + cb[ch];
}
__device__ __forceinline__ void scan_seq(const float* XC, const float* RG, const float* IG, float* REC, int mbase, int L, int dir, int ch, float sp, float bav, float bxv, float& h) {
    for (int s0 = 0; s0 < L; s0 += 8) {
        float x[8], r[8], g[8], pr[8];
#pragma unroll
        for (int u = 0; u < 8; ++u) { const int t = dir == 0 ? s0 + u : L - 1 - (s0 + u); const size_t o = (size_t)(mbase + t) * D + ch; x[u] = XC[o]; r[u] = RG[o]; g[u] = IG[o]; pr[u] = dir == 0 ? 0.f : REC[o]; }
#pragma unroll
        for (int u = 0; u < 8; ++u) { const int t = dir == 0 ? s0 + u : L - 1 - (s0 + u); const size_t o = (size_t)(mbase + t) * D + ch;
            const float rr = sigm(r[u] + bav), ig = sigm(g[u] + bxv);
            const float la = -8.f * rr * sp, a = expf(la), bc = sqrtf(-expm1f(2.f * la)) * (ig * x[u]);
            h = a * h + bc; REC[o] = pr[u] + h; }
    }
}
__global__ __launch_bounds__(64) void k_scan(const float* XC, const float* RG, const float* IG, const float* ba, const float* bx, const float* lam, int dir, float* REC) {
    const int idx = blockIdx.x * 64 + threadIdx.x;
    const int b = idx >> 10, ch = idx & (D - 1);
    const float sp = log1pf(expf(-lam[ch])), bav = ba[ch], bxv = bx[ch];
    float h = 0.f;
    scan_seq(XC, RG, IG, REC, ML + b * CTX, CTX, dir, ch, sp, bav, bxv, h);
    scan_seq(XC, RG, IG, REC, b * SEQ, SEQ, dir, ch, sp, bav, bxv, h);
}
__global__ __launch_bounds__(256) void k_recgate(const float* REC, const bf16* P, bf16* RECG) {
    const long idx = (long)blockIdx.x * 256 + threadIdx.x; if (idx >= (long)MT * D) return;
    const int ch = (int)(idx & (D - 1)), m = (int)(idx >> 10);
    RECG[idx] = f2bf(REC[idx] * bf2f(P[(size_t)m * INC + OFF_Y + ch]));
}
__global__ __launch_bounds__(256) void k_merge(const float* T1, const float* T2, const bf16* P, bf16* MM) {
    const long idx = (long)blockIdx.x * 256 + threadIdx.x; if (idx >= (long)MT * D) return;
    const int ch = (int)(idx & (D - 1)), m = (int)(idx >> 10);
    const bf16* p = P + (size_t)m * INC;
    MM[idx] = f2bf(bf2f(p[OFF_GA + ch]) * T1[idx] + bf2f(p[OFF_GR + ch]) * T2[idx]);
}
__global__ __launch_bounds__(256) void k_resid(float* H, const float* Y, const float* MODl, int g_off) {
    const long idx = (long)blockIdx.x * 256 + threadIdx.x; if (idx >= (long)MT * D) return;
    const int n = (int)(idx & (D - 1)), m = (int)(idx >> 10);
    H[idx] += MODl[(size_t)row_vec(m) * 6 * D + g_off + n] * Y[idx];
}
__global__ __launch_bounds__(256) void k_route(const bf16* XN, const float* wr, int* te, float* tw) {
    const int m = (blockIdx.x * 256 + threadIdx.x) >> 6, lane = threadIdx.x & 63;
    if (m >= MT) return;
    float lg[NE];
#pragma unroll
    for (int e = 0; e < NE; ++e) lg[e] = 0.f;
    for (int j = 0; j < 16; ++j) { const int k = lane + 64 * j; const float x = bf2f(XN[(size_t)m * D + k]); const float* w = wr + (size_t)k * NE;
#pragma unroll
        for (int e = 0; e < NE; ++e) lg[e] += x * w[e]; }
#pragma unroll
    for (int e = 0; e < NE; ++e) lg[e] = wave_sum(lg[e]);
    if (lane == 0) {
        int i0 = 0; float v0 = lg[0];
#pragma unroll
        for (int e = 1; e < NE; ++e) if (lg[e] > v0) { v0 = lg[e]; i0 = e; }
        int i1 = -1; float v1 = -INFINITY;
#pragma unroll
        for (int e = 0; e < NE; ++e) if (e != i0 && lg[e] > v1) { v1 = lg[e]; i1 = e; }
        const float e1 = expf(v1 - v0), w0 = 1.f / (1.f + e1), w1 = e1 / (1.f + e1);
        te[2 * m] = i0; te[2 * m + 1] = i1; tw[2 * m] = w0; tw[2 * m + 1] = w1;
    }
}
__global__ __launch_bounds__(1024) void k_moe_lists(const int* te, int* slot_tok, int* tok_slot, int* tile_e) {
    __shared__ int cnt[NE], off[NE + 1], cur[NE];
    const int tid = threadIdx.x;
    if (tid < NE) { cnt[tid] = 0; cur[tid] = 0; }
    for (int i = tid; i < NSLOT; i += 1024) slot_tok[i] = -1;
    __syncthreads();
    for (int i = tid; i < 2 * MT; i += 1024) atomicAdd(&cnt[te[i]], 1);
    __syncthreads();
    if (tid == 0) { int o = 0; for (int e = 0; e < NE; ++e) { off[e] = o; o += (cnt[e] + 255) / 256 * 256; } off[NE] = o; }
    __syncthreads();
    for (int i = tid; i < NSLOT / 128; i += 1024) { int e = -1; for (int x = 0; x < NE; ++x) if (i * 128 >= off[x] && i * 128 < off[x + 1]) e = x; tile_e[i] = e; }
    for (int i = tid; i < 2 * MT; i += 1024) { const int e = te[i]; const int pos = atomicAdd(&cur[e], 1); const int s = off[e] + pos; slot_tok[s] = i >> 1; tok_slot[i] = s; }
}
__global__ __launch_bounds__(256) void k_moe_combine(float* H, const bf16* FS, const int* tok_slot, const float* tw, const float* MODl, int g_off) {
    const long idx = (long)blockIdx.x * 256 + threadIdx.x; if (idx >= (long)MT * D) return;
    const int n = (int)(idx & (D - 1)), m = (int)(idx >> 10);
    const float f = tw[2 * m] * bf2f(FS[(size_t)tok_slot[2 * m] * D + n]) + tw[2 * m + 1] * bf2f(FS[(size_t)tok_slot[2 * m + 1] * D + n]);
    H[idx] += MODl[(size_t)row_vec(m) * 6 * D + g_off + n] * f;
}
__global__ __launch_bounds__(256) void k_final(const float* H, const float* g, float* out) {
    const int m = (blockIdx.x * 256 + threadIdx.x) >> 6, lane = threadIdx.x & 63;
    if (m >= ML) return;
    const float* h = H + (size_t)m * D;
    float v[16]; float ss = 0.f;
#pragma unroll
    for (int j = 0; j < 16; ++j) { v[j] = h[lane + 64 * j]; ss += v[j] * v[j]; }
    ss = wave_sum(ss);
    const float r = rsqrtf(ss * (1.f / D) + EPS);
#pragma unroll
    for (int j = 0; j < 16; ++j) { const int n = lane + 64 * j; out[(size_t)m * D + n] = v[j] * r * g[n]; }
}
}

template <class TA, class TC>
static void ngemm(hipStream_t st, const TA* A, int lda, const int* arow, const float* B, int ldb, TC* C, int ldc, int M, int N, int K,
                  int nz = 1, long sA = 0, long sB = 0, long sC = 0, const int* tile_e = nullptr, long sBe = 0, int mode = 0) {
    nv::NGemm<TA, TC> g{}; g.A = A; g.lda = lda; g.arow = arow; g.B = B; g.ldb = ldb; g.C = C; g.ldc = ldc; g.K = K; g.sA = sA; g.sB = sB; g.sC = sC; g.tile_e = tile_e; g.sBe = sBe; g.mode = mode;
    hipLaunchKernelGGL((nv::k_gemm<TA, TC>), dim3(N / 128, M / 128, nz), dim3(256), 0, st, g);
}

#ifndef PG8_WGM
#define PG8_WGM 4
#endif
namespace pg8 {
#define PG8_LAS __attribute__((address_space(3)))
typedef unsigned short bf16_t;
typedef short bf16x8 __attribute__((ext_vector_type(8)));
typedef float f32x4 __attribute__((ext_vector_type(4)));
typedef unsigned u32x4 __attribute__((ext_vector_type(4)));
constexpr int BM = 256, BK = 64, HALF = 128, HTB = HALF * BK * 2  , STAGE_BYTES = 8 * HTB, NXCD = 8, WGM = PG8_WGM;

__host__ __device__ __forceinline__ int lds_byte(int r, int c) { const int st = (r >> 4) * 2 + (c >> 5), rr = r & 15, cc = c & 31, ob = rr * 64 + cc * 2; return st * 1024 + (ob ^ (((ob >> 9) & 1) << 5)); }
__host__ __device__ __forceinline__ void stage_rc(int b, int& R, int& C) { const int st = b / 1024, sb = b % 1024, swz = sb ^ (((sb >> 9) & 1) << 5); R = (st >> 1) * 16 + swz / 64; C = (st & 1) * 32 + (swz % 64) / 2; }
__host__ __device__ __forceinline__ int perm32(int rho) { const int n = rho >> 4, i = rho & 15; return 8 * (i >> 2) + 4 * n + (i & 3); }

struct Unit { int pm, pn; };
struct Gemm { const bf16_t* A; const bf16_t* Bt; int M, N, K; };

struct StaticOrder {
    static constexpr bool GATHER = false;
    int nM, nN, nwg, G, c, rev, wgm;
    __host__ __device__ void init(int M, int N, int G_, int c_, int rev_ = 0) { nM = M / BM; nN = N / BM; nwg = nM * nN; G = G_; c = c_; rev = rev_; wgm = WGM; }
    __host__ __device__ bool next(int i, Unit& u) const {
        const long L = (long)i * G + c; if (L >= nwg) return false;
        int wgid = (int)L; { const int q = nwg / NXCD, r = nwg % NXCD, xcd = wgid % NXCD; int off = wgid / NXCD; if (rev & 2) off = (xcd < r ? q + 1 : q) - 1 - off;
            wgid = (xcd < r ? xcd * (q + 1) : r * (q + 1) + (xcd - r) * q) + off; }
        const int nig = wgm * nN, gid = wgid / nig, fm = gid * wgm, gsz = (nM - fm) < wgm ? (nM - fm) : wgm;
        u.pm = fm + ((wgid % nig) % gsz); u.pn = (wgid % nig) / gsz; if (rev & 1) u.pn = nN - 1 - u.pn; return true;
    }
    __device__ __forceinline__ void a_ready(const Unit&) const {}
    __device__ __forceinline__ size_t boff(const Unit&) const { return 0; }
    __device__ __forceinline__ void done(const Unit&) const {}
};


struct ExpertOrder : StaticOrder {
    const int* panel_e; size_t estride;
    unsigned* pub; const unsigned* ready; unsigned need; unsigned* tmo;
    __device__ __forceinline__ size_t boff(const Unit& u) const { return (size_t)__builtin_amdgcn_readfirstlane(panel_e[u.pm]) * estride; }
    mutable int pend;
    __device__ __forceinline__ void done(const Unit& u) const {
        if (pub) { if (pend >= 0 && (threadIdx.x & 63) == 0) __hip_atomic_fetch_add(pub + 64 * pend, 1u, __ATOMIC_RELAXED, __HIP_MEMORY_SCOPE_AGENT); pend = u.pm; }
    }
    __device__ __forceinline__ void flush() const {
        if (pub && pend >= 0) { asm volatile("s_waitcnt vmcnt(0)" ::: "memory"); if ((threadIdx.x & 63) == 0) __hip_atomic_fetch_add(pub + 64 * pend, 1u, __ATOMIC_RELAXED, __HIP_MEMORY_SCOPE_AGENT); pend = -1; }
    }
    __device__ __forceinline__ void a_ready(const Unit& u) const {
        if (!ready) return;
        if (threadIdx.x < 64) {
            const unsigned long long t0 = __builtin_amdgcn_s_memrealtime(); unsigned polls = 0;
            while ((unsigned)__builtin_amdgcn_readfirstlane(__hip_atomic_load(ready + 64 * u.pm, __ATOMIC_RELAXED, __HIP_MEMORY_SCOPE_AGENT)) < need) {
                if ((++polls & 255u) == 0u && __builtin_amdgcn_readfirstlane(__hip_atomic_load(tmo, __ATOMIC_RELAXED, __HIP_MEMORY_SCOPE_AGENT)) != 0u) break;
                if (__builtin_amdgcn_s_memrealtime() - t0 > 2000000ull) { if (threadIdx.x == 0) __hip_atomic_store(tmo, 1u, __ATOMIC_RELAXED, __HIP_MEMORY_SCOPE_AGENT); break; }
                __builtin_amdgcn_s_sleep(2); }
            __builtin_amdgcn_fence(__ATOMIC_ACQUIRE, "agent");
            asm volatile("s_waitcnt vmcnt(0)" ::: "memory");
        }
        asm volatile("" ::: "memory"); __builtin_amdgcn_s_barrier(); asm volatile("" ::: "memory");
    }
};
struct GatherOrder : ExpertOrder { static constexpr bool GATHER = true; const int* arow; };
struct EpiInProj {
    static constexpr bool PERM = true, AFTER_DRAIN = false;
    bf16* P; const f32x4* rope;
    __device__ __forceinline__ void operator()(const f32x4 (&acc)[2][2][4][2], const Unit& u, int wr, int wc, int fr, int fq) const {
        const int pn = u.pn;
        const int kind = pn < 5 ? 0 : (pn < 10 ? 1 : (pn < 14 ? 2 : 3));
        const bool rope_on = kind == 0 && u.pm < 64;
        const int row0 = u.pm * BM + wr * 64 + fr, col0 = pn * BM + wc * 32 + 8 * fq;
#pragma unroll
        for (int ai = 0; ai < 2; ++ai)
#pragma unroll
            for (int m = 0; m < 4; ++m) {
                const int row = row0 + ai * HALF + m * 16;
                bf16* rowp = P + (size_t)row * INC + col0;
                f32x4 cs0 = {1.f, 0.f, 1.f, 0.f}, cs1 = {1.f, 0.f, 1.f, 0.f};
                if (rope_on) { const int t = row & (SEQ - 1); const int pos = (wc >> 1) ? (t & 63) : (t >> 6); const f32x4* rp = rope + pos * 16 + 8 * (wc & 1) + 2 * fq; cs0 = rp[0]; cs1 = rp[1]; }
#pragma unroll
                for (int bj = 0; bj < 2; ++bj) {
                    f32x4 v0 = acc[ai][bj][m][0], v1 = acc[ai][bj][m][1];
                    if (kind == 0) {
                        const f32x4 a = v0, b = v1;
                        v0[0] = a[0] * cs0[0] - a[1] * cs0[1]; v0[1] = a[1] * cs0[0] + a[0] * cs0[1];
                        v0[2] = a[2] * cs0[2] - a[3] * cs0[3]; v0[3] = a[3] * cs0[2] + a[2] * cs0[3];
                        v1[0] = b[0] * cs1[0] - b[1] * cs1[1]; v1[1] = b[1] * cs1[0] + b[0] * cs1[1];
                        v1[2] = b[2] * cs1[2] - b[3] * cs1[3]; v1[3] = b[3] * cs1[2] + b[2] * cs1[3];
                    } else if (kind == 2) {
#pragma unroll
                        for (int j = 0; j < 4; ++j) { v0[j] = fgelu(v0[j]); v1[j] = fgelu(v1[j]); }
                    } else if (kind == 3) {
#pragma unroll
                        for (int j = 0; j < 4; ++j) { v0[j] = fsigm(v0[j]); v1[j] = fsigm(v1[j]); }
                    }
                    u32x4 w; w.x = pk2(v0[0], v0[1]); w.y = pk2(v0[2], v0[3]); w.z = pk2(v1[0], v1[1]); w.w = pk2(v1[2], v1[3]);
                    st16w(rowp + bj * HALF, w);
                }
            }
    }
};
struct EpiMerge {
    static constexpr bool PERM = true, AFTER_DRAIN = false;
    const bf16* P; bf16* T1; bf16* MM; int mode; int goff;
    __device__ __forceinline__ void operator()(const f32x4 (&acc)[2][2][4][2], const Unit& u, int wr, int wc, int fr, int fq) const {
        const int row0 = u.pm * BM + wr * 64 + fr, col0 = u.pn * BM + wc * 32 + 8 * fq;
#pragma unroll
        for (int ai = 0; ai < 2; ++ai)
#pragma unroll
            for (int m = 0; m < 4; ++m) {
                const size_t row = (size_t)(row0 + ai * HALF + m * 16);
#pragma unroll
                for (int bj = 0; bj < 2; ++bj) {
                    const int col = col0 + bj * HALF;
                    const u32x4 g = *(const u32x4*)(P + row * INC + goff + col);
                    const f32x4 a0 = acc[ai][bj][m][0], a1 = acc[ai][bj][m][1];
                    float o[8] = {bflo(g.x) * a0[0], bfhi(g.x) * a0[1], bflo(g.y) * a0[2], bfhi(g.y) * a0[3], bflo(g.z) * a1[0], bfhi(g.z) * a1[1], bflo(g.w) * a1[2], bfhi(g.w) * a1[3]};
                    if (mode) { const u32x4 t = *(const u32x4*)(T1 + row * D + col);
                        o[0] += bflo(t.x); o[1] += bfhi(t.x); o[2] += bflo(t.y); o[3] += bfhi(t.y); o[4] += bflo(t.z); o[5] += bfhi(t.z); o[6] += bflo(t.w); o[7] += bfhi(t.w); }
                    u32x4 w; w.x = pk2(o[0], o[1]); w.y = pk2(o[2], o[3]); w.z = pk2(o[4], o[5]); w.w = pk2(o[6], o[7]);
                    if (mode) st16w(MM + row * D + col, w); else *(u32x4*)(T1 + row * D + col) = w;
                }
            }
    }
};
struct EpiResid {
    static constexpr bool PERM = true, AFTER_DRAIN = false;
    bf16* H; const float* gate; const bf16* base; const float* base32;
    __device__ __forceinline__ void operator()(const f32x4 (&acc)[2][2][4][2], const Unit& u, int wr, int wc, int fr, int fq) const {
        const int row0 = u.pm * BM + wr * 64 + fr, col0 = u.pn * BM + wc * 32 + 8 * fq;
        const float* gv = gate + (size_t)(u.pm < 32 ? 0 : (u.pm < 64 ? 1 : 2)) * 6 * D;
        f32x4 g4[2][2];
#pragma unroll
        for (int bj = 0; bj < 2; ++bj)
#pragma unroll
            for (int n = 0; n < 2; ++n) g4[bj][n] = *(const f32x4*)(gv + col0 + bj * HALF + 4 * n);
#pragma unroll
        for (int ai = 0; ai < 2; ++ai)
#pragma unroll
            for (int m = 0; m < 4; ++m) { const size_t ro = (size_t)(row0 + ai * HALF + m * 16) * D + col0;
#pragma unroll
                for (int bj = 0; bj < 2; ++bj) { const size_t off = ro + bj * HALF;
                    f32x4 b0, b1;
                    if (base32) { b0 = *(const f32x4*)(base32 + off); b1 = *(const f32x4*)(base32 + off + 4); }
                    else { const u32x4 hb = *(const u32x4*)(base + off); b0 = (f32x4){bflo(hb.x), bfhi(hb.x), bflo(hb.y), bfhi(hb.y)}; b1 = (f32x4){bflo(hb.z), bfhi(hb.z), bflo(hb.w), bfhi(hb.w)}; }
                    const f32x4 o0 = b0 + g4[bj][0] * acc[ai][bj][m][0], o1 = b1 + g4[bj][1] * acc[ai][bj][m][1];
                    u32x4 w; w.x = pk2(o0[0], o0[1]); w.y = pk2(o0[2], o0[3]); w.z = pk2(o1[0], o1[1]); w.w = pk2(o1[2], o1[3]);
                    st16w(H + off, w); } }
    }
};
struct EpiSwiGLU {
    static constexpr bool PERM = true, AFTER_DRAIN = false;
    bf16* HID; int ldh; int wt;
    __device__ __forceinline__ void operator()(const f32x4 (&acc)[2][2][4][2], const Unit& u, int wr, int wc, int fr, int fq) const {
        const int row0 = u.pm * BM + wr * 64 + fr, col0 = u.pn * HALF + wc * 32 + 8 * fq;
#pragma unroll
        for (int ai = 0; ai < 2; ++ai)
#pragma unroll
            for (int m = 0; m < 4; ++m) {
                const f32x4 g0 = acc[ai][0][m][0], g1 = acc[ai][0][m][1], u0 = acc[ai][1][m][0], u1 = acc[ai][1][m][1];
                u32x4 w; w.x = pk2(fsilu(g0[0]) * u0[0], fsilu(g0[1]) * u0[1]); w.y = pk2(fsilu(g0[2]) * u0[2], fsilu(g0[3]) * u0[3]);
                w.z = pk2(fsilu(g1[0]) * u1[0], fsilu(g1[1]) * u1[1]); w.w = pk2(fsilu(g1[2]) * u1[2], fsilu(g1[3]) * u1[3]);
                bf16* dst = HID + (size_t)(row0 + ai * HALF + m * 16) * ldh + col0;
                if (wt) asm volatile("global_store_dwordx4 %0, %1, off sc1\n\ts_nop 1" :: "v"(dst), "v"(w) : "memory");
                else st16w(dst, w);
            }
    }
};
struct EpiPlain {
    static constexpr bool PERM = true, AFTER_DRAIN = false;
    bf16* O; int ldc;
    __device__ __forceinline__ void operator()(const f32x4 (&acc)[2][2][4][2], const Unit& u, int wr, int wc, int fr, int fq) const {
        const int row0 = u.pm * BM + wr * 64 + fr, col0 = u.pn * BM + wc * 32 + 8 * fq;
#pragma unroll
        for (int ai = 0; ai < 2; ++ai)
#pragma unroll
            for (int m = 0; m < 4; ++m) { bf16* rowp = O + (size_t)(row0 + ai * HALF + m * 16) * ldc + col0;
#pragma unroll
                for (int bj = 0; bj < 2; ++bj) { const f32x4 v0 = acc[ai][bj][m][0], v1 = acc[ai][bj][m][1];
                    u32x4 w; w.x = pk2(v0[0], v0[1]); w.y = pk2(v0[2], v0[3]); w.z = pk2(v1[0], v1[1]); w.w = pk2(v1[2], v1[3]);
                    st16w(rowp + bj * HALF, w); } }
    }
};
#ifndef PG8_B_AUX
#define PG8_B_AUX 0
#endif
#ifndef PG8_A_AUX
#define PG8_A_AUX 0
#endif
template <class Epi, class Sched, bool ALIGN_EPI = false, bool SP2 = false>
__device__ __forceinline__ void gemm_phase(PG8_LAS unsigned char* lds, const Gemm g, const Sched& S, const Epi& E) {
    int tid_ = threadIdx.x; asm volatile("" : "+v"(tid_));
    const int tid = tid_, wid = __builtin_amdgcn_readfirstlane(tid >> 6), lane = tid & 63, wr = wid >> 2, wc = wid & 3, fr = lane & 15, fq = lane >> 4;
    const int K = g.K, nt = K / BK;
    unsigned voffA[2], voffB[2];
#pragma unroll
    for (int i = 0; i < 2; ++i) { int R, C; stage_rc(tid * 16 + i * 8192, R, C); const int Rb = Epi::PERM ? ((R & ~31) + perm32(R & 31)) : R;
        voffA[i] = (unsigned)(R * K + C) * 2u; voffB[i] = (unsigned)(Rb * K + C) * 2u; }
    unsigned vAc[2][2] = {{0u, 0u}, {0u, 0u}}, vAn[2][2] = {{0u, 0u}, {0u, 0u}};
#define PG8_SETA(v, u) do { if constexpr (Sched::GATHER) { _Pragma("unroll") for (int h_ = 0; h_ < 2; ++h_) _Pragma("unroll") for (int i_ = 0; i_ < 2; ++i_) { \
        int R_, C_; stage_rc(tid * 16 + i_ * 8192, R_, C_); int tok_ = S.arow[(u).pm * BM + h_ * HALF + R_]; tok_ = tok_ < 0 ? 0 : tok_; (v)[h_][i_] = (unsigned)(tok_ * K + C_) * 2u; } } } while (0)
#define PG8_STAGE_A(bufoff, h, ptr, nsel) do { if constexpr (Sched::GATHER) { if (nsel) PG8_STAGE_X(bufoff, ptr, vAn[h], PG8_A_AUX); else PG8_STAGE_X(bufoff, ptr, vAc[h], PG8_A_AUX); } \
        else PG8_STAGE_X(bufoff, (ptr) + (h) * hstep, voffA, PG8_A_AUX); } while (0)
    const size_t kstep = (size_t)(BK * 2);
    const size_t hstep = (size_t)HALF * K * 2;
    const size_t tstep = 2 * hstep;
    const unsigned ldsw = (unsigned)wid * 1024u;
    const int aoff = lds_byte(wr * 64 + fr, fq * 8), boff = lds_byte(wc * 32 + fr, fq * 8);
#define PG8_SA(b, h) (((b) * 2 + (h)) * HTB)
#define PG8_SB(b, h) ((4 + (b) * 2 + (h)) * HTB)
#define PG8_STAGE_X(bufoff, gbase, voff, aux) do { _Pragma("unroll") for (int _i = 0; _i < 2; ++_i) \
        __builtin_amdgcn_global_load_lds((const unsigned*)((const char*)(gbase) + (voff)[_i]), (PG8_LAS unsigned*)(lds + (bufoff) + ldsw + _i * 8192), 16, 0, aux); } while (0)
#define PG8_STAGE(bufoff, gbase, voff) PG8_STAGE_X(bufoff, gbase, voff, PG8_B_AUX)
#define PG8_LDA(dst, b, h) do { _Pragma("unroll") for (int m = 0; m < 4; ++m) _Pragma("unroll") for (int k = 0; k < 2; ++k) dst[m][k] = *(const PG8_LAS bf16x8*)(lds + PG8_SA(b, h) + aoff + m * 2048 + k * 1024); } while (0)
#define PG8_LDB(dst, b, h) do { _Pragma("unroll") for (int n = 0; n < 2; ++n) _Pragma("unroll") for (int k = 0; k < 2; ++k) dst[n][k] = *(const PG8_LAS bf16x8*)(lds + PG8_SB(b, h) + boff + n * 2048 + k * 1024); } while (0)
#define PG8_MMA(ai, bj, At, Bt) do { __builtin_amdgcn_s_setprio(1); _Pragma("unroll") for (int m = 0; m < 4; ++m) _Pragma("unroll") for (int n = 0; n < 2; ++n) _Pragma("unroll") for (int k = 0; k < 2; ++k) \
        acc[ai][bj][m][n] = __builtin_amdgcn_mfma_f32_16x16x32_bf16(Bt[n][k], At[m][k], acc[ai][bj][m][n], 0, 0, 0); __builtin_amdgcn_s_setprio(0); } while (0)
#define PG8_WAIT_V(n) asm volatile("s_waitcnt vmcnt(" #n ")" ::: "memory")
#define PG8_WAIT_L(n) asm volatile("s_waitcnt lgkmcnt(" #n ")" ::: "memory")
#define PG8_BAR __builtin_amdgcn_s_barrier()
#define PG8_SCHED __builtin_amdgcn_sched_barrier(0)
    Unit cur, nxt; int ui = 0;
    if (!S.next(0, cur)) return;
    f32x4 acc[2][2][4][2];
#pragma unroll
    for (int a = 0; a < 2; ++a)
#pragma unroll
        for (int b = 0; b < 2; ++b)
#pragma unroll
            for (int m = 0; m < 4; ++m)
#pragma unroll
                for (int n = 0; n < 2; ++n) acc[a][b][m][n] = (f32x4){0.f, 0.f, 0.f, 0.f};
    bf16x8 At[4][2], B0[2][2], B1[2][2];
    const char* cA = Sched::GATHER ? (const char*)g.A : (const char*)g.A + (size_t)cur.pm * tstep; PG8_SETA(vAc, cur); const char* cB = (const char*)g.Bt + S.boff(cur) + (size_t)cur.pn * tstep;
    S.a_ready(cur);
    if constexpr (SP2) {
        PG8_STAGE(PG8_SB(0, 0), cB, voffB); PG8_STAGE(PG8_SB(0, 1), cB + hstep, voffB); PG8_STAGE_A(PG8_SA(0, 0), 0, cA, false); PG8_STAGE_A(PG8_SA(0, 1), 1, cA, false);
        if (wr == 1) PG8_BAR;
        PG8_WAIT_V(2); PG8_BAR;
        PG8_STAGE(PG8_SB(1, 0), cB + kstep, voffB); PG8_STAGE_A(PG8_SA(1, 0), 0, cA + kstep, false); PG8_STAGE(PG8_SB(1, 1), cB + hstep + kstep, voffB);
        PG8_WAIT_V(6); PG8_BAR;
    } else {
        PG8_STAGE(PG8_SB(0, 0), cB, voffB); PG8_STAGE_A(PG8_SA(0, 0), 0, cA, false); PG8_STAGE(PG8_SB(0, 1), cB + hstep, voffB); PG8_STAGE_A(PG8_SA(0, 1), 1, cA, false);
        if (wr == 1) PG8_BAR;
        PG8_WAIT_V(4); PG8_BAR;
        PG8_STAGE(PG8_SB(1, 0), cB + kstep, voffB); PG8_STAGE_A(PG8_SA(1, 0), 0, cA + kstep, false); PG8_STAGE(PG8_SB(1, 1), cB + hstep + kstep, voffB);
        PG8_WAIT_V(6); PG8_BAR;
    }
    for (;;) {
        const bool has_next = S.next(ui + 1, nxt);
        const char* nA = Sched::GATHER ? (const char*)g.A : (has_next ? (const char*)g.A + (size_t)nxt.pm * tstep : cA);
        if constexpr (Sched::GATHER) { if (has_next) PG8_SETA(vAn, nxt); else { _Pragma("unroll") for (int h_ = 0; h_ < 2; ++h_) { vAn[h_][0] = vAc[h_][0]; vAn[h_][1] = vAc[h_][1]; } }
            *(PG8_LAS u32x4*)(lds + STAGE_BYTES + tid * 16) = (u32x4){vAn[0][0], vAn[0][1], vAn[1][0], vAn[1][1]}; }     const char* nB = has_next ? (const char*)g.Bt + S.boff(nxt) + (size_t)nxt.pn * tstep : cB;
        for (int t = 0; t < nt; t += 2) {
            const bool last = (t == nt - 2);
            const char* a1 = cA + (size_t)(t + 1) * kstep;
            const char* a2 = last ? nA : cA + (size_t)(t + 2) * kstep; const char* b2 = last ? nB : cB + (size_t)(t + 2) * kstep;
            const char* a3 = a2 + kstep; const char* b3 = b2 + kstep;
            if (last && has_next) S.a_ready(nxt);
            if constexpr (Sched::GATHER) { if (last) { const u32x4 pv_ = *(const PG8_LAS u32x4*)(lds + STAGE_BYTES + tid * 16); vAn[0][0] = pv_.x; vAn[0][1] = pv_.y; vAn[1][0] = pv_.z; vAn[1][1] = pv_.w; } }
            if constexpr (SP2) {
            PG8_LDB(B0, 0, 0); PG8_LDB(B1, 0, 1); PG8_SCHED; PG8_LDA(At, 0, 0); PG8_STAGE_A(PG8_SA(1, 1), 1, a1, false);
            PG8_WAIT_V(8); PG8_WAIT_L(0); PG8_BAR; PG8_MMA(0, 0, At, B0); PG8_MMA(0, 1, At, B1); PG8_BAR; PG8_SCHED;
            PG8_LDA(At, 0, 1); PG8_STAGE(PG8_SB(0, 0), b2, voffB); PG8_STAGE(PG8_SB(0, 1), b2 + hstep, voffB); PG8_STAGE_A(PG8_SA(0, 0), 0, a2, last);
            PG8_WAIT_V(8); PG8_WAIT_L(0); PG8_BAR; PG8_MMA(1, 0, At, B0); PG8_MMA(1, 1, At, B1); PG8_BAR; PG8_SCHED;
            PG8_LDB(B0, 1, 0); PG8_LDB(B1, 1, 1); PG8_SCHED; PG8_LDA(At, 1, 0); PG8_STAGE_A(PG8_SA(0, 1), 1, a2, last);
            PG8_WAIT_V(8); PG8_WAIT_L(0); PG8_BAR; PG8_MMA(0, 0, At, B0); PG8_MMA(0, 1, At, B1); PG8_BAR; PG8_SCHED;
            PG8_LDA(At, 1, 1); PG8_STAGE(PG8_SB(1, 0), b3, voffB); PG8_STAGE(PG8_SB(1, 1), b3 + hstep, voffB); PG8_STAGE_A(PG8_SA(1, 0), 0, a3, last);
            PG8_WAIT_V(8); PG8_WAIT_L(0); PG8_BAR; PG8_MMA(1, 0, At, B0); PG8_MMA(1, 1, At, B1); PG8_BAR; PG8_SCHED;
            } else {
            PG8_LDB(B0, 0, 0); PG8_SCHED; PG8_LDA(At, 0, 0); PG8_STAGE_A(PG8_SA(1, 1), 1, a1, false);
            PG8_WAIT_L(8); PG8_BAR; PG8_WAIT_L(0); PG8_MMA(0, 0, At, B0); PG8_BAR; PG8_SCHED;
            PG8_LDB(B1, 0, 1); PG8_STAGE(PG8_SB(0, 0), b2, voffB);
            PG8_BAR; PG8_WAIT_L(0); PG8_MMA(0, 1, At, B1); PG8_BAR;
            PG8_LDA(At, 0, 1); PG8_STAGE_A(PG8_SA(0, 0), 0, a2, last);
            PG8_BAR; PG8_WAIT_L(0); PG8_MMA(1, 0, At, B0); PG8_BAR; PG8_SCHED;
            PG8_STAGE(PG8_SB(0, 1), b2 + hstep, voffB);
            PG8_WAIT_V(6); PG8_BAR; PG8_MMA(1, 1, At, B1); PG8_BAR;
            PG8_LDB(B0, 1, 0); PG8_SCHED; PG8_LDA(At, 1, 0); PG8_STAGE_A(PG8_SA(0, 1), 1, a2, last);
            PG8_WAIT_L(8); PG8_BAR; PG8_WAIT_L(0); PG8_MMA(0, 0, At, B0); PG8_BAR; PG8_SCHED;
            PG8_LDB(B1, 1, 1); PG8_STAGE(PG8_SB(1, 0), b3, voffB);
            PG8_BAR; PG8_WAIT_L(0); PG8_MMA(0, 1, At, B1); PG8_BAR;
            PG8_LDA(At, 1, 1); PG8_STAGE_A(PG8_SA(1, 0), 0, a3, last);
            PG8_BAR; PG8_WAIT_L(0); PG8_MMA(1, 0, At, B0); PG8_BAR; PG8_SCHED;
            PG8_STAGE(PG8_SB(1, 1), b3 + hstep, voffB);
            PG8_WAIT_V(6); PG8_BAR; PG8_MMA(1, 1, At, B1); PG8_BAR;
            }
        }
        if constexpr (ALIGN_EPI) { if (wr == 0) PG8_BAR; }
        if constexpr (!Epi::AFTER_DRAIN) { E(acc, cur, wr, wc, fr, fq); S.done(cur); }
        if (!has_next) break;
#pragma unroll
        for (int a = 0; a < 2; ++a)
#pragma unroll
            for (int b = 0; b < 2; ++b)
#pragma unroll
                for (int m = 0; m < 4; ++m)
#pragma unroll
                    for (int n = 0; n < 2; ++n) acc[a][b][m][n] = (f32x4){0.f, 0.f, 0.f, 0.f};
        cur = nxt; cA = nA; cB = nB; ++ui;
        if constexpr (Sched::GATHER) { const u32x4 pv_ = *(const PG8_LAS u32x4*)(lds + STAGE_BYTES + tid * 16); vAc[0][0] = pv_.x; vAc[0][1] = pv_.y; vAc[1][0] = pv_.z; vAc[1][1] = pv_.w; }
        if constexpr (ALIGN_EPI) { if (wr == 1) PG8_BAR; }
    }
    PG8_WAIT_V(0);
    if constexpr (!ALIGN_EPI) { if (wr == 0) PG8_BAR; }
    PG8_BAR;
    if constexpr (Epi::AFTER_DRAIN) { E.fused(acc, cur, wr, wc, fr, fq, lds, wid, lane); S.done(cur); }
#undef PG8_SA
#undef PG8_SB
#undef PG8_STAGE
#undef PG8_STAGE_A
#undef PG8_SETA
#undef PG8_LDA
#undef PG8_LDB
#undef PG8_MMA
#undef PG8_WAIT_V
#undef PG8_WAIT_L
#undef PG8_BAR
#undef PG8_SCHED
}

}

constexpr int NWAVES = 8;
constexpr int RING_OFF = 0;
constexpr int TR_WAVE_BYTES = 64 * 65 * 4;
constexpr int SVEC_OFF = NWAVES * TR_WAVE_BYTES;
constexpr int LDSCTL_OFF = 147456 - 512, LDS_BYTES = 147456;
static_assert(SVEC_OFF + 3 * D * 4 <= LDSCTL_OFF, "LDS map");

#define RLX_AGENT __ATOMIC_RELAXED, __HIP_MEMORY_SCOPE_AGENT
#define XB_TMO      128
#define XB_XCNT(j)  (256  + 64 * (j))
#define XB_XSUB(j)  (1280 + 64 * (j))
#define XB_XGEN(j)  (2304 + 64 * (j))
#define XB_TOP      3328
#define XB_TOPGEN   3392
#define XCD_BAR_WORDS 3456
#define XB_SPIN_CAP (1u << 18)
#ifndef XB_EARLYWB
#define XB_EARLYWB 0
#endif

__device__ __forceinline__ unsigned xb_ld(unsigned* p)              { return __hip_atomic_load(p, __ATOMIC_RELAXED, __HIP_MEMORY_SCOPE_AGENT); }
__device__ __forceinline__ unsigned xb_add(unsigned* p, unsigned v) {
    unsigned one; asm volatile("v_mov_b32 %0, 1" : "=v"(one)); (void)v;
    return __hip_atomic_fetch_add(p, one, __ATOMIC_RELAXED, __HIP_MEMORY_SCOPE_AGENT); }
__device__ __forceinline__ unsigned xb_xcc_id() { return (unsigned)__builtin_amdgcn_s_getreg((3 << 11) | 20) & 0xFu; }
#define XB_SPIN(cond, bar) do { unsigned _sp = 0; while (cond) { __builtin_amdgcn_s_sleep(1); \
    if ((++_sp & 255u) == 0u) { if (xb_ld(&(bar)[XB_TMO])) break; if (_sp > XB_SPIN_CAP) { (void)xb_add(&(bar)[XB_TMO], 1u); break; } } } } while (0)

struct XcdBarrier {
    unsigned* bar; unsigned x;
    volatile LAS unsigned* st;
};

__device__ __forceinline__ XcdBarrier xcd_barrier_post(unsigned* bar, volatile LAS unsigned* st) {
    XcdBarrier b; b.bar = bar; b.x = xb_xcc_id(); b.st = st;
    if (threadIdx.x == 0) (void)xb_add(&bar[XB_XCNT(b.x)], 1u);
    return b;
}
__device__ __forceinline__ void xcd_barrier_complete(unsigned* bar, unsigned x, unsigned& nloc, unsigned& nx) {
    const unsigned G = gridDim.x * gridDim.y * gridDim.z;
    unsigned sum, cnt, mine, sp = 0u;
    for (;;) {
        sum = 0u; cnt = 0u; mine = 0u;
#pragma unroll
        for (unsigned j = 0; j < 16; ++j) { const unsigned c = xb_ld(&bar[XB_XCNT(j)]); sum += c; cnt += (c > 0u) ? 1u : 0u; mine = (j == x) ? c : mine; }
        if (sum == G) break;
        __builtin_amdgcn_s_sleep(1);
        if ((++sp & 255u) == 0u) { if (xb_ld(&bar[XB_TMO])) break; if (sp > XB_SPIN_CAP) { (void)xb_add(&bar[XB_TMO], 1u); break; } }
    }
    nloc = mine > 0u ? mine : 1u; nx = cnt > 0u ? cnt : 1u;
}

__device__ __forceinline__ void xcd_barrier(const XcdBarrier& b) {
    asm volatile("s_waitcnt vmcnt(0)" ::: "memory");
    __syncthreads();
    if (threadIdx.x == 0) {
        unsigned* bar = b.bar;
        __builtin_amdgcn_s_waitcnt(0);
        unsigned nloc = b.st[0], nx = b.st[1];
        if (nloc == 0u) { xcd_barrier_complete(bar, b.x, nloc, nx); b.st[0] = nloc; b.st[1] = nx; }
#if XB_EARLYWB
        __builtin_amdgcn_fence(__ATOMIC_RELEASE, "agent");
        asm volatile("s_waitcnt vmcnt(0)" ::: "memory");
#endif
        const unsigned old = xb_add(&bar[XB_XSUB(b.x)], 1u);
        const unsigned gen = old / nloc;
        if (old + 1u == (gen + 1u) * nloc) {
            __builtin_amdgcn_fence(__ATOMIC_RELEASE, "agent");
            asm volatile("s_waitcnt vmcnt(0)" ::: "memory");
            const unsigned og = xb_add(&bar[XB_TOP], 1u);
            const unsigned tg = og / nx;
            if (og + 1u == (tg + 1u) * nx) xb_add(&bar[XB_TOPGEN], 1u);
            else XB_SPIN(xb_ld(&bar[XB_TOPGEN]) == tg, bar);
            __builtin_amdgcn_fence(__ATOMIC_ACQUIRE, "agent");
            xb_add(&bar[XB_XGEN(b.x)], 1u);
            asm volatile("s_waitcnt vmcnt(0)" ::: "memory");
        } else {
            XB_SPIN(xb_ld(&bar[XB_XGEN(b.x)]) == gen, bar);
            __builtin_amdgcn_fence(__ATOMIC_ACQUIRE, "agent");
            asm volatile("s_waitcnt vmcnt(0)" ::: "memory");
        }
    }
    __syncthreads();
}


__device__ __forceinline__ float bperm(float v, int src) { return __builtin_bit_cast(float, __builtin_amdgcn_ds_bpermute(src << 2, __builtin_bit_cast(int, v))); }
__device__ __forceinline__ int bpermi(int v, int src) { return __builtin_amdgcn_ds_bpermute(src << 2, v); }
__device__ __forceinline__ float wsum(float v, int lane) {
#pragma unroll
    for (int o = 1; o < 64; o <<= 1) v += bperm(v, lane ^ o);
    return v;
}
struct Args { const float* in[28]; float* out; unsigned char* ws; int ph_lo, ph_hi, flags, bar_idx; };
typedef const __attribute__((address_space(4))) Args CArgs;
struct Frame {
    LAS unsigned char* lds; volatile LAS unsigned* MISC;
    unsigned* ctl; unsigned char* ws;
    int tid, lane, wave, vcu, G, bx; long zo;
};

__device__ __forceinline__ void tr_item(const float* src, int ld, int k0, int c0, bf16* dst, int Kd, int n0, bool qkperm, LAS float* scr, int lane, float scale = 1.f) {
    const float* s = src + (size_t)k0 * ld + c0;
    const int kr = lane >> 4, nq = lane & 15;
#pragma unroll 4
    for (int i = 0; i < 16; ++i) { const int k = 4 * i + kr; const f32x4 v = __builtin_nontemporal_load((const f32x4*)(s + (size_t)k * ld + 4 * nq));
        LAS float* d = scr + k * 65 + 4 * nq; d[0] = v[0]; d[1] = v[1]; d[2] = v[2]; d[3] = v[3]; }
    asm volatile("s_waitcnt lgkmcnt(0)" ::: "memory");
    const int c = lane & 7;
#pragma unroll
    for (int j = 0; j < 8; ++j) { const int n = (lane >> 3) + 8 * j; const int sc_ = qkperm ? ((n & 1) * 32 + (n >> 1)) : n; const LAS float* p = scr + (8 * c) * 65 + sc_;
        u32x4 o; o.x = pk2(p[0] * scale, p[65] * scale); o.y = pk2(p[130] * scale, p[195] * scale); o.z = pk2(p[260] * scale, p[325] * scale); o.w = pk2(p[390] * scale, p[455] * scale);
        __builtin_nontemporal_store(o, (u32x4*)(dst + (size_t)(n0 + n) * Kd + k0 + 8 * c)); }
    asm volatile("s_waitcnt lgkmcnt(0)" ::: "memory");
}
constexpr int TI_WIN = 4 * 16 * 88, TI_GT = 4 * 2 * 2 * 8 * 4, TI_WO = 4 * 3 * 256, TI_FGU = 2 * 16 * 88, TI_FD = 2 * 44 * 16, TI_EGU = 16 * 16 * 112, TI_ED = 16 * 56 * 16;
constexpr int TI_TOTAL = TI_WIN + TI_GT + TI_WO + TI_FGU + TI_FD + TI_EGU + TI_ED, MOD_ITEMS = 4 * 96;

__device__ __forceinline__ void conv_item(Frame& F, const Args& a, int it, LAS float* scr, int lane) {
    unsigned char* ws = F.ws;
    int r = it;
    do {
        if (r < TI_WIN) { const int l = r / (16 * 88), q = r % (16 * 88), kt = q / 88, nt = q % 88;
            tr_item((a.in[8] + F.zo) + (size_t)l * D * INC, INC, 64 * kt, 64 * nt, (bf16*)(ws + WS_WIN) + (size_t)l * INC * D, D, 64 * nt, nt < 20, scr, lane); break; }
        r -= TI_WIN;
        if (r < TI_GT) { const int tl = r & 3, m = r >> 2, h = m & 7, gx = (m >> 3) & 1, d = (m >> 4) & 1, l = m >> 5;
            const float* src = (gx ? (a.in[14] + F.zo) : (a.in[12] + F.zo)) + (size_t)((l * 2 + d) * 8 + h) * 128 * 128;
            bf16* dst = (bf16*)(ws + WS_GT) + (size_t)((l * 8 + h) * 4 + 2 * d + gx) * 128 * 128;
            tr_item(src, 128, 64 * (tl >> 1), 64 * (tl & 1), dst, 128, 64 * (tl & 1), false, scr, lane, -1.4426950408889634f); break; }
        r -= TI_GT;
        if (r < TI_WO) { const int mi = r / 256, q = r % 256, kt = q / 16, nt = q % 16, l = mi / 3, w = mi % 3;
            const float* src = (w == 0 ? (a.in[17] + F.zo) : (w == 1 ? (a.in[18] + F.zo) : (a.in[19] + F.zo))) + (size_t)l * D * D;
            tr_item(src, D, 64 * kt, 64 * nt, (bf16*)(ws + WS_WO) + (size_t)mi * D * D, D, 64 * nt, false, scr, lane); break; }
        r -= TI_WO;
        if (r < TI_FGU) { const int i = r / (16 * 88), q = r % (16 * 88), kt = q / 88, nt = q % 88;
            const int pn = nt >> 2, bj = (nt >> 1) & 1, hf = nt & 1;
            const float* src = (bj ? (a.in[21] + F.zo) : (a.in[20] + F.zo)) + (size_t)i * D * DFF;
            tr_item(src, DFF, 64 * kt, 128 * pn + 64 * hf, (bf16*)(ws + WS_FF + i * FF_STRIDE), D, 64 * nt, false, scr, lane); break; }
        r -= TI_FGU;
        if (r < TI_FD) { const int i = r / (44 * 16), q = r % (44 * 16), kt = q / 16, nt = q % 16;
            tr_item((a.in[22] + F.zo) + (size_t)i * DFF * D, D, 64 * kt, 64 * nt, (bf16*)(ws + WS_FF + i * FF_STRIDE) + (size_t)2 * DFF * D, DFF, 64 * nt, false, scr, lane); break; }
        r -= TI_FD;
        if (r < TI_EGU) { const int ie = r / (16 * 112), q = r % (16 * 112), kt = q / 112, nt = q % 112, i = ie >> 3, e = ie & 7;
            const int pn = nt >> 2, bj = (nt >> 1) & 1, hf = nt & 1;
            const float* src = (bj ? (a.in[25] + F.zo) : (a.in[24] + F.zo)) + (size_t)ie * D * DFE;
            tr_item(src, DFE, 64 * kt, 128 * pn + 64 * hf, (bf16*)(ws + WS_EXP + i * EXP_STRIDE) + (size_t)e * 2 * DFE * D, D, 64 * nt, false, scr, lane); break; }
        r -= TI_EGU;
        { const int ie = r / (56 * 16), q = r % (56 * 16), kt = q / 16, nt = q % 16, i = ie >> 3, e = ie & 7;
            tr_item((a.in[26] + F.zo) + (size_t)ie * DFE * D, D, 64 * kt, 64 * nt, (bf16*)(ws + WS_EXP + i * EXP_STRIDE) + (size_t)NE * 2 * DFE * D + (size_t)e * D * DFE, DFE, 64 * nt, false, scr, lane); }
    } while (0);
}
#ifndef DEFER_CONV
#define DEFER_CONV 0
#endif
constexpr int TI_DEF_GU = DEFER_CONV ? 8 * 16 * 112 : 0, TI_DEF_D = DEFER_CONV ? 8 * 56 * 16 : 0, TI_DEF = TI_DEF_GU + TI_DEF_D;
constexpr int TI_B_EGU = TI_WIN + TI_GT + TI_WO + TI_FGU + TI_FD, TI_B_ED = TI_B_EGU + TI_EGU;
__device__ __forceinline__ void conv_drain(Frame& F, const Args& a, int quota) {
    if (!DEFER_CONV) return;
    LAS float* scr = (LAS float*)(F.lds + F.wave * TR_WAVE_BYTES);
    for (int n = 0; n < quota; ++n) {
        unsigned q = 0;
        if (F.lane == 0) q = __hip_atomic_fetch_add(F.ctl + CW_Q, 1u, __ATOMIC_RELAXED, __HIP_MEMORY_SCOPE_AGENT);
        q = (unsigned)__builtin_amdgcn_readfirstlane((int)q);
        if (q >= (unsigned)TI_DEF) break;
        conv_item(F, a, (int)q < TI_DEF_GU ? TI_B_EGU + TI_DEF_GU + (int)q : TI_B_ED + TI_DEF_D + ((int)q - TI_DEF_GU), scr, F.lane);
    }
}
__device__ __forceinline__ void ph_prologue(Frame& F, const Args& a) {
    LAS float* scr = (LAS float*)(F.lds + F.wave * TR_WAVE_BYTES);
    LAS float* sv = (LAS float*)(F.lds + SVEC_OFF);
    for (int i = F.tid; i < 3 * D; i += NWAVES * 64) { const int v = i >> 10, k = i & (D - 1); const float x = v < 2 ? (a.in[1] + F.zo)[v * D + k] : (a.in[3] + F.zo)[k]; sv[i] = x * fsigm(x); }
    __syncthreads();
    const int gw = F.vcu * NWAVES + F.wave, NGW = F.G * NWAVES, lane = F.lane;
    unsigned char* ws = F.ws;
    if (gw == NGW - 1) { f32x2* rt = (f32x2*)(ws + WS_ROPE);
        for (int e = lane; e < 128 * 32; e += 64) { const int pos = e >> 5, i = e & 31; const float ang = (float)pos * powf(10000.f, -(float)i / 32.f); rt[e] = (f32x2){cosf(ang), sinf(ang)}; } }
    for (int it = NGW - 2 - gw; it >= 0 && it < MOD_ITEMS; it += NGW) {
        const int l = it / 96, n = (it % 96) * 64 + lane;
        const float* w = (a.in[4] + F.zo) + (size_t)l * D * 6 * D + n;
        float a0 = 0.f, a1 = 0.f, a2 = 0.f;
#pragma unroll 8
        for (int k = 0; k < D; ++k) { const float wv = w[(size_t)k * 6 * D]; a0 += sv[k] * wv; a1 += sv[D + k] * wv; a2 += sv[2 * D + k] * wv; }
        const float b = (a.in[5] + F.zo)[l * 6 * D + n];
        float* o = (float*)(ws + WS_MOD) + (size_t)l * 18 * D + n;
        o[0] = a0 + b; o[6 * D] = a1 + b; o[12 * D] = a2 + b;
    }
    for (int i = gw * 64 + lane; i < DEPTH * 2 * D; i += NGW * 64) ((f32x4*)(ws + WS_SPT))[i] = (f32x4){-1.4426950408889634f * (a.in[13] + F.zo)[i], -1.4426950408889634f * (a.in[15] + F.zo)[i], -8.f * 1.4426950408889634f * log1pf(expf(-(a.in[16] + F.zo)[i])), 0.f};
    for (int jt = gw; jt < TI_TOTAL - TI_DEF; jt += NGW) conv_item(F, a, jt < TI_B_EGU + TI_DEF_GU ? jt : jt + TI_DEF_GU, scr, lane);

}

__device__ __forceinline__ int rows_per_wave(int NGW) { return ML / NGW; }
template <int KIND, int NR> __device__ __forceinline__ void rows_block(Frame& F, const Args& a, int l, bool combine, bool moe, int m0, const f32x4 (&gm)[2][2], const f32x4 (&shv)[2][2], LAS const float* wr_l, LAS int* lcnt) {
    const int lane = F.lane; unsigned char* ws = F.ws;
    bf16* H = (bf16*)(ws + WS_H); bf16* XN = (bf16*)(ws + WS_XN);
    const int cbase = 8 * lane;
    f32x4 v[NR][2][2]; u32x4 q0[NR][2], q1[NR][2]; int sl0[NR], sl1[NR]; float tw0[NR], tw1[NR];
#pragma unroll
    for (int i = 0; i < NR; ++i) { const int m = m0 + i;
        if (KIND == 0 && l == 0) { const float* src = m < ML ? (a.in[0] + F.zo) + (size_t)m * D : (a.in[2] + F.zo) + (size_t)(m - ML) * D;
#pragma unroll
            for (int j = 0; j < 2; ++j) { v[i][j][0] = *(const f32x4*)(src + cbase + 512 * j); v[i][j][1] = *(const f32x4*)(src + cbase + 512 * j + 4); } }
        else {
#pragma unroll
            for (int j = 0; j < 2; ++j) { const u32x4 hb = *(const u32x4*)(H + (size_t)m * D + cbase + 512 * j);
                v[i][j][0] = (f32x4){bflo(hb.x), bfhi(hb.x), bflo(hb.y), bfhi(hb.y)}; v[i][j][1] = (f32x4){bflo(hb.z), bfhi(hb.z), bflo(hb.w), bfhi(hb.w)}; } }
        if (combine) { sl0[i] = ((const int*)(ws + WS_TOKSLOT))[2 * m]; sl1[i] = ((const int*)(ws + WS_TOKSLOT))[2 * m + 1]; tw0[i] = ((const float*)(ws + WS_TW))[2 * m]; tw1[i] = ((const float*)(ws + WS_TW))[2 * m + 1]; } }
    if (combine) {
#pragma unroll
        for (int i = 0; i < NR; ++i) { const bf16* f0 = (const bf16*)(ws + WS_FS) + (size_t)sl0[i] * D + cbase; const bf16* f1 = (const bf16*)(ws + WS_FS) + (size_t)sl1[i] * D + cbase;
#pragma unroll
            for (int j = 0; j < 2; ++j) { q0[i][j] = *(const u32x4*)(f0 + 512 * j); q1[i][j] = *(const u32x4*)(f1 + 512 * j); } }
        const int lp = KIND == 0 ? l - 1 : DEPTH - 1;
        const float* g2 = (const float*)(ws + WS_MOD) + (size_t)lp * 18 * D + (size_t)row_vec(m0) * 6 * D + 5 * D + cbase;
        f32x4 gg[2][2];
#pragma unroll
        for (int j = 0; j < 2; ++j) { gg[j][0] = *(const f32x4*)(g2 + 512 * j); gg[j][1] = *(const f32x4*)(g2 + 512 * j + 4); }
#pragma unroll
        for (int i = 0; i < NR; ++i) { const float w0 = tw0[i], w1 = tw1[i];
#pragma unroll
            for (int j = 0; j < 2; ++j) { const u32x4 p0 = q0[i][j], p1 = q1[i][j];
                v[i][j][0][0] += gg[j][0][0] * (w0 * bflo(p0.x) + w1 * bflo(p1.x)); v[i][j][0][1] += gg[j][0][1] * (w0 * bfhi(p0.x) + w1 * bfhi(p1.x));
                v[i][j][0][2] += gg[j][0][2] * (w0 * bflo(p0.y) + w1 * bflo(p1.y)); v[i][j][0][3] += gg[j][0][3] * (w0 * bfhi(p0.y) + w1 * bfhi(p1.y));
                v[i][j][1][0] += gg[j][1][0] * (w0 * bflo(p0.z) + w1 * bflo(p1.z)); v[i][j][1][1] += gg[j][1][1] * (w0 * bfhi(p0.z) + w1 * bfhi(p1.z));
                v[i][j][1][2] += gg[j][1][2] * (w0 * bflo(p0.w) + w1 * bflo(p1.w)); v[i][j][1][3] += gg[j][1][3] * (w0 * bfhi(p0.w) + w1 * bfhi(p1.w)); }
            if (KIND != 2) {
#pragma unroll
                for (int j = 0; j < 2; ++j) { u32x4 hw; hw.x = pk2(v[i][j][0][0], v[i][j][0][1]); hw.y = pk2(v[i][j][0][2], v[i][j][0][3]); hw.z = pk2(v[i][j][1][0], v[i][j][1][1]); hw.w = pk2(v[i][j][1][2], v[i][j][1][3]); st16w<3>(H + (size_t)(m0 + i) * D + cbase + 512 * j, hw); }
            } }
    }
#pragma unroll
    for (int i = 0; i < NR; ++i) { const int m = m0 + i;
        float ss = 0.f;
#pragma unroll
        for (int j = 0; j < 2; ++j)
#pragma unroll
            for (int hf = 0; hf < 2; ++hf) { const f32x4 x = v[i][j][hf]; ss += (x[0] * x[0] + x[1] * x[1]) + (x[2] * x[2] + x[3] * x[3]); }
        ss = wsum(ss, lane);
        const float r = rsqrtf(ss * (1.f / D) + EPS);
        if (KIND == 2) {
#pragma unroll
            for (int j = 0; j < 2; ++j) { *(f32x4*)((a.out + F.zo) + (size_t)m * D + cbase + 512 * j) = v[i][j][0] * r * gm[j][0]; *(f32x4*)((a.out + F.zo) + (size_t)m * D + cbase + 512 * j + 4) = v[i][j][1] * r * gm[j][1]; }
        } else {
            float lg[NE];
#pragma unroll
            for (int e = 0; e < NE; ++e) lg[e] = 0.f;
#pragma unroll
            for (int j = 0; j < 2; ++j) {
                const f32x4 y0 = v[i][j][0] * (gm[j][0] * r) + shv[j][0], y1 = v[i][j][1] * (gm[j][1] * r) + shv[j][1];
                u32x4 ob; ob.x = pk2(y0[0], y0[1]); ob.y = pk2(y0[2], y0[3]); ob.z = pk2(y1[0], y1[1]); ob.w = pk2(y1[2], y1[3]);
                st16w<3>(XN + (size_t)m * D + cbase + 512 * j, ob);
                if (moe) {
#pragma unroll
                    for (int e = 0; e < NE; ++e) { const f32x4 w0 = *(const LAS f32x4*)(wr_l + ((e * 2 + j) * 2 + 0) * 256 + 4 * lane), w1 = *(const LAS f32x4*)(wr_l + ((e * 2 + j) * 2 + 1) * 256 + 4 * lane);
                        lg[e] += ((y0[0] * w0[0] + y0[1] * w0[1]) + (y0[2] * w0[2] + y0[3] * w0[3])) + ((y1[0] * w1[0] + y1[1] * w1[1]) + (y1[2] * w1[2] + y1[3] * w1[3])); }
                }
            }
            if (moe) {
#pragma unroll
                for (int e = 0; e < NE; ++e) lg[e] = wsum(lg[e], lane);
                int i0 = 0; float v0 = lg[0];
#pragma unroll
                for (int e = 1; e < NE; ++e) if (lg[e] > v0) { v0 = lg[e]; i0 = e; }
                int i1 = -1; float v1 = -INFINITY;
#pragma unroll
                for (int e = 0; e < NE; ++e) if (e != i0 && lg[e] > v1) { v1 = lg[e]; i1 = e; }
                if (lane == 0) {
                    const float e1 = expf(v1 - v0), w0 = 1.f / (1.f + e1), w1 = e1 / (1.f + e1);
                    int* te = (int*)(ws + WS_TE); float* tw = (float*)(ws + WS_TW);
                    te[2 * m] = i0; te[2 * m + 1] = i1; tw[2 * m] = w0; tw[2 * m + 1] = w1;
                    lcnt[F.wave * 8 + i0] += 1; lcnt[F.wave * 8 + i1] += 1;
                }
            }
        }
    }
}
template <int KIND> __device__ __forceinline__ void ph_rows(Frame& F, const Args& a, int l, bool combine) {
    const int gw = F.vcu * NWAVES + F.wave, NGW = F.G * NWAVES, lane = F.lane;
    unsigned char* ws = F.ws;
    const float* MOD = (const float*)(ws + WS_MOD);
    const bool moe = KIND == 1 && (l & 1);
    LAS float* wr_l = (LAS float*)(F.lds);
    LAS int* lcnt = (LAS int*)(F.lds + 32768);
    if (moe) {
        const float* wr = (a.in[23] + F.zo) + (size_t)(l >> 1) * D * NE;
        for (int i = F.tid; i < D * NE; i += NWAVES * 64) { const int k = i >> 3, e = i & 7; wr_l[((e * 2 + (k >> 9)) * 2 + ((k >> 2) & 1)) * 256 + ((k & 511) >> 3) * 4 + (k & 3)] = wr[i]; }
        if (F.tid < 64) lcnt[F.tid] = 0;
        __syncthreads();
    }
    const bool with_ctx = !(KIND == 2 || (KIND == 1 && l == DEPTH - 1));
    const float* gvec = (KIND == 0 ? (a.in[6] + F.zo) + l * D : (KIND == 1 ? (a.in[7] + F.zo) + l * D : (a.in[27] + F.zo))) + 8 * lane;
    const int RPW = rows_per_wave(NGW);
#pragma unroll 1
    for (int part = 0; part < 2; ++part) {
        if (part == 1 && !(with_ctx && gw < MC)) break;
        const int mfirst = part == 0 ? gw * RPW : ML + gw, vec = part == 0 ? mfirst / SEQ : 2;
        f32x4 gm[2][2], shv[2][2];
        const float* mv = MOD + (size_t)(KIND == 2 ? 0 : l) * 18 * D + (size_t)vec * 6 * D + (KIND == 0 ? 0 : 3 * D) + 8 * lane;
#pragma unroll
        for (int j = 0; j < 2; ++j)
#pragma unroll
            for (int hf = 0; hf < 2; ++hf) { const f32x4 g = *(const f32x4*)(gvec + 512 * j + 4 * hf);
                if (KIND == 2) { gm[j][hf] = g; shv[j][hf] = (f32x4){0.f, 0.f, 0.f, 0.f}; }
                else { gm[j][hf] = g * (*(const f32x4*)(mv + D + 512 * j + 4 * hf) + 1.f); shv[j][hf] = *(const f32x4*)(mv + 512 * j + 4 * hf); } }
        if (part == 0) { for (int r0 = 0; r0 < RPW; r0 += 4) rows_block<KIND, 4>(F, a, l, combine, moe, mfirst + r0, gm, shv, wr_l, lcnt); }
        else rows_block<KIND, 1>(F, a, l, combine, moe, mfirst, gm, shv, wr_l, lcnt);
    }
    if (moe) {
        asm volatile("s_waitcnt lgkmcnt(0)" ::: "memory");
        if (lane < NE) ((int*)(ws + WS_WCNT))[gw * 8 + lane] = lcnt[F.wave * 8 + lane];
    }
}

__device__ __forceinline__ void ph_lists(Frame& F, int l) {
    const int gw = F.vcu * NWAVES + F.wave, NGW = F.G * NWAVES, lane = F.lane;
    unsigned char* ws = F.ws;
    const int nrows = l == DEPTH - 1 ? ML : MT;
    const int* te = (const int*)(ws + WS_TE); int* tok_slot = (int*)(ws + WS_TOKSLOT); int* panel_e = (int*)(ws + WS_PANELE);
    int* slot_tok = (int*)(ws + WS_SLOTTOK);
    LAS int* wc = (LAS int*)(F.lds); LAS int* blk = wc + 16384; LAS int* segs = blk + 2048; LAS int* segp = segs + 64; LAS int* bb = segp + 64; LAS int* tot = bb + 8; LAS int* wpos = tot + 8;
    if (NGW * 8 == 8 * NWAVES * 64 * 4) {
        const u32x4* WC4 = (const u32x4*)(ws + WS_WCNT); u32x4 v[8];
#pragma unroll
        for (int j = 0; j < 8; ++j) v[j] = WC4[F.tid + NWAVES * 64 * j];
#pragma unroll
        for (int j = 0; j < 8; ++j) ((LAS u32x4*)wc)[F.tid + NWAVES * 64 * j] = v[j];
    } else { const int* WC = (const int*)(ws + WS_WCNT); for (int i = F.tid; i < NGW * 8; i += NWAVES * 64) wc[i] = WC[i]; }
    __syncthreads();
    for (int i = F.tid; i < F.G * 8; i += NWAVES * 64) { const int b = i >> 3, e = i & 7; int s = 0;
#pragma unroll
        for (int w = 0; w < 8; ++w) s += wc[(b * 8 + w) * 8 + e];
        blk[i] = s; }
    __syncthreads();
    if (F.tid < 64) { const int sg = F.tid >> 3, e = F.tid & 7; int s = 0, p = 0;
        for (int b = 32 * sg; b < 32 * sg + 32 && b < F.G; ++b) { const int v = blk[b * 8 + e]; s += v; p += b < F.vcu ? v : 0; }
        segs[F.tid] = s; segp[F.tid] = p; }
    __syncthreads();
    if (F.tid < NE) { int t = 0, bs = 0; const int ms = F.vcu >> 5;
#pragma unroll
        for (int sg = 0; sg < 8; ++sg) { const int v = segs[sg * 8 + F.tid]; t += v; bs += sg < ms ? v : (sg == ms ? segp[sg * 8 + F.tid] : 0); }
        tot[F.tid] = t; bb[F.tid] = bs; }
    __syncthreads();
    if (F.tid < 64) { const int w = F.tid >> 3, e = F.tid & 7; int s = bb[e]; for (int w2 = 0; w2 < w; ++w2) s += wc[((F.vcu * 8 + w2) * 8) + e]; wpos[F.tid] = s; }
    int cnt[NE], off[NE + 1];
    { int o = 0;
#pragma unroll
      for (int e = 0; e < NE; ++e) { cnt[e] = tot[e]; off[e] = o; o += (cnt[e] + 255) & ~255; }
      off[NE] = o; }
    __syncthreads();
    const int RPW = rows_per_wave(NGW), nmine = RPW + ((nrows == MT && gw < MC) ? 1 : 0);
    int tev = 0;
    if (lane < 2 * RPW) tev = te[2 * (gw * RPW) + lane]; else if (lane < 2 * RPW + 2 && nmine > RPW) tev = te[2 * (ML + gw) + (lane - 2 * RPW)];
    for (int ri = 0; ri < nmine; ++ri) { const int m = ri < RPW ? gw * RPW + ri : ML + gw;
        int s0 = 0, s1 = 0;
        const int e0_ = __builtin_amdgcn_readlane(tev, 2 * ri), e1_ = __builtin_amdgcn_readlane(tev, 2 * ri + 1);
        if (lane == 0) {
#pragma unroll
            for (int k = 0; k < 2; ++k) { const int e = k == 0 ? e0_ : e1_; const int pos = wpos[F.wave * 8 + e]; wpos[F.wave * 8 + e] = pos + 1; int o = 0;
#pragma unroll
                for (int x = 0; x < NE; ++x) o = (x == e) ? off[x] : o;
                const int slot = o + pos; tok_slot[2 * m + k] = slot; if (k == 0) s0 = slot; else s1 = slot; }
        }
        if (lane == 0) { slot_tok[s0] = m; slot_tok[s1] = m; }
    }
#pragma unroll
    for (int e = 0; e < NE; ++e) { const int base = off[e] + cnt[e], npad = off[e + 1] - base;
        for (int i = gw * 64 + lane; i < npad; i += NGW * 64) slot_tok[base + i] = -1; }
    if (F.bx == 0) { for (int p = F.tid; p < 256; p += NWAVES * 64) { int e = 0;
#pragma unroll
            for (int x = 1; x < NE; ++x) if (p * 256 >= off[x]) e = x;
            panel_e[p] = e; }
        if (F.tid == 0) panel_e[256] = off[NE] / 256; }
}

#ifndef ATT2
#define ATT2 2
#endif
#if ATT2 == 1
#ifndef A2_SD
#define A2_SD 2
#endif
#define A2_SO (A2_SD - 1)
constexpr int A2_V = 0, A2_K = 32768, A2_TILE = 16384;
typedef short s16x4 __attribute__((ext_vector_type(4)));
#define A2_SBAR() __builtin_amdgcn_sched_barrier(0)
__device__ __forceinline__ int a2_crow(int r, int hi) { return (r & 3) + 8 * (r >> 2) + 4 * hi; }
template <int OFF> __device__ __forceinline__ s16x4 a2_tr(unsigned vb) { s16x4 r; asm volatile("ds_read_b64_tr_b16 %0, %1 offset:%2" : "=&v"(r) : "v"(vb), "i"(OFF) : "memory"); return r; }
constexpr float A2_SCALE = 0.08838834764831845f, A2_C = 0.08838834764831845f * 1.4426950408889634f, A2_THR = 8.f / 0.08838834764831845f;
__device__ __forceinline__ void a2_qkt(f32x16& p0, f32x16& p1, const LAS unsigned char* Ks, const bf16x8 (&qr)[8], int r32, int hi) {
#pragma unroll
    for (int r = 0; r < 16; ++r) { p0[r] = 0.f; p1[r] = 0.f; }
    const int base = r32 * 256 + ((16 * hi) ^ ((r32 & 7) << 4));
#pragma unroll
    for (int d0 = 0; d0 < 8; ++d0) {
        const bf16x8 b0 = *(const LAS bf16x8*)(Ks + (base ^ (32 * d0))), b1 = *(const LAS bf16x8*)(Ks + (base ^ (32 * d0)) + 8192);
        p0 = __builtin_amdgcn_mfma_f32_32x32x16_bf16(b0, qr[d0], p0, 0, 0, 0);
        p1 = __builtin_amdgcn_mfma_f32_32x32x16_bf16(b1, qr[d0], p1, 0, 0, 0);
    }
}
__device__ __forceinline__ void a2_psm(f32x16& p0, f32x16& p1, float& m_reg, float& alpha, bool need_mask, int kd, int hi) {
    if (need_mask) {
#pragma unroll
        for (int r = 0; r < 16; ++r) { const int d0 = kd + a2_crow(r, hi), d1 = d0 + 32;
            if (d0 > WIN || d0 < -WIN) p0[r] = -INFINITY; if (d1 > WIN || d1 < -WIN) p1[r] = -INFINITY; }
    }
    float pmax = p0[0];
#pragma unroll
    for (int r = 1; r < 16; ++r) pmax = fmaxf(pmax, p0[r]);
#pragma unroll
    for (int r = 0; r < 16; ++r) pmax = fmaxf(pmax, p1[r]);
    { auto rr = __builtin_amdgcn_permlane32_swap(__float_as_uint(pmax), __float_as_uint(pmax), false, false);
      pmax = fmaxf(__uint_as_float(rr[0]), __uint_as_float(rr[1])); }
    float mn;
    if (__builtin_amdgcn_ballot_w64(pmax - m_reg > A2_THR) == 0ull) { mn = m_reg; alpha = 1.f; }
    else { mn = fmaxf(m_reg, pmax); alpha = __builtin_amdgcn_exp2f((m_reg - mn) * A2_C); m_reg = mn; }
    const float mnC = -mn * A2_C;
#pragma unroll
    for (int r = 0; r < 16; ++r) { p0[r] = fmaf(p0[r], A2_C, mnC); p1[r] = fmaf(p1[r], A2_C, mnC); }
#pragma unroll
    for (int r = 0; r < 16; ++r) p0[r] = __builtin_amdgcn_exp2f(p0[r]);
}
__device__ __forceinline__ void a2_fsm(f32x16& p0, f32x16& p1, float alpha, float& l_reg, bf16x8 (&pf)[4]) {
#pragma unroll
    for (int r = 0; r < 16; ++r) p1[r] = __builtin_amdgcn_exp2f(p1[r]);
    float ps = 0.f;
#pragma unroll
    for (int r = 0; r < 16; ++r) ps += p0[r];
#pragma unroll
    for (int r = 0; r < 16; ++r) ps += p1[r];
    l_reg = l_reg * alpha + ps;
#pragma unroll
    for (int s = 0; s < 2; ++s) {
        u32x4 x0, x1;
        x0.x = pk2(p0[8 * s + 0], p0[8 * s + 1]); x0.y = pk2(p0[8 * s + 2], p0[8 * s + 3]); x0.z = pk2(p0[8 * s + 4], p0[8 * s + 5]); x0.w = pk2(p0[8 * s + 6], p0[8 * s + 7]);
        x1.x = pk2(p1[8 * s + 0], p1[8 * s + 1]); x1.y = pk2(p1[8 * s + 2], p1[8 * s + 3]); x1.z = pk2(p1[8 * s + 4], p1[8 * s + 5]); x1.w = pk2(p1[8 * s + 6], p1[8 * s + 7]);
        pf[s] = __builtin_bit_cast(bf16x8, x0); pf[2 + s] = __builtin_bit_cast(bf16x8, x1);
    }
}
template <int DT> __device__ __forceinline__ void a2_pv_one(f32x16& od, unsigned vb, const bf16x8 (&pf)[4]) {
    const s16x4 l0 = a2_tr<DT * 512 + 0 * 4096>(vb), h0 = a2_tr<DT * 512 + 0 * 4096 + 2048>(vb), l1 = a2_tr<DT * 512 + 1 * 4096>(vb), h1 = a2_tr<DT * 512 + 1 * 4096 + 2048>(vb);
    const s16x4 l2 = a2_tr<DT * 512 + 2 * 4096>(vb), h2 = a2_tr<DT * 512 + 2 * 4096 + 2048>(vb), l3 = a2_tr<DT * 512 + 3 * 4096>(vb), h3 = a2_tr<DT * 512 + 3 * 4096 + 2048>(vb);
    asm volatile("s_waitcnt lgkmcnt(0)" ::: "memory"); A2_SBAR();
#define A2_PK(L, H) (bf16x8){L[0], L[1], L[2], L[3], H[0], H[1], H[2], H[3]}
    od = __builtin_amdgcn_mfma_f32_32x32x16_bf16(A2_PK(l0, h0), pf[0], od, 0, 0, 0);
    od = __builtin_amdgcn_mfma_f32_32x32x16_bf16(A2_PK(l1, h1), pf[1], od, 0, 0, 0);
    od = __builtin_amdgcn_mfma_f32_32x32x16_bf16(A2_PK(l2, h2), pf[2], od, 0, 0, 0);
    od = __builtin_amdgcn_mfma_f32_32x32x16_bf16(A2_PK(l3, h3), pf[3], od, 0, 0, 0);
#undef A2_PK
}
__device__ __forceinline__ void a2_pv(f32x16 (&o)[4], unsigned vb, const bf16x8 (&pf)[4]) {
    a2_pv_one<0>(o[0], vb, pf); a2_pv_one<1>(o[1], vb, pf); a2_pv_one<2>(o[2], vb, pf); a2_pv_one<3>(o[3], vb, pf);
}
__device__ __forceinline__ void attn_unit(Frame& F, const float* sinkl, int unit) {
    const int tid = F.tid, lane = F.lane, w = F.wave, r32 = lane & 31, hi = lane >> 5;
    const bf16* P = (const bf16*)(F.ws + WS_P); bf16* ATT = (bf16*)(F.ws + WS_ATT);
    LAS unsigned char* lds = F.lds;
    const bool lat = unit < 512;
    int b, kvh, t0;
    if (lat) { b = unit >> 8; kvh = (unit >> 7) & 1; t0 = (unit & 127) * 64; } else { const int u = unit - 512; b = u >> 3; kvh = (u >> 2) & 1; t0 = (u & 3) * 64; }
    const int hh = kvh * 4 + (w >> 1), qlo = t0 + 32 * (w & 1), qt = qlo + r32;
    const size_t mq = lat ? (size_t)b * SEQ + qt : (size_t)ML + b * CTX + qt;
    const int ti_lo = lat ? (t0 >= 128 ? 0 : (128 - t0) >> 6) : 0, ti_hi = lat ? ((SEQ + 128 - t0) >> 6 < 5 ? (SEQ + 128 - t0) >> 6 : 5) : 0;
    const int nl = ti_hi - ti_lo, NT = nl + 4;
    const int ks0 = t0 - 128 + 64 * ti_lo;
    const int wrow0 = b * SEQ + ks0, crow0 = ML + b * CTX;
    const int sr = tid >> 4, sc = (tid & 15) * 8;
    const bf16* Pk0 = P + (size_t)sr * INC + OFF_K + kvh * HD + sc;
    const int vst0 = ((sr >> 3) * 4 + (sc >> 5)) * 512 + ((sr & 7) * 32 + (sc & 31)) * 2, kst0 = sr * 256 + ((sc * 2) ^ ((sr & 7) << 4));
    const unsigned vb0 = (unsigned)(size_t)(lds + A2_V) + (((lane & 3) << 3) | (((lane >> 2) & 3) << 6) | (((lane >> 4) & 1) << 5) | (((lane >> 5) & 1) << 8));
    u32x4 sg[A2_SD][4];
#define A2_ROW(n) ((n) < nl ? wrow0 + 64 * (n) : crow0 + 64 * ((n) - nl))
#define A2_LOAD(i, n) do { const bf16* p_ = Pk0 + (size_t)A2_ROW(n) * INC; sg[i][0] = *(const u32x4*)(p_ + (OFF_V - OFF_K)); sg[i][1] = *(const u32x4*)(p_ + (OFF_V - OFF_K) + (size_t)32 * INC); \
        sg[i][2] = *(const u32x4*)(p_); sg[i][3] = *(const u32x4*)(p_ + (size_t)32 * INC); } while (0)
#define A2_WRITE(bf, i) do { *(LAS u32x4*)(lds + A2_V + (bf) * A2_TILE + vst0) = sg[i][0]; *(LAS u32x4*)(lds + A2_V + (bf) * A2_TILE + vst0 + 8192) = sg[i][1]; \
        *(LAS u32x4*)(lds + A2_K + (bf) * A2_TILE + kst0) = sg[i][2]; *(LAS u32x4*)(lds + A2_K + (bf) * A2_TILE + kst0 + 8192) = sg[i][3]; } while (0)
#define A2_WAIT() do { if (A2_SD == 2) asm volatile("s_waitcnt vmcnt(4)" ::: "memory"); else asm volatile("s_waitcnt vmcnt(0)" ::: "memory"); } while (0)
#define A2_MASKED(n) ((n) < nl && ((ks0 + 64 * (n) + 63 - qlo > WIN) || (qlo + 31 - (ks0 + 64 * (n)) > WIN)))
#define A2_PSM(p0_, p1_, al_, n) a2_psm(p0_, p1_, m_reg, al_, A2_MASKED(n), ks0 + 64 * (n) - qt, hi)
#define A2_RESC(al_) do { if (__builtin_amdgcn_ballot_w64((al_) < 1.f) != 0ull) { _Pragma("unroll") for (int d_ = 0; d_ < 4; ++d_) _Pragma("unroll") for (int r_ = 0; r_ < 16; ++r_) o[d_][r_] *= (al_); } } while (0)
    bf16x8 qr[8];
    { const bf16* qp = P + mq * INC + OFF_Q + hh * HD + 8 * hi;
#pragma unroll
      for (int kk = 0; kk < 8; ++kk) qr[kk] = *(const bf16x8*)(qp + 16 * kk); }
    f32x16 o[4];
#pragma unroll
    for (int dt = 0; dt < 4; ++dt)
#pragma unroll
        for (int r = 0; r < 16; ++r) o[dt][r] = 0.f;
    float m_reg = sinkl[hh] * (1.f / A2_SCALE), l_reg = hi == 0 ? 1.f : 0.f;
    f32x16 pA0, pA1, pB0, pB1; float alA, alB; bf16x8 pf[4];
    const LAS unsigned char* K0 = lds + A2_K; const LAS unsigned char* K1 = lds + A2_K + A2_TILE;
    __syncthreads();
    A2_LOAD(0, 0); A2_WRITE(0, 0); __syncthreads();
    a2_qkt(pA0, pA1, K0, qr, r32, hi); A2_PSM(pA0, pA1, alA, 0);
    A2_LOAD(A2_SO, 1); if (A2_SD == 2) A2_LOAD(0, 2);
    A2_WAIT(); A2_WRITE(1, A2_SO); __syncthreads();
    int j = 1;
    for (; j + 1 < NT; j += 2) {
        A2_SBAR(); a2_qkt(pB0, pB1, K1, qr, r32, hi);
        a2_fsm(pA0, pA1, alA, l_reg, pf); A2_SBAR();
        if (j + A2_SD < NT) A2_LOAD(A2_SO, j + A2_SD); A2_SBAR();
        a2_pv(o, vb0, pf); A2_PSM(pB0, pB1, alB, j);
        __syncthreads(); A2_WAIT(); A2_WRITE(0, 0);
        A2_RESC(alB); __syncthreads();
        A2_SBAR(); a2_qkt(pA0, pA1, K0, qr, r32, hi);
        a2_fsm(pB0, pB1, alB, l_reg, pf); A2_SBAR();
        if (j + 1 + A2_SD < NT) A2_LOAD(0, j + 1 + A2_SD); A2_SBAR();
        a2_pv(o, vb0 + A2_TILE, pf); A2_PSM(pA0, pA1, alA, j + 1);
        __syncthreads(); A2_WAIT(); if (j + 2 < NT) A2_WRITE(1, A2_SO);
        A2_RESC(alA); __syncthreads();
    }
    if (j < NT) {
        A2_SBAR(); a2_qkt(pB0, pB1, K1, qr, r32, hi);
        a2_fsm(pA0, pA1, alA, l_reg, pf); A2_SBAR();
        a2_pv(o, vb0, pf); A2_PSM(pB0, pB1, alB, j);
        A2_RESC(alB);
        a2_fsm(pB0, pB1, alB, l_reg, pf); A2_SBAR();
        a2_pv(o, vb0 + A2_TILE, pf);
    } else {
        a2_fsm(pA0, pA1, alA, l_reg, pf); A2_SBAR();
        a2_pv(o, vb0, pf);
    }
#undef A2_ROW
#undef A2_LOAD
#undef A2_WRITE
#undef A2_WAIT
#undef A2_MASKED
#undef A2_PSM
#undef A2_RESC
    const float ltot = l_reg + bperm(l_reg, lane ^ 32), inv = 1.f / ltot;
    bf16* op = ATT + mq * D + hh * HD + 4 * hi;
#pragma unroll
    for (int dt = 0; dt < 4; ++dt)
#pragma unroll
        for (int rg = 0; rg < 4; ++rg) { u32x2 wv; wv.x = pk2(o[dt][4 * rg] * inv, o[dt][4 * rg + 1] * inv); wv.y = pk2(o[dt][4 * rg + 2] * inv, o[dt][4 * rg + 3] * inv);
            *(u32x2*)(op + 32 * dt + 8 * rg) = wv; }
}
#elif ATT2 == 2
constexpr int A3_BUF = 32768, A3_K = 16384;
#ifndef A3_PRIO
#define A3_PRIO 0
#endif
#ifndef A3_LATEDMA
#define A3_LATEDMA 0
#endif
#ifndef A3_TRALL
#define A3_TRALL 0
#endif
#ifndef A3_NOSBAR
#define A3_NOSBAR 0
#endif
typedef short s16x4 __attribute__((ext_vector_type(4)));
#define A2_SBAR() __builtin_amdgcn_sched_barrier(0)
#define A3_SB() do { if (!A3_NOSBAR) __builtin_amdgcn_sched_barrier(0); } while (0)
__device__ __forceinline__ int a2_crow(int r, int hi) { return (r & 3) + 8 * (r >> 2) + 4 * hi; }
template <int OFF> __device__ __forceinline__ s16x4 a2_tr(unsigned vb) { s16x4 r; asm volatile("ds_read_b64_tr_b16 %0, %1 offset:%2" : "=&v"(r) : "v"(vb), "i"(OFF) : "memory"); return r; }
constexpr float A2_SCALE = 0.08838834764831845f, A2_C = 0.08838834764831845f * 1.4426950408889634f, A2_THR = 8.f / 0.08838834764831845f;
__device__ __forceinline__ void a3_qk(f32x16& p, const LAS unsigned char* Kh, const bf16x8 (&qr)[8], int base) {
#pragma unroll
    for (int r = 0; r < 16; ++r) p[r] = 0.f;
#pragma unroll
    for (int d0 = 0; d0 < 8; ++d0) { const bf16x8 b = *(const LAS bf16x8*)(Kh + (base ^ (32 * d0))); if (A3_PRIO) __builtin_amdgcn_s_setprio(1); p = __builtin_amdgcn_mfma_f32_32x32x16_bf16(b, qr[d0], p, 0, 0, 0); if (A3_PRIO) __builtin_amdgcn_s_setprio(0); }
}
__device__ __forceinline__ void a3_psm(f32x16& p, float& m_reg, float& alpha, bool need_mask, int kd, int hi) {
    if (need_mask) {
#pragma unroll
        for (int r = 0; r < 16; ++r) { const int d = kd + a2_crow(r, hi); if (d > WIN || d < -WIN) p[r] = -INFINITY; }
    }
    float pmax = p[0];
#pragma unroll
    for (int r = 1; r < 16; ++r) pmax = fmaxf(pmax, p[r]);
    { auto rr = __builtin_amdgcn_permlane32_swap(__float_as_uint(pmax), __float_as_uint(pmax), false, false);
      pmax = fmaxf(__uint_as_float(rr[0]), __uint_as_float(rr[1])); }
    float mn;
    if (__builtin_amdgcn_ballot_w64(pmax - m_reg > A2_THR) == 0ull) { mn = m_reg; alpha = 1.f; }
    else { mn = fmaxf(m_reg, pmax); alpha = __builtin_amdgcn_exp2f((m_reg - mn) * A2_C); m_reg = mn; }
    const float mnC = -mn * A2_C;
#pragma unroll
    for (int r = 0; r < 16; ++r) p[r] = fmaf(p[r], A2_C, mnC);
#pragma unroll
    for (int r = 0; r < 8; ++r) p[r] = __builtin_amdgcn_exp2f(p[r]);
}
__device__ __forceinline__ void a3_fsm(f32x16& p, float alpha, float& l_reg, bf16x8 (&pf)[2]) {
#pragma unroll
    for (int r = 8; r < 16; ++r) p[r] = __builtin_amdgcn_exp2f(p[r]);
    float ps = 0.f;
#pragma unroll
    for (int r = 0; r < 16; ++r) ps += p[r];
    l_reg = l_reg * alpha + ps;
#pragma unroll
    for (int s = 0; s < 2; ++s) { u32x4 x; x.x = pk2(p[8 * s + 0], p[8 * s + 1]); x.y = pk2(p[8 * s + 2], p[8 * s + 3]); x.z = pk2(p[8 * s + 4], p[8 * s + 5]); x.w = pk2(p[8 * s + 6], p[8 * s + 7]); pf[s] = __builtin_bit_cast(bf16x8, x); }
}
template <int DT, int KH> __device__ __forceinline__ void a3_pv2(f32x16& oa, f32x16& ob, unsigned vb, const bf16x8 (&pf)[2]) {
    constexpr int B0 = DT * 512 + (2 * KH) * 4096, B1 = B0 + 512;
    const s16x4 al0 = a2_tr<B0>(vb), ah0 = a2_tr<B0 + 2048>(vb), al1 = a2_tr<B0 + 4096>(vb), ah1 = a2_tr<B0 + 4096 + 2048>(vb);
    const s16x4 bl0 = a2_tr<B1>(vb), bh0 = a2_tr<B1 + 2048>(vb), bl1 = a2_tr<B1 + 4096>(vb), bh1 = a2_tr<B1 + 4096 + 2048>(vb);
    asm volatile("s_waitcnt lgkmcnt(0)" ::: "memory"); A2_SBAR();
#define A2_PK(L, H) (bf16x8){L[0], L[1], L[2], L[3], H[0], H[1], H[2], H[3]}
    oa = __builtin_amdgcn_mfma_f32_32x32x16_bf16(A2_PK(al0, ah0), pf[0], oa, 0, 0, 0);
    ob = __builtin_amdgcn_mfma_f32_32x32x16_bf16(A2_PK(bl0, bh0), pf[0], ob, 0, 0, 0);
    oa = __builtin_amdgcn_mfma_f32_32x32x16_bf16(A2_PK(al1, ah1), pf[1], oa, 0, 0, 0);
    ob = __builtin_amdgcn_mfma_f32_32x32x16_bf16(A2_PK(bl1, bh1), pf[1], ob, 0, 0, 0);
#undef A2_PK
}
template <int KH> __device__ __forceinline__ void a3_pv(f32x16 (&o)[4], unsigned vb, const bf16x8 (&pf)[2]) {
#if A3_TRALL
    constexpr int B0 = (2 * KH) * 4096;
#define A2_PK(L, H) (bf16x8){L[0], L[1], L[2], L[3], H[0], H[1], H[2], H[3]}
#define A3_RD(d) const s16x4 l0##d = a2_tr<B0 + d * 512>(vb), h0##d = a2_tr<B0 + d * 512 + 2048>(vb), l1##d = a2_tr<B0 + d * 512 + 4096>(vb), h1##d = a2_tr<B0 + d * 512 + 4096 + 2048>(vb)
    A3_RD(0); A3_RD(1); A3_RD(2); A3_RD(3);
    asm volatile("s_waitcnt lgkmcnt(0)" ::: "memory"); A2_SBAR();
    if (A3_PRIO) __builtin_amdgcn_s_setprio(1);
    o[0] = __builtin_amdgcn_mfma_f32_32x32x16_bf16(A2_PK(l00, h00), pf[0], o[0], 0, 0, 0); o[1] = __builtin_amdgcn_mfma_f32_32x32x16_bf16(A2_PK(l01, h01), pf[0], o[1], 0, 0, 0);
    o[2] = __builtin_amdgcn_mfma_f32_32x32x16_bf16(A2_PK(l02, h02), pf[0], o[2], 0, 0, 0); o[3] = __builtin_amdgcn_mfma_f32_32x32x16_bf16(A2_PK(l03, h03), pf[0], o[3], 0, 0, 0);
    o[0] = __builtin_amdgcn_mfma_f32_32x32x16_bf16(A2_PK(l10, h10), pf[1], o[0], 0, 0, 0); o[1] = __builtin_amdgcn_mfma_f32_32x32x16_bf16(A2_PK(l11, h11), pf[1], o[1], 0, 0, 0);
    o[2] = __builtin_amdgcn_mfma_f32_32x32x16_bf16(A2_PK(l12, h12), pf[1], o[2], 0, 0, 0); o[3] = __builtin_amdgcn_mfma_f32_32x32x16_bf16(A2_PK(l13, h13), pf[1], o[3], 0, 0, 0);
    if (A3_PRIO) __builtin_amdgcn_s_setprio(0);
#undef A3_RD
#undef A2_PK
#else
    a3_pv2<0, KH>(o[0], o[1], vb, pf); a3_pv2<2, KH>(o[2], o[3], vb, pf);
#endif
}
__device__ __forceinline__ void attn_unit(Frame& F, const float* sinkl, int unit) {
    const int lane = F.lane, w = F.wave, r32 = lane & 31, hi = lane >> 5;
    const bf16* P = (const bf16*)(F.ws + WS_P); bf16* ATT = (bf16*)(F.ws + WS_ATT);
    LAS unsigned char* lds = F.lds;
    const bool lat = unit < 512;
    int b, kvh, t0;
    if (lat) { b = unit >> 8; kvh = (unit >> 7) & 1; t0 = (unit & 127) * 64; } else { const int u = unit - 512; b = u >> 3; kvh = (u >> 2) & 1; t0 = (u & 3) * 64; }
    const int hh = kvh * 4 + (w >> 1), qlo = t0 + 32 * (w & 1), qt = qlo + r32;
    const size_t mq = lat ? (size_t)b * SEQ + qt : (size_t)ML + b * CTX + qt;
    const int ti_lo = lat ? (t0 >= 128 ? 0 : (128 - t0) >> 6) : 0, ti_hi = lat ? ((SEQ + 128 - t0) >> 6 < 5 ? (SEQ + 128 - t0) >> 6 : 5) : 0;
    const int nl = ti_hi - ti_lo, NT = nl + 4;
    const int ks0 = t0 - 128 + 64 * ti_lo;
    const int wrow0 = b * SEQ + ks0, crow0 = ML + b * CTX;
    const bf16* Pt = P + kvh * HD;
    unsigned voffV[2], voffK[2];
#pragma unroll
    for (int i = 0; i < 2; ++i) { const int p = (w * 2 + i) * 64 + lane;
        voffV[i] = (unsigned)((((p >> 7) * 8 + ((p >> 2) & 7)) * INC + ((p >> 5) & 3) * 32 + (p & 3) * 8) * 2);
        voffK[i] = (unsigned)(((p >> 4) * INC + ((p & 15) ^ ((p >> 4) & 7)) * 8) * 2); }
    const unsigned vb0 = (unsigned)(size_t)lds + (((lane & 3) << 3) | (((lane >> 2) & 3) << 6) | (((lane >> 4) & 1) << 5) | (((lane >> 5) & 1) << 8));
    const int kbase = r32 * 256 + ((16 * hi) ^ ((r32 & 7) << 4));
#define A3_ROW(n) ((n) < nl ? wrow0 + 64 * (n) : crow0 + 64 * ((n) - nl))
#define A3_DMA(n) do { const int q_ = (n) & 3; const char* tb_ = (const char*)(Pt + (size_t)A3_ROW(n) * INC); \
        _Pragma("unroll") for (int i_ = 0; i_ < 2; ++i_) { \
            __builtin_amdgcn_global_load_lds((const unsigned*)(tb_ + OFF_V * 2 + voffV[i_]), (LAS unsigned*)(lds + q_ * A3_BUF + (w * 2 + i_) * 1024), 16, 0, 0); \
            __builtin_amdgcn_global_load_lds((const unsigned*)(tb_ + OFF_K * 2 + voffK[i_]), (LAS unsigned*)(lds + q_ * A3_BUF + A3_K + (w * 2 + i_) * 1024), 16, 0, 0); } } while (0)
#define A3_KB(n, h) (ks0 + 64 * (n) + 32 * (h))
#define A3_MASKED(n, h) ((n) < nl && ((A3_KB(n, h) + 31 - qlo > WIN) || (qlo + 31 - A3_KB(n, h) > WIN)))
#define A3_PSM(p_, al_, n, h) a3_psm(p_, m_reg, al_, A3_MASKED(n, h), A3_KB(n, h) - qt, hi)
#define A3_RESC(al_) do { if (__builtin_amdgcn_ballot_w64((al_) < 1.f) != 0ull) { _Pragma("unroll") for (int d_ = 0; d_ < 4; ++d_) _Pragma("unroll") for (int r_ = 0; r_ < 16; ++r_) o[d_][r_] *= (al_); } } while (0)
#define A3_BAR() do { asm volatile("s_waitcnt lgkmcnt(0)" ::: "memory"); __builtin_amdgcn_s_barrier(); asm volatile("" ::: "memory"); } while (0)
    A3_BAR();
    bf16x8 qr[8];
    { const bf16* qp = P + mq * INC + OFF_Q + hh * HD + 8 * hi;
#pragma unroll
      for (int kk = 0; kk < 8; ++kk) qr[kk] = *(const bf16x8*)(qp + 16 * kk); }
    A3_DMA(0); A3_DMA(1);
    f32x16 o[4];
#pragma unroll
    for (int dt = 0; dt < 4; ++dt)
#pragma unroll
        for (int r = 0; r < 16; ++r) o[dt][r] = 0.f;
    float m_reg = sinkl[hh] * (1.f / A2_SCALE), l_reg = hi == 0 ? 1.f : 0.f;
    f32x16 pE, pO; float alE, alO; bf16x8 pf[2];
    asm volatile("s_waitcnt vmcnt(4)" ::: "memory"); A3_BAR();
    A3_DMA(2);
    a3_qk(pE, lds + A3_K, qr, kbase); A3_PSM(pE, alE, 0, 0);
    A3_SB(); a3_qk(pO, lds + A3_K + 8192, qr, kbase);
    a3_fsm(pE, alE, l_reg, pf); A3_SB();
    a3_pv<0>(o, vb0, pf); A3_PSM(pO, alO, 0, 1);
    A3_RESC(alO);
    for (int j = 1; j < NT; ++j) {
        if (j + 1 < NT) asm volatile("s_waitcnt vmcnt(4)" ::: "memory"); else asm volatile("s_waitcnt vmcnt(0)" ::: "memory");
        A3_BAR();
        if (!A3_LATEDMA && j + 2 < NT) A3_DMA(j + 2);
        const int bc = (j & 3) * A3_BUF, bp = ((j - 1) & 3) * A3_BUF;
        A3_SB(); a3_qk(pE, lds + bc + A3_K, qr, kbase);
        a3_fsm(pO, alO, l_reg, pf); A3_SB();
        if (A3_LATEDMA && j + 2 < NT) A3_DMA(j + 2);
        a3_pv<1>(o, vb0 + bp, pf); A3_PSM(pE, alE, j, 0);
        A3_RESC(alE);
        A3_SB(); a3_qk(pO, lds + bc + A3_K + 8192, qr, kbase);
        a3_fsm(pE, alE, l_reg, pf); A3_SB();
        a3_pv<0>(o, vb0 + bc, pf); A3_PSM(pO, alO, j, 1);
        A3_RESC(alO);
    }
    a3_fsm(pO, alO, l_reg, pf); A3_SB();
    a3_pv<1>(o, vb0 + ((NT - 1) & 3) * A3_BUF, pf);
#undef A3_ROW
#undef A3_BAR
#undef A3_DMA
#undef A3_KB
#undef A3_MASKED
#undef A3_PSM
#undef A3_RESC
    const float ltot = l_reg + bperm(l_reg, lane ^ 32), inv = 1.f / ltot;
    bf16* op = ATT + mq * D + hh * HD + 4 * hi;
#pragma unroll
    for (int dt = 0; dt < 4; ++dt)
#pragma unroll
        for (int rg = 0; rg < 4; ++rg) { u32x2 wv; wv.x = pk2(o[dt][4 * rg] * inv, o[dt][4 * rg + 1] * inv); wv.y = pk2(o[dt][4 * rg + 2] * inv, o[dt][4 * rg + 3] * inv);
            st8w<2>(op + 32 * dt + 8 * rg, wv); }
}

struct A3U { int lat, b, kvh, t0, nl, NT, ks0, wrow0, crow0; };
__device__ __forceinline__ A3U a3_decode(int unit) {
    A3U u; u.lat = unit < 512 ? 1 : 0;
    if (u.lat) { u.b = unit >> 8; u.kvh = (unit >> 7) & 1; u.t0 = (unit & 127) * 64; } else { const int x = unit - 512; u.b = x >> 3; u.kvh = (x >> 2) & 1; u.t0 = (x & 3) * 64; }
    const int ti_lo = u.lat ? (u.t0 >= 128 ? 0 : (128 - u.t0) >> 6) : 0, ti_hi = u.lat ? ((SEQ + 128 - u.t0) >> 6 < 5 ? (SEQ + 128 - u.t0) >> 6 : 5) : 0;
    u.nl = ti_hi - ti_lo; u.NT = u.nl + 4; u.ks0 = u.t0 - 128 + 64 * ti_lo; u.wrow0 = u.b * SEQ + u.ks0; u.crow0 = ML + u.b * CTX; return u;
}
__device__ __forceinline__ void attn_stream(Frame& F, const float* sinkl, int u_first, int u_stride, int n_lat, int u_extra) {
    const int nU = n_lat + (u_extra >= 0 ? 1 : 0);
    if (nU <= 0) return;
    const int lane = F.lane, w = F.wave, r32 = lane & 31, hi = lane >> 5;
    const bf16* P = (const bf16*)(F.ws + WS_P); bf16* ATT = (bf16*)(F.ws + WS_ATT);
    LAS unsigned char* lds = F.lds;
    unsigned voffV[2], voffK[2];
#pragma unroll
    for (int i = 0; i < 2; ++i) { const int p = (w * 2 + i) * 64 + lane;
        voffV[i] = (unsigned)((((p >> 7) * 8 + ((p >> 2) & 7)) * INC + ((p >> 5) & 3) * 32 + (p & 3) * 8) * 2);
        voffK[i] = (unsigned)(((p >> 4) * INC + ((p & 15) ^ ((p >> 4) & 7)) * 8) * 2); }
    const unsigned vb0 = (unsigned)(size_t)lds + (((lane & 3) << 3) | (((lane >> 2) & 3) << 6) | (((lane >> 4) & 1) << 5) | (((lane >> 5) & 1) << 8));
    const int kbase = r32 * 256 + ((16 * hi) ^ ((r32 & 7) << 4));
#define A3S_UNIT(i) ((i) < n_lat ? u_first + (i) * u_stride : u_extra)
#define A3S_ROW(U, n) ((n) < U.nl ? U.wrow0 + 64 * (n) : U.crow0 + 64 * ((n) - U.nl))
#define A3S_DMA(U, n, ring) do { const int q_ = (ring) & 3; const char* tb_ = (const char*)(P + U.kvh * HD + (size_t)A3S_ROW(U, n) * INC); \
        _Pragma("unroll") for (int i_ = 0; i_ < 2; ++i_) { \
            __builtin_amdgcn_global_load_lds((const unsigned*)(tb_ + OFF_V * 2 + voffV[i_]), (LAS unsigned*)(lds + q_ * A3_BUF + (w * 2 + i_) * 1024), 16, 0, 0); \
            __builtin_amdgcn_global_load_lds((const unsigned*)(tb_ + OFF_K * 2 + voffK[i_]), (LAS unsigned*)(lds + q_ * A3_BUF + A3_K + (w * 2 + i_) * 1024), 16, 0, 0); } } while (0)
#define A3S_QLOAD(U) do { const int hh_ = U.kvh * 4 + (w >> 1), qt_ = U.t0 + 32 * (w & 1) + r32; const size_t mq_ = U.lat ? (size_t)U.b * SEQ + qt_ : (size_t)ML + U.b * CTX + qt_; \
        const bf16* qp_ = P + mq_ * INC + OFF_Q + hh_ * HD + 8 * hi; _Pragma("unroll") for (int kk_ = 0; kk_ < 8; ++kk_) qr[kk_] = *(const bf16x8*)(qp_ + 16 * kk_); } while (0)
#define A3_KB(n, h) (cu.ks0 + 64 * (n) + 32 * (h))
#define A3_MASKED(n, h) ((n) < cu.nl && ((A3_KB(n, h) + 31 - qlo > WIN) || (qlo + 31 - A3_KB(n, h) > WIN)))
#define A3_PSM(p_, al_, n, h) a3_psm(p_, m_reg, al_, A3_MASKED(n, h), A3_KB(n, h) - qt, hi)
#define A3_RESC(al_) do { if (__builtin_amdgcn_ballot_w64((al_) < 1.f) != 0ull) { _Pragma("unroll") for (int d_ = 0; d_ < 4; ++d_) _Pragma("unroll") for (int r_ = 0; r_ < 16; ++r_) o[d_][r_] *= (al_); } } while (0)
#define A3_BAR() do { asm volatile("s_waitcnt lgkmcnt(0)" ::: "memory"); __builtin_amdgcn_s_barrier(); asm volatile("" ::: "memory"); } while (0)
    A3U cu = a3_decode(A3S_UNIT(0)); int rb = 0;
    A3_BAR();
    bf16x8 qr[8];
    A3S_QLOAD(cu);
    A3S_DMA(cu, 0, 0); A3S_DMA(cu, 1, 1);
    for (int ui = 0; ui < nU; ++ui) {
        const bool has_next = ui + 1 < nU;
        const A3U nx = a3_decode(A3S_UNIT(has_next ? ui + 1 : ui));
        const int NT = cu.NT;
        const int hh = cu.kvh * 4 + (w >> 1), qlo = cu.t0 + 32 * (w & 1), qt = qlo + r32;
        const size_t mq = cu.lat ? (size_t)cu.b * SEQ + qt : (size_t)ML + cu.b * CTX + qt;
        f32x16 o[4];
#pragma unroll
        for (int dt = 0; dt < 4; ++dt)
#pragma unroll
            for (int r = 0; r < 16; ++r) o[dt][r] = 0.f;
        float m_reg = sinkl[hh] * (1.f / A2_SCALE), l_reg = hi == 0 ? 1.f : 0.f;
        f32x16 pE, pO; float alE, alO; bf16x8 pf[2];
        if (ui == 0) asm volatile("s_waitcnt vmcnt(4)" ::: "memory");
        A3_BAR();
        A3S_DMA(cu, 2, rb + 2);
        { const int b0 = (rb & 3) * A3_BUF;
          a3_qk(pE, lds + b0 + A3_K, qr, kbase); A3_PSM(pE, alE, 0, 0);
          A3_SB(); a3_qk(pO, lds + b0 + A3_K + 8192, qr, kbase);
          a3_fsm(pE, alE, l_reg, pf); A3_SB();
          a3_pv<0>(o, vb0 + b0, pf); A3_PSM(pO, alO, 0, 1);
          A3_RESC(alO); }
        for (int j = 1; j < NT; ++j) {
            if (j + 1 < NT || has_next) asm volatile("s_waitcnt vmcnt(4)" ::: "memory"); else asm volatile("s_waitcnt vmcnt(0)" ::: "memory");
            A3_BAR();
            const int bc = ((rb + j) & 3) * A3_BUF, bp = ((rb + j - 1) & 3) * A3_BUF;
            A3_SB(); a3_qk(pE, lds + bc + A3_K, qr, kbase);
            a3_fsm(pO, alO, l_reg, pf); A3_SB();
            if (j + 2 < NT) A3S_DMA(cu, j + 2, rb + j + 2); else if (has_next) A3S_DMA(nx, j + 2 - NT, rb + j + 2);
            a3_pv<1>(o, vb0 + bp, pf); A3_PSM(pE, alE, j, 0);
            A3_RESC(alE);
            A3_SB(); a3_qk(pO, lds + bc + A3_K + 8192, qr, kbase);
            if (j == NT - 1 && has_next) A3S_QLOAD(nx);
            a3_fsm(pE, alE, l_reg, pf); A3_SB();
            a3_pv<0>(o, vb0 + bc, pf); A3_PSM(pO, alO, j, 1);
            A3_RESC(alO);
        }
        a3_fsm(pO, alO, l_reg, pf); A3_SB();
        a3_pv<1>(o, vb0 + ((rb + NT - 1) & 3) * A3_BUF, pf);
        const float ltot = l_reg + bperm(l_reg, lane ^ 32), inv = 1.f / ltot;
        bf16* op = ATT + mq * D + hh * HD + 4 * hi;
#pragma unroll
        for (int dt = 0; dt < 4; ++dt)
#pragma unroll
            for (int rg = 0; rg < 4; ++rg) { u32x2 wv; wv.x = pk2(o[dt][4 * rg] * inv, o[dt][4 * rg + 1] * inv); wv.y = pk2(o[dt][4 * rg + 2] * inv, o[dt][4 * rg + 3] * inv);
                st8w<2>(op + 32 * dt + 8 * rg, wv); }
        if (has_next) asm volatile("" : "+v"(qr[0]), "+v"(qr[1]), "+v"(qr[2]), "+v"(qr[3]), "+v"(qr[4]), "+v"(qr[5]), "+v"(qr[6]), "+v"(qr[7]) :: "memory");
        rb += NT; cu = nx;
    }
#undef A3S_UNIT
#undef A3S_ROW
#undef A3S_DMA
#undef A3S_QLOAD
#undef A3_KB
#undef A3_MASKED
#undef A3_PSM
#undef A3_RESC
#undef A3_BAR
}
#else
#ifndef ADUP
#define ADUP 0
#endif
constexpr int AT_K = 0, AT_KSTR = 272, AT_V = 64 * AT_KSTR, AT_VSTR = 144, AT_BUF = 64 * 272 + 128 * 144;
__device__ __forceinline__ void attn_unit(Frame& F, const float* sinkl, int unit) {
    const int tid = F.tid, lane = F.lane, w = F.wave, l31 = lane & 31, h5 = lane >> 5;
    const bf16* P = (const bf16*)(F.ws + WS_P); bf16* ATT = (bf16*)(F.ws + WS_ATT);
    LAS unsigned char* lds = F.lds;
    const bool lat = unit < 512;
    int b, kvh, t0;
    if (lat) { b = unit >> 8; kvh = (unit >> 7) & 1; t0 = (unit & 127) * 64; } else { const int u = unit - 512; b = u >> 3; kvh = (u >> 2) & 1; t0 = (u & 3) * 64; }
    const int hh = kvh * 4 + (w >> 1), qlo = t0 + 32 * (w & 1), qt = qlo + l31;
    const size_t mq = lat ? (size_t)b * SEQ + qt : (size_t)ML + b * CTX + qt;
    bf16x8 qf[8];
    { const bf16* qp = P + mq * INC + OFF_Q + hh * HD + 8 * h5;
#pragma unroll
      for (int kk = 0; kk < 8; ++kk) qf[kk] = *(const bf16x8*)(qp + 16 * kk); }
    f32x16 o[4];
#pragma unroll
    for (int dt = 0; dt < 4; ++dt)
#pragma unroll
        for (int r = 0; r < 16; ++r) o[dt][r] = 0.f;
    const float c2 = 0.08838834764831845f * 1.4426950408889634f;
    float mrun = sinkl[hh] * 1.4426950408889634f, lrun = h5 == 0 ? 1.f : 0.f;
    const int ti_lo = lat ? (t0 >= 128 ? 0 : (128 - t0) >> 6) : 0, ti_hi = lat ? ((SEQ + 128 - t0) >> 6 < 5 ? (SEQ + 128 - t0) >> 6 : 5) : 0;
    const int nl = ti_hi - ti_lo, ntiles = nl + 4;
    u32x4 kreg[2], vreg[2];
#define AT_LOAD(n) do { const int ti_ = (n) < nl ? ti_lo + (n) : (n) - nl; const bool il_ = (n) < nl; const int ks_ = il_ ? t0 - 128 + 64 * ti_ : 64 * ti_; \
        const size_t kr_ = il_ ? (size_t)b * SEQ + ks_ : (size_t)ML + b * CTX + ks_; \
        _Pragma("unroll") for (int p = 0; p < 2; ++p) { const int idx = tid + 512 * p; \
            kreg[p] = *(const u32x4*)(P + (kr_ + (idx >> 4)) * INC + OFF_K + kvh * HD + 8 * (idx & 15)); \
            vreg[p] = *(const u32x4*)(P + (kr_ + (idx & 63)) * INC + OFF_V + kvh * HD + 8 * (idx >> 6)); } } while (0)
#define AT_STORE(bufo) do { _Pragma("unroll") for (int p = 0; p < 2; ++p) { const int idx = tid + 512 * p; \
            *(LAS u32x4*)(lds + (bufo) + AT_K + (idx >> 4) * AT_KSTR + (idx & 15) * 16) = kreg[p]; \
            const int key = idx & 63, c = idx >> 6; const int pos = (key & 0x33) | ((key & 4) << 1) | ((key & 8) >> 1); const u32x4 v = vreg[p]; \
            LAS unsigned char* d = lds + (bufo) + AT_V + (8 * c) * AT_VSTR + 2 * pos; \
            *(LAS unsigned short*)(d + 0 * AT_VSTR) = (unsigned short)(v.x & 0xffff); *(LAS unsigned short*)(d + 1 * AT_VSTR) = (unsigned short)(v.x >> 16); \
            *(LAS unsigned short*)(d + 2 * AT_VSTR) = (unsigned short)(v.y & 0xffff); *(LAS unsigned short*)(d + 3 * AT_VSTR) = (unsigned short)(v.y >> 16); \
            *(LAS unsigned short*)(d + 4 * AT_VSTR) = (unsigned short)(v.z & 0xffff); *(LAS unsigned short*)(d + 5 * AT_VSTR) = (unsigned short)(v.z >> 16); \
            *(LAS unsigned short*)(d + 6 * AT_VSTR) = (unsigned short)(v.w & 0xffff); *(LAS unsigned short*)(d + 7 * AT_VSTR) = (unsigned short)(v.w >> 16); } } while (0)
    __syncthreads();
    AT_LOAD(0); AT_STORE(0); AT_LOAD(1);
    for (int n = 0; n < ntiles; ++n) {
        const int ti = n < nl ? ti_lo + n : n - nl; const bool islat = n < nl; const int ks = islat ? t0 - 128 + 64 * ti : 64 * ti;
        const int bo = (n & 1) * AT_BUF;
        __syncthreads();
        f32x16 s0, s1;
        for (int rs_ = 0; rs_ < ((ADUP & 2) ? 2 : 1); ++rs_) {
        if (ADUP & 2) asm volatile("" ::: "memory");
#pragma unroll
        for (int r = 0; r < 16; ++r) { s0[r] = 0.f; s1[r] = 0.f; }
        {
            const LAS unsigned char* kb0 = lds + bo + AT_K + l31 * AT_KSTR + 16 * h5;
            bf16x8 ka[2][2];
#pragma unroll
            for (int hb = 0; hb < 4; ++hb) {
#pragma unroll
                for (int kk = 0; kk < 2; ++kk) { ka[kk][0] = *(const LAS bf16x8*)(kb0 + 32 * (kk + 2 * hb)); ka[kk][1] = *(const LAS bf16x8*)(kb0 + 32 * AT_KSTR + 32 * (kk + 2 * hb)); }
#pragma unroll
                for (int kk = 0; kk < 2; ++kk) { s0 = __builtin_amdgcn_mfma_f32_32x32x16_bf16(ka[kk][0], qf[kk + 2 * hb], s0, 0, 0, 0); s1 = __builtin_amdgcn_mfma_f32_32x32x16_bf16(ka[kk][1], qf[kk + 2 * hb], s1, 0, 0, 0); }
            }
        }
        }
        if (n + 1 < ntiles) { AT_STORE(AT_BUF - bo); if (ADUP & 1) { asm volatile("" ::: "memory"); AT_STORE(AT_BUF - bo); } if (n + 2 < ntiles) AT_LOAD(n + 2); }
        const LAS unsigned char* vb0 = lds + bo + AT_V + l31 * AT_VSTR + 16 * h5;
        bf16x8 vf0[4], vf1[4];
#pragma unroll
        for (int ss = 0; ss < 4; ++ss) { vf0[ss] = *(const LAS bf16x8*)(vb0 + 32 * ss); vf1[ss] = *(const LAS bf16x8*)(vb0 + 32 * AT_VSTR + 32 * ss); }
        const bool need_mask = islat && ((ks + 63 - qlo > WIN) || (qlo + 31 - ks > WIN));
        float mt = -INFINITY;
#pragma unroll
        for (int r = 0; r < 16; ++r) {
            float a0 = s0[r] * c2, a1 = s1[r] * c2;
            if (need_mask) { const int kp = ks + (r & 3) + 8 * (r >> 2) + 4 * h5; const int d0 = kp - qt, d1 = kp + 32 - qt;
                if (d0 > WIN || d0 < -WIN) a0 = -INFINITY; if (d1 > WIN || d1 < -WIN) a1 = -INFINITY; }
            s0[r] = a0; s1[r] = a1; mt = fmaxf(mt, fmaxf(a0, a1));
        }
        mt = fmaxf(mt, bperm(mt, lane ^ 32));
        if (__builtin_amdgcn_ballot_w64(mt > mrun + 8.f) != 0ull) {
            const float mnew = fmaxf(mrun, mt), alpha = __builtin_amdgcn_exp2f(mrun - mnew);
            lrun *= alpha; mrun = mnew;
#pragma unroll
            for (int dt = 0; dt < 4; ++dt)
#pragma unroll
                for (int r = 0; r < 16; ++r) o[dt][r] *= alpha;
        }
        if (ADUP & 4) { float dm = 0.f;
#pragma unroll
            for (int r = 0; r < 16; r += 2) { float u0 = s0[r], u1 = s0[r + 1], u2 = s1[r], u3 = s1[r + 1]; asm volatile("" : "+v"(u0), "+v"(u1), "+v"(u2), "+v"(u3));
                dm += (__builtin_amdgcn_exp2f(u0 - mrun) + __builtin_amdgcn_exp2f(u1 - mrun)) + (__builtin_amdgcn_exp2f(u2 - mrun) + __builtin_amdgcn_exp2f(u3 - mrun)); }
            lrun += 0.f * dm; }
        float psum = 0.f;
#pragma unroll
        for (int r = 0; r < 16; ++r) { s0[r] = __builtin_amdgcn_exp2f(s0[r] - mrun); s1[r] = __builtin_amdgcn_exp2f(s1[r] - mrun); psum += s0[r] + s1[r]; }
        lrun += psum;
        const float PH_ = (ADUP & 8) ? 0.5f : 1.f;
        bf16x8 pf[4];
#pragma unroll
        for (int s = 0; s < 2; ++s) {
            u32x4 x0, x1;
            x0.x = pk2(PH_ * s0[8 * s + 0], PH_ * s0[8 * s + 1]); x0.y = pk2(PH_ * s0[8 * s + 2], PH_ * s0[8 * s + 3]); x0.z = pk2(PH_ * s0[8 * s + 4], PH_ * s0[8 * s + 5]); x0.w = pk2(PH_ * s0[8 * s + 6], PH_ * s0[8 * s + 7]);
            x1.x = pk2(PH_ * s1[8 * s + 0], PH_ * s1[8 * s + 1]); x1.y = pk2(PH_ * s1[8 * s + 2], PH_ * s1[8 * s + 3]); x1.z = pk2(PH_ * s1[8 * s + 4], PH_ * s1[8 * s + 5]); x1.w = pk2(PH_ * s1[8 * s + 6], PH_ * s1[8 * s + 7]);
            pf[s] = __builtin_bit_cast(bf16x8, x0); pf[2 + s] = __builtin_bit_cast(bf16x8, x1);
        }
        for (int rp_ = 0; rp_ < ((ADUP & 8) ? 2 : 1); ++rp_) {
        if (ADUP & 8) { asm volatile("" ::: "memory");
#pragma unroll
            for (int ss = 0; ss < 4; ++ss) { vf0[ss] = *(const LAS bf16x8*)(vb0 + 32 * ss); vf1[ss] = *(const LAS bf16x8*)(vb0 + 32 * AT_VSTR + 32 * ss); } }
#pragma unroll
        for (int ss = 0; ss < 4; ++ss) o[0] = __builtin_amdgcn_mfma_f32_32x32x16_bf16(vf0[ss], pf[ss], o[0], 0, 0, 0);
#pragma unroll
        for (int ss = 0; ss < 4; ++ss) vf0[ss] = *(const LAS bf16x8*)(vb0 + 64 * AT_VSTR + 32 * ss);
#pragma unroll
        for (int ss = 0; ss < 4; ++ss) o[1] = __builtin_amdgcn_mfma_f32_32x32x16_bf16(vf1[ss], pf[ss], o[1], 0, 0, 0);
#pragma unroll
        for (int ss = 0; ss < 4; ++ss) vf1[ss] = *(const LAS bf16x8*)(vb0 + 96 * AT_VSTR + 32 * ss);
#pragma unroll
        for (int ss = 0; ss < 4; ++ss) o[2] = __builtin_amdgcn_mfma_f32_32x32x16_bf16(vf0[ss], pf[ss], o[2], 0, 0, 0);
#pragma unroll
        for (int ss = 0; ss < 4; ++ss) o[3] = __builtin_amdgcn_mfma_f32_32x32x16_bf16(vf1[ss], pf[ss], o[3], 0, 0, 0);
        }
    }
#undef AT_LOAD
#undef AT_STORE
    const float ltot = lrun + bperm(lrun, lane ^ 32), inv = 1.f / ltot;
    bf16* op = ATT + mq * D + hh * HD + 4 * h5;
#pragma unroll
    for (int dt = 0; dt < 4; ++dt)
#pragma unroll
        for (int rg = 0; rg < 4; ++rg) { u32x2 wv; wv.x = pk2(o[dt][4 * rg] * inv, o[dt][4 * rg + 1] * inv); wv.y = pk2(o[dt][4 * rg + 2] * inv, o[dt][4 * rg + 3] * inv);
            *(u32x2*)(op + 32 * dt + 8 * rg) = wv; }
}

#endif
constexpr int SC_X = 0, SC_Y = 17408, SC_O = 34816, SC_STR = 272, SC_CW = 52224  , SC_PRM = SC_CW + 2560  ;
__device__ __forceinline__ int sc_rho(int t) { return (t & 3) | (((t >> 4) & 3) << 2) | (((t >> 2) & 3) << 4); }
struct ScanPref { u32x4 x[5]; };
__device__ __forceinline__ void scan_prefetch(ScanPref& pf, const bf16* P, int c, int h, int tid) {
    const int m0 = 64 * c, ch8 = tid & 15, cb = 128 * h + 8 * ch8, t0 = 2 * (tid >> 4);
    int seq_lo, seq_hi;
    if (c < 256) { seq_lo = (c >> 7) * SEQ; seq_hi = seq_lo + SEQ; } else { seq_lo = ML + ((c - 256) >> 2) * CTX; seq_hi = seq_lo + CTX; }
#pragma unroll
    for (int j = 0; j < 5; ++j) { const int mr = m0 + t0 + j - 2; pf.x[j] = (u32x4){0u, 0u, 0u, 0u};
        if (mr >= seq_lo && mr < seq_hi) pf.x[j] = *(const u32x4*)(P + (size_t)mr * INC + OFF_X + cb); }
}
#ifndef S2_ROT
#define S2_ROT 0
#endif
#ifndef S2_REV
#define S2_REV 1
#endif
#ifndef SC1_ONEBAR
#define SC1_ONEBAR 0
#endif
#ifndef SCAB_NT
#define SCAB_NT 0
#endif
#ifndef SC1_LDSTAB
#define SC1_LDSTAB 0
#endif
#ifndef SC1_VM
#define SC1_VM "0"
#endif
__device__ __forceinline__ void scan_unit(Frame& F, const Args& a, int l, int c, int cn, int h, ScanPref& pf, const bf16x8 (&bfr)[4][4], int par) {
    const int tid = F.tid, lane = F.lane, w = F.wave, l15 = lane & 15, g = lane >> 4;
    unsigned char* ws = F.ws; LAS unsigned char* lds = F.lds + par * 17408;
    const bf16* P = (const bf16*)(ws + WS_P);
    asm volatile("s_waitcnt vmcnt(" SC1_VM ")" : "+v"(pf.x[0]), "+v"(pf.x[1]), "+v"(pf.x[2]), "+v"(pf.x[3]), "+v"(pf.x[4]) :: "memory");
    const int chl = 16 * w + l15, ch = 128 * h + chl;
#if SC1_LDSTAB
    const f32x4 prm0 = ((const LAS f32x4*)(F.lds + SC_PRM))[chl], prm1 = ((const LAS f32x4*)(F.lds + SC_PRM))[128 + chl];
#else
    const f32x4* SPT = (const f32x4*)(ws + WS_SPT);
    const f32x4 prm0 = SPT[((size_t)l * 2 + 0) * D + ch], prm1 = SPT[((size_t)l * 2 + 1) * D + ch];
#endif
    {
        const int ch8 = tid & 15; const int cb = 128 * h + 8 * ch8;
        const float* cw = (a.in[10] + F.zo) + (size_t)l * 4 * D + cb; const float* cbp = (a.in[11] + F.zo) + l * D + cb;
        f32x4 w4[4][2];
#if SC1_LDSTAB
        const LAS float* cwt = (const LAS float*)(F.lds + SC_CW) + 8 * ch8; (void)cw; (void)cbp;
#pragma unroll
        for (int j = 0; j < 4; ++j) { w4[j][0] = *(const LAS f32x4*)(cwt + j * 128); w4[j][1] = *(const LAS f32x4*)(cwt + j * 128 + 4); }
        const f32x4 b0 = *(const LAS f32x4*)(cwt + 4 * 128), b1 = *(const LAS f32x4*)(cwt + 4 * 128 + 4);
#else
#pragma unroll
        for (int j = 0; j < 4; ++j) { w4[j][0] = *(const f32x4*)(cw + j * D); w4[j][1] = *(const f32x4*)(cw + j * D + 4); }
        const f32x4 b0 = *(const f32x4*)(cbp), b1 = *(const f32x4*)(cbp + 4);
#endif
#pragma unroll
        for (int i = 0; i < 2; ++i) { const int t = 2 * (tid >> 4) + i, row = sc_rho(t);
            f32x4 a0 = b0, a1 = b1;
#pragma unroll
            for (int j = 0; j < 4; ++j) { const u32x4 xv = pf.x[i + j];
                a0[0] += bflo(xv.x) * w4[j][0][0]; a0[1] += bfhi(xv.x) * w4[j][0][1]; a0[2] += bflo(xv.y) * w4[j][0][2]; a0[3] += bfhi(xv.y) * w4[j][0][3];
                a1[0] += bflo(xv.z) * w4[j][1][0]; a1[1] += bfhi(xv.z) * w4[j][1][1]; a1[2] += bflo(xv.w) * w4[j][1][2]; a1[3] += bfhi(xv.w) * w4[j][1][3]; }
            u32x4 o; o.x = pk2(a0[0], a0[1]); o.y = pk2(a0[2], a0[3]); o.z = pk2(a1[0], a1[1]); o.w = pk2(a1[2], a1[3]);
            *(LAS u32x4*)(lds + SC_X + row * SC_STR + ch8 * 16) = o;
        }
    }
    __syncthreads();
    if (cn >= 0) scan_prefetch(pf, P, cn, h, tid);
    f32x4 acc[4][4];
#pragma unroll
    for (int mt = 0; mt < 4; ++mt) {
        acc[mt][0] = (f32x4){prm0[0], prm0[0], prm0[0], prm0[0]}; acc[mt][1] = (f32x4){prm0[1], prm0[1], prm0[1], prm0[1]};
        acc[mt][2] = (f32x4){prm1[0], prm1[0], prm1[0], prm1[0]}; acc[mt][3] = (f32x4){prm1[1], prm1[1], prm1[1], prm1[1]}; }
#pragma unroll
    for (int kk = 0; kk < 4; ++kk) {
#pragma unroll
        for (int mt = 0; mt < 4; ++mt) { const bf16x8 af = *(const LAS bf16x8*)(lds + SC_X + (16 * mt + l15) * SC_STR + (32 * kk + 8 * g) * 2);
#pragma unroll
            for (int gt = 0; gt < 4; ++gt) acc[mt][gt] = __builtin_amdgcn_mfma_f32_16x16x32_bf16(af, bfr[kk][gt], acc[mt][gt], 0, 0, 0); }
    }
    float xv[16];
#pragma unroll
    for (int k = 0; k < 16; ++k) { const int row = 16 * (k >> 2) + 4 * g + (k & 3); xv[k] = bf2f(*(const LAS bf16*)(lds + SC_X + row * SC_STR + chl * 2)); }
    float* AGG_A = (float*)(ws + WS_AGG); float* AGG_B = (float*)(ws + WS_AGG + AGG_BYTES);
    u32x4* blk = (u32x4*)(ws + WS_SCAB) + ((size_t)((c * 8 + h) * 8 + w) * 8) * 64 + lane;
#pragma unroll
    for (int d = 0; d < 2; ++d) {
        const f32x4 prm = d == 0 ? prm0 : prm1;
        float av[16], bv[16];
#pragma unroll
        for (int k = 0; k < 16; ++k) {
            const float rg = __builtin_amdgcn_rcpf(1.f + __builtin_amdgcn_exp2f(acc[k >> 2][2 * d][k & 3])), ig = __builtin_amdgcn_rcpf(1.f + __builtin_amdgcn_exp2f(acc[k >> 2][2 * d + 1][k & 3]));
            const float aa = __builtin_amdgcn_exp2f(prm[2] * rg);
            av[k] = aa; bv[k] = __builtin_amdgcn_sqrtf(__builtin_fmaf(-aa, aa, 1.f)) * (ig * xv[k]);
        }
#pragma unroll
        for (int hf = 0; hf < 2; ++hf) { u32x4 pa, pb;
            pa.x = pk2(1.f - av[8 * hf + 0], 1.f - av[8 * hf + 1]); pa.y = pk2(1.f - av[8 * hf + 2], 1.f - av[8 * hf + 3]); pa.z = pk2(1.f - av[8 * hf + 4], 1.f - av[8 * hf + 5]); pa.w = pk2(1.f - av[8 * hf + 6], 1.f - av[8 * hf + 7]);
            pb.x = pk2(bv[8 * hf + 0], bv[8 * hf + 1]); pb.y = pk2(bv[8 * hf + 2], bv[8 * hf + 3]); pb.z = pk2(bv[8 * hf + 4], bv[8 * hf + 5]); pb.w = pk2(bv[8 * hf + 6], bv[8 * hf + 7]);
            if (SCAB_NT) { __builtin_nontemporal_store(pa, blk + (4 * d + hf) * 64); __builtin_nontemporal_store(pb, blk + (4 * d + 2 + hf) * 64); } else { st16w<1>(blk + (4 * d + hf) * 64, pa); st16w<1>(blk + (4 * d + 2 + hf) * 64, pb); } }
        const size_t ao = ((size_t)d * NCHUNK + c) * D + ch;
        float As = 1.f, Bs = 0.f;
#pragma unroll
        for (int i = 0; i < 16; ++i) { const int k = d == 0 ? i : 15 - i; Bs = av[k] * Bs + bv[k]; As = av[k] * As; }
        const int gi = d == 0 ? g : 3 - g;
        const int p1 = (d == 0 ? lane - 16 : lane + 16) & 63, p2 = (d == 0 ? lane - 32 : lane + 32) & 63;
        float Ai = As, Bi = Bs;
        { const float A1 = bperm(Ai, p1), B1 = bperm(Bi, p1); if (gi >= 1) { Bi = Ai * B1 + Bi; Ai = Ai * A1; } }
        { const float A2 = bperm(Ai, p2), B2 = bperm(Bi, p2); if (gi >= 2) { Bi = Ai * B2 + Bi; Ai = Ai * A2; } }
        if (gi == 3) { AGG_A[ao] = Ai; AGG_B[ao] = Bi; }
    }
#if !SC1_ONEBAR
    __syncthreads();
#endif
}
#ifndef SC1_REBAL
#define SC1_REBAL 1
#endif
#ifndef CARRY_PF
#define CARRY_PF 1
#endif
#ifndef LOCMAP
#define LOCMAP 0
#endif
__device__ __forceinline__ int sc_first(int j) { return (33 * j) >> 2; }
__device__ __forceinline__ int sc1_chunk(int v, int k, int G, bool rebal) {
    const int cs = G >> 3, base = v >> 3;
    if ((LOCMAP & 2) && G == 256) {
        const int j = base, c0 = sc_first(j), n = sc_first(j + 1) - c0;
        if (rebal) {
            if (j == 28 || j == 29) return k < 6 ? c0 + k : -1;
            if ((j <= 2 || j == 4) && k == 8) { const int r = j == 4 ? 3 : j; return sc_first(28 + (r & 1)) + 6 + (r >> 1); }
        }
        return k < n ? c0 + k : -1;
    }
    if (rebal) {
        if (v >= 240) return k < 6 ? base + 32 * k : -1;
        if (v >= 64 && v < 96 && k == 8) { const int idx = v - 64, src = 240 + (idx & 7) + 8 * ((idx >> 3) & 1), kd = 6 + (idx >> 4); return (src >> 3) + 32 * kd; }
    }
    const int c = base + cs * k; return c < NCHUNK ? c : -1;
}
__device__ __forceinline__ void ph_scan1(Frame& F, const Args& a, int l, bool rebal = false) {
    const int h = F.vcu & 7; int k = 0; int c = sc1_chunk(F.vcu, 0, F.G, rebal);
    if (c < 0) return;
    ScanPref pf; scan_prefetch(pf, (const bf16*)(F.ws + WS_P), c, h, F.tid);
    bf16x8 bfr[4][4];
    { const bf16* Wt = (const bf16*)(F.ws + WS_GT) + (size_t)(l * 8 + h) * 4 * 128 * 128 + (size_t)(16 * F.wave + (F.lane & 15)) * 128 + 8 * (F.lane >> 4);
#pragma unroll
      for (int kk = 0; kk < 4; ++kk)
#pragma unroll
        for (int gt = 0; gt < 4; ++gt) bfr[kk][gt] = *(const bf16x8*)(Wt + gt * 128 * 128 + 32 * kk); }
#if SC1_LDSTAB
    {
        LAS float* cwt = (LAS float*)(F.lds + SC_CW); LAS f32x4* prt = (LAS f32x4*)(F.lds + SC_PRM);
        for (int i = F.tid; i < 5 * 128; i += NWAVES * 64) { const int j = i >> 7, cc = 128 * h + (i & 127); cwt[i] = j < 4 ? (a.in[10] + F.zo)[(size_t)l * 4 * D + j * D + cc] : (a.in[11] + F.zo)[l * D + cc]; }
        for (int i = F.tid; i < 256; i += NWAVES * 64) prt[i] = ((const f32x4*)(F.ws + WS_SPT))[((size_t)l * 2 + (i >> 7)) * D + 128 * h + (i & 127)];
        __syncthreads();
    }
#endif
    int par = 0;
    for (; c >= 0; ++k) { const int cn = sc1_chunk(F.vcu, k + 1, F.G, rebal); scan_unit(F, a, l, c, cn, h, pf, bfr, SC1_ONEBAR ? par : 0); par ^= 1; c = cn; }
    if (SC1_ONEBAR) __syncthreads();
}
__device__ __forceinline__ int sc2_chunk(int v, int k, int G) {
    if ((LOCMAP & 4) && G == 256) { const int j = v >> 3, c0 = sc_first(j), n = sc_first(j + 1) - c0; return k < n ? c0 + k : -1; }
    if (S2_ROT) { const int cs = G >> 3, base = v >> 3, n = (NCHUNK - base + cs - 1) / cs; if (k >= n) return -1; return base + cs * ((k + base) % n); }
    return sc1_chunk(v, k, G, false);
}
__device__ __forceinline__ void ph_scan2(Frame& F) {
    const int tid = F.tid, lane = F.lane, w = F.wave, l15 = lane & 15, g = lane >> 4;
    unsigned char* ws = F.ws; LAS unsigned char* lds = F.lds;
    const int h = F.vcu & 7, cs = F.G >> 3; const int chl = 16 * w + l15, ch = 128 * h + chl;
    const float* CARRY = (const float*)(ws + WS_AGG + 2 * AGG_BYTES); bf16* RECG = (bf16*)(ws + WS_RECG);
    int par = 0;
#define S2_LOAD(Q, Y, C0, C1, cc) do { const u32x4* blk_ = (const u32x4*)(ws + WS_SCAB) + ((size_t)(((cc) * 8 + h) * 8 + w) * 8) * 64 + lane; \
        _Pragma("unroll") for (int k_ = 0; k_ < 8; ++k_) Q[k_] = SCAB_NT ? __builtin_nontemporal_load(blk_ + k_ * 64) : blk_[k_ * 64]; \
        _Pragma("unroll") for (int i_ = 0; i_ < 2; ++i_) Y[i_] = *(const u32x4*)((const bf16*)(ws + WS_P) + (size_t)(64 * (cc) + (tid >> 4) + 32 * i_) * INC + OFF_Y + 128 * h + 8 * (tid & 15)); \
        C0 = CARRY[((size_t)0 * NCHUNK + (cc)) * D + ch]; C1 = CARRY[((size_t)1 * NCHUNK + (cc)) * D + ch]; } while (0)
#define S2_PIN(n, Q, Y, C0, C1) asm volatile("s_waitcnt vmcnt(" n ")" : "+v"(Q[0]), "+v"(Q[1]), "+v"(Q[2]), "+v"(Q[3]), "+v"(Q[4]), "+v"(Q[5]), "+v"(Q[6]), "+v"(Q[7]), "+v"(Y[0]), "+v"(Y[1]), "+v"(C0), "+v"(C1) :: "memory")
    int nk2 = 0; while (sc2_chunk(F.vcu, nk2, F.G) >= 0) ++nk2;
    int k2 = S2_REV ? nk2 - 1 : 0; int c = nk2 > 0 ? sc2_chunk(F.vcu, k2, F.G) : -1;
    if (c < 0) return;
    u32x4 q[8], yq[2]; float cin0, cin1;
    S2_LOAD(q, yq, cin0, cin1, c); S2_PIN("0", q, yq, cin0, cin1);
    for (;; par ^= 1) {
        const int cn = S2_REV ? (k2 > 0 ? sc2_chunk(F.vcu, --k2, F.G) : -1) : sc2_chunk(F.vcu, ++k2, F.G); const bool has = cn >= 0;
        u32x4 qn[8], yn[2]; float cn0 = 0.f, cn1 = 0.f;
        if (has) S2_LOAD(qn, yn, cn0, cn1, cn);
        float hs[16];
#pragma unroll
        for (int d = 0; d < 2; ++d) {
            float av[16], bv[16];
#pragma unroll
            for (int hf = 0; hf < 2; ++hf) { const u32x4 pa = q[4 * d + hf], pb = q[4 * d + 2 + hf];
                av[8 * hf + 0] = 1.f - bflo(pa.x); av[8 * hf + 1] = 1.f - bfhi(pa.x); av[8 * hf + 2] = 1.f - bflo(pa.y); av[8 * hf + 3] = 1.f - bfhi(pa.y);
                av[8 * hf + 4] = 1.f - bflo(pa.z); av[8 * hf + 5] = 1.f - bfhi(pa.z); av[8 * hf + 6] = 1.f - bflo(pa.w); av[8 * hf + 7] = 1.f - bfhi(pa.w);
                bv[8 * hf + 0] = bflo(pb.x); bv[8 * hf + 1] = bfhi(pb.x); bv[8 * hf + 2] = bflo(pb.y); bv[8 * hf + 3] = bfhi(pb.y);
                bv[8 * hf + 4] = bflo(pb.z); bv[8 * hf + 5] = bfhi(pb.z); bv[8 * hf + 6] = bflo(pb.w); bv[8 * hf + 7] = bfhi(pb.w); }
            float As = 1.f, Bs = 0.f;
#pragma unroll
            for (int i = 0; i < 16; ++i) { const int k = d == 0 ? i : 15 - i; Bs = av[k] * Bs + bv[k]; As = av[k] * As; }
            const int gi = d == 0 ? g : 3 - g;
            const int p1 = (d == 0 ? lane - 16 : lane + 16) & 63, p2 = (d == 0 ? lane - 32 : lane + 32) & 63;
            float Ai = As, Bi = Bs;
            { const float A1 = bperm(Ai, p1), B1 = bperm(Bi, p1); if (gi >= 1) { Bi = Ai * B1 + Bi; Ai = Ai * A1; } }
            { const float A2 = bperm(Ai, p2), B2 = bperm(Bi, p2); if (gi >= 2) { Bi = Ai * B2 + Bi; Ai = Ai * A2; } }
            float Ae = bperm(Ai, p1), Be = bperm(Bi, p1); if (gi == 0) { Ae = 1.f; Be = 0.f; }
            float hc = Ae * (d == 0 ? cin0 : cin1) + Be;
#pragma unroll
            for (int i = 0; i < 16; ++i) { const int k = d == 0 ? i : 15 - i; hc = av[k] * hc + bv[k]; hs[k] = d == 0 ? hc : hs[k] + hc; }
        }
        LAS unsigned char* ot = lds + par * 17408;
#pragma unroll
        for (int k = 0; k < 16; ++k) *(LAS bf16*)(ot + (16 * g + k) * SC_STR + chl * 2) = f2bf(hs[k]);
        __syncthreads();
#pragma unroll
        for (int i = 0; i < 2; ++i) { const int t = (tid >> 4) + 32 * i, ch8 = tid & 15;
            const u32x4 r = *(const LAS u32x4*)(ot + t * SC_STR + ch8 * 16), y = yq[i]; u32x4 ov;
            ov.x = pk2(bflo(r.x) * bflo(y.x), bfhi(r.x) * bfhi(y.x)); ov.y = pk2(bflo(r.y) * bflo(y.y), bfhi(r.y) * bfhi(y.y));
            ov.z = pk2(bflo(r.z) * bflo(y.z), bfhi(r.z) * bfhi(y.z)); ov.w = pk2(bflo(r.w) * bflo(y.w), bfhi(r.w) * bfhi(y.w));
            st16w<1>(RECG + (size_t)(64 * c + t) * D + 128 * h + 8 * ch8, ov); }
        if (!has) break;
        S2_PIN("2", qn, yn, cn0, cn1);
#pragma unroll
        for (int k = 0; k < 8; ++k) q[k] = qn[k];
        yq[0] = yn[0]; yq[1] = yn[1]; cin0 = cn0; cin1 = cn1; c = cn;
    }
#undef S2_LOAD
#undef S2_PIN
}
__device__ __forceinline__ void ph_carry(Frame& F) {
    const int gw = F.vcu * NWAVES + F.wave;
    if (gw >= 64) return;
    const int idx = gw * 64 + F.lane, ch = idx & (D - 1), b = (idx >> 10) & 1, d = idx >> 11;
    const float* AGG_A = (const float*)(F.ws + WS_AGG) + (size_t)d * NCHUNK * D + ch; const float* AGG_B = (const float*)(F.ws + WS_AGG + AGG_BYTES) + (size_t)d * NCHUNK * D + ch;
    float* CARRY = (float*)(F.ws + WS_AGG + 2 * AGG_BYTES) + (size_t)d * NCHUNK * D + ch;
    float hcur = 0.f;
    {   float A[4], B[4];
#pragma unroll
        for (int i = 0; i < 4; ++i) { const int c = 256 + 4 * b + (d == 0 ? i : 3 - i); A[i] = AGG_A[(size_t)c * D]; B[i] = AGG_B[(size_t)c * D]; }
#pragma unroll
        for (int i = 0; i < 4; ++i) { const int c = 256 + 4 * b + (d == 0 ? i : 3 - i); CARRY[(size_t)c * D] = hcur; hcur = A[i] * hcur + B[i]; }
    }
    for (int i0 = 0; i0 < 128; i0 += 16) {
        float A[16], B[16];
#pragma unroll
        for (int i = 0; i < 16; ++i) { const int c = 128 * b + (d == 0 ? i0 + i : 127 - i0 - i); A[i] = AGG_A[(size_t)c * D]; B[i] = AGG_B[(size_t)c * D]; }
#pragma unroll
        for (int i = 0; i < 16; ++i) { const int c = 128 * b + (d == 0 ? i0 + i : 127 - i0 - i); CARRY[(size_t)c * D] = hcur; hcur = A[i] * hcur + B[i]; }
    }
}

__device__ __forceinline__ void ph_carry_par(Frame& F) {
    if (F.vcu >= 64) return;
    const int g = F.vcu, b = (g >> 4) & 1, d = g >> 5, ch = 64 * (g & 15) + F.lane, w = F.wave;
    const float* AGG_A = (const float*)(F.ws + WS_AGG) + (size_t)d * NCHUNK * D + ch; const float* AGG_B = (const float*)(F.ws + WS_AGG + AGG_BYTES) + (size_t)d * NCHUNK * D + ch;
    float* CARRY = (float*)(F.ws + WS_AGG + 2 * AGG_BYTES) + (size_t)d * NCHUNK * D + ch;
    const int s0 = w < 4 ? 17 * w : 68 + 16 * (w - 4), n = w < 4 ? 17 : 16;
#define CYP_C(s) ((s) < 4 ? 256 + 4 * b + (d == 0 ? (s) : 3 - (s)) : 128 * b + (d == 0 ? (s) - 4 : 131 - (s)))
    float A[17], B[17];
#pragma unroll
    for (int j = 0; j < 17; ++j) { A[j] = 1.f; B[j] = 0.f; if (j < n) { const int c = CYP_C(s0 + j); A[j] = AGG_A[(size_t)c * D]; B[j] = AGG_B[(size_t)c * D]; } }
    float Aw = 1.f, Bw = 0.f;
#pragma unroll
    for (int j = 0; j < 17; ++j) { Bw = A[j] * Bw + B[j]; Aw = A[j] * Aw; }
    LAS float* comp = (LAS float*)F.lds;
    comp[(w * 2 + 0) * 64 + F.lane] = Aw; comp[(w * 2 + 1) * 64 + F.lane] = Bw;
    __syncthreads();
    float h = 0.f;
    for (int w2 = 0; w2 < w; ++w2) h = comp[(w2 * 2 + 0) * 64 + F.lane] * h + comp[(w2 * 2 + 1) * 64 + F.lane];
#pragma unroll
    for (int j = 0; j < 17; ++j) { if (j < n) { const int c = CYP_C(s0 + j); CARRY[(size_t)c * D] = h; h = A[j] * h + B[j]; } }
#undef CYP_C
}

template <int NS  > __device__ __forceinline__ f32x4 ctx_tile(Frame& F, const bf16* A, const bf16* Bt, int r0, int c0) {
    constexpr int K = NS * 256;
    const int lane = F.lane, w = F.wave, l15 = lane & 15, g = lane >> 4;
    const bf16* ap = A + (size_t)(r0 + l15) * K + w * (K / 8) + 8 * g;
    const bf16* bp = Bt + (size_t)(c0 + l15) * K + w * (K / 8) + 8 * g;
    f32x4 acc[4][2];
#pragma unroll
    for (int rt = 0; rt < 4; ++rt) { acc[rt][0] = (f32x4){0.f, 0.f, 0.f, 0.f}; acc[rt][1] = (f32x4){0.f, 0.f, 0.f, 0.f}; }
#pragma unroll 4
    for (int s = 0; s < NS; ++s) {
        bf16x8 af[4], bf[2];
#pragma unroll
        for (int rt = 0; rt < 4; ++rt) af[rt] = *(const bf16x8*)(ap + (size_t)(16 * rt) * K + 32 * s);
        bf[0] = *(const bf16x8*)(bp + 32 * s); bf[1] = *(const bf16x8*)(bp + (size_t)16 * K + 32 * s);
#pragma unroll
        for (int rt = 0; rt < 4; ++rt) { acc[rt][0] = __builtin_amdgcn_mfma_f32_16x16x32_bf16(bf[0], af[rt], acc[rt][0], 0, 0, 0); acc[rt][1] = __builtin_amdgcn_mfma_f32_16x16x32_bf16(bf[1], af[rt], acc[rt][1], 0, 0, 0); }
    }
    LAS f32x4* red = (LAS f32x4*)F.lds;
    __syncthreads();
#pragma unroll
    for (int rt = 0; rt < 4; ++rt) { red[(w * 8 + 2 * rt) * 64 + lane] = acc[rt][0]; red[(w * 8 + 2 * rt + 1) * 64 + lane] = acc[rt][1]; }
    __syncthreads();
    const int tt = F.tid >> 6;
    f32x4 v = red[tt * 64 + lane];
#pragma unroll
    for (int ww = 1; ww < 8; ++ww) v = v + red[(ww * 8 + tt) * 64 + lane];
    return v;
}
__global__ void __launch_bounds__(NWAVES * 64, 2) mk_fwd(Args args) {
    extern __shared__ __attribute__((aligned(16))) unsigned char lds_raw[];
    Frame F;
    F.lds = (LAS unsigned char*)lds_raw;
    F.MISC = (volatile LAS unsigned*)(F.lds + LDSCTL_OFF);
    F.tid = threadIdx.x; F.lane = F.tid & 63; F.wave = __builtin_amdgcn_readfirstlane(F.tid >> 6);
    F.G = gridDim.x; F.bx = blockIdx.x; F.vcu = 0;
    F.ws = args.ws; F.zo = 0; F.ctl = (unsigned*)(args.ws + WS_CTL);
    for (int u = F.tid; u < (LDS_BYTES - LDSCTL_OFF) / 4; u += NWAVES * 64) ((LAS unsigned*)(F.lds + LDSCTL_OFF))[u] = 0u;
    __syncthreads();
    const int lo = args.ph_lo, hi = args.ph_hi;
    const bool multi = hi - lo > 1;
    unsigned* barw = F.ctl + CW_BAR + args.bar_idx * XCD_BAR_WORDS;
    XcdBarrier bar; bar.bar = barw; bar.x = 0; bar.st = nullptr;
    if (multi) bar = xcd_barrier_post(barw, F.MISC + 8);
#ifndef INPROJ_REV
#define INPROJ_REV 0
#endif
#ifndef UP_REV
#define UP_REV 0
#endif
#ifndef MERGE_REC_FIRST
#define MERGE_REC_FIRST 1
#endif
#ifndef ATT_SEAM
#define ATT_SEAM 1
#endif
#ifndef MOE_UP_WGM
#define MOE_UP_WGM 8
#endif
#ifndef DOWN_LIFO
#define DOWN_LIFO 1
#endif
#ifndef P2_SCAN_FIRST
#define P2_SCAN_FIRST 0
#endif
#ifndef ARPT
#define ARPT 2
#endif
#ifndef NO_SCAN1
#define NO_SCAN1 0
#endif
#ifndef PH_MASK
#define PH_MASK 0xffff
#endif
#define SITE(s) ((PH_MASK >> (s)) & 1)
#ifndef CHAIN_MOE
#define CHAIN_MOE 0
#endif
#ifndef DUP_MASK
#define DUP_MASK 0
#endif
#define REPS(s) for (int rep_ = 0; rep_ < (((DUP_MASK >> (s)) & 1) ? 2 : 1); ++rep_)
#define IN(k) (lo <= (k) && (k) < hi)
#define REFRESH() do { long zo_ = 0; int t_ = threadIdx.x, z_ = 0; asm volatile("" : "+s"(zo_), "+v"(t_), "+s"(z_)); \
    ws = args.ws + zo_; F.ws = ws; F.zo = zo_; F.ctl = (unsigned*)(ws + WS_CTL); F.tid = t_; F.lane = t_ & 63; F.wave = __builtin_amdgcn_readfirstlane(t_ >> 6); \
    F.lds = (LAS unsigned char*)lds_raw + z_; ring = F.lds + RING_OFF; \
    int bx_ = blockIdx.x, g_ = gridDim.x; asm volatile("" : "+s"(bx_), "+s"(g_)); F.bx = bx_; F.G = g_; F.vcu = (g_ % 8 == 0) ? (bx_ % 8) * (g_ / 8) + bx_ / 8 : bx_; } while (0)
#define SEAM(k) do { if (IN(k) && IN((k) + 1)) { XcdBarrier b_; unsigned* p_ = (unsigned*)(args.ws + WS_CTL) + CW_BAR + args.bar_idx * XCD_BAR_WORDS; unsigned x_ = xb_xcc_id(); asm volatile("" : "+s"(p_), "+s"(x_)); \
    b_.bar = p_; b_.x = x_; b_.st = (volatile LAS unsigned*)(lds_raw + LDSCTL_OFF) + 8; xcd_barrier(b_); } } while (0)
    unsigned char* ws = args.ws;
    LAS unsigned char* ring = F.lds + RING_OFF;

    if (SITE(0) && IN(0)) { REFRESH(); REPS(0) { ph_prologue(F, args); } if (multi && ((DUP_MASK >> 22) & 1)) { for (int xb_ = 0; xb_ < 20; ++xb_) { XcdBarrier b_ = bar; unsigned* p_ = b_.bar; unsigned x_ = b_.x; asm volatile("" : "+s"(p_), "+s"(x_)); b_.bar = p_; b_.x = x_; xcd_barrier(b_); } }
        if ((DUP_MASK >> 21) & 1) { __syncthreads(); ph_rows<1>(F, args, 0, false); ph_rows<1>(F, args, 0, false); ph_rows<1>(F, args, 0, false); ph_rows<1>(F, args, 0, false); } SEAM(0); }
    for (int l = 0; l < DEPTH; ++l) {
        const int pb = 1 + 11 * l;
        const bool moe = l & 1, last = l == DEPTH - 1;
        const int Mrows = last ? ML : MT;
        if (SITE(1) && IN(pb + 0)) { REFRESH(); for (int rn_ = 0; rn_ < ((((DUP_MASK >> 19) & 1) && l != 2) ? 2 : 1); ++rn_) ph_rows<0>(F, args, l, (args.flags & 4) && l > 0 && ((l - 1) & 1)); SEAM(pb + 0); }
        if (SITE(2) && IN(pb + 1)) { REFRESH(); REPS(2) {
            pg8::Gemm g{(const bf16*)(ws + WS_XN), (const bf16*)(ws + WS_WIN) + (size_t)l * INC * D, MT, INC, D}; pg8::StaticOrder S; S.init(MT, INC, F.G, F.bx, INPROJ_REV);
            pg8::EpiInProj E{(bf16*)(ws + WS_P), (const f32x4*)(ws + WS_ROPE)};
            pg8::gemm_phase<pg8::EpiInProj, pg8::StaticOrder, true, true>(ring, g, S, E);
            { const int rem = (MT / 256 * 22) % F.G; if (DEFER_CONV == 1 && rem && F.bx >= rem) conv_drain(F, args, 3); }
            } SEAM(pb + 1);
        }
        if (SITE(3) && IN(pb + 2)) { REFRESH(); REPS(3) {
            const int fl = args.flags & 3; const bool rebal_ = SC1_REBAL && multi && fl == 0 && F.G == 256;
            for (int ord_ = 0; ord_ < 2; ++ord_) { if ((ord_ == 0) != (P2_SCAN_FIRST != 0)) {
            if (fl == 0 || (fl & 1)) { for (int ra_ = 0; ra_ < (((DUP_MASK >> 16) & 1) ? ARPT : 1); ++ra_) { if ((LOCMAP & 1) && multi && F.G == 256) { for (int kv_ = 0; kv_ < 2; ++kv_) attn_unit(F, args.in[9] + F.zo + l * NH, (F.vcu >> 7) * 256 + kv_ * 128 + (F.vcu & 127)); }
                else if (ATT_SEAM) { const int lim_ = multi ? 512 : 528; const int nl_ = F.vcu < lim_ ? (lim_ - F.vcu + F.G - 1) / F.G : 0;
                    const int ux_ = (rebal_ && ((LOCMAP & 2) ? (F.vcu >= 224 && F.vcu < 240) : F.vcu >= 240)) ? 512 + F.vcu - ((LOCMAP & 2) ? 224 : 240) : -1;
                    attn_stream(F, args.in[9] + F.zo + l * NH, F.vcu, F.G, nl_, ux_); __syncthreads(); continue; }
                else for (int u = F.vcu; u < (multi ? 512 : 528); u += F.G) attn_unit(F, args.in[9] + F.zo + l * NH, u);
                if (rebal_ && ((LOCMAP & 2) ? (F.vcu >= 224 && F.vcu < 240) : F.vcu >= 240)) attn_unit(F, args.in[9] + F.zo + l * NH, 512 + F.vcu - ((LOCMAP & 2) ? 224 : 240)); __syncthreads(); } }
            if (DEFER_CONV == 2 && multi && l < DEPTH - 1) { conv_drain(F, args, 4); __syncthreads(); }
            } else {
            REFRESH();
            if (!NO_SCAN1 && (fl == 0 || (fl & 2))) { for (int rs_ = 0; rs_ < (((DUP_MASK >> 17) & 1) ? 2 : 1); ++rs_) { ph_scan1(F, args, l, SC1_REBAL && multi && fl == 0 && F.G == 256); __syncthreads(); } }
            } }
            } SEAM(pb + 2);
        }
        if (SITE(4) && IN(pb + 3)) { REFRESH(); if ((DUP_MASK >> 18) & 1) { ph_scan1(F, args, l); __syncthreads(); } REPS(4) { if (CARRY_PF && F.G == 256) { __syncthreads(); ph_carry_par(F); } else ph_carry(F); }
            if (multi && F.vcu >= 8 && !(SC1_REBAL && (args.flags & 3) == 0 && F.G == 256)) { for (int u = 512 + F.vcu - 8; u < 528; u += F.G) attn_unit(F, args.in[9] + F.zo + l * NH, u); }
            SEAM(pb + 3); }
        if (SITE(5) && IN(pb + 4)) { REFRESH(); REPS(5) { ph_scan2(F); } SEAM(pb + 4); }
        if (SITE(6) && IN(pb + 5)) { REFRESH(); REPS(6) {
            const bf16* WO = (const bf16*)(ws + WS_WO) + (size_t)l * 3 * D * D;
            pg8::StaticOrder S; S.init(ML, D, F.G, F.bx);
            { pg8::Gemm g{(const bf16*)(ws + (MERGE_REC_FIRST ? WS_RECG : WS_ATT)), WO + (MERGE_REC_FIRST ? (size_t)D * D : 0), ML, D, D}; pg8::EpiMerge E{(const bf16*)(ws + WS_P), (bf16*)(ws + WS_T1), (bf16*)(ws + WS_MM), 0, MERGE_REC_FIRST ? OFF_GR : OFF_GA};
              pg8::gemm_phase<pg8::EpiMerge, pg8::StaticOrder, true, true>(ring, g, S, E); }
            asm volatile("s_waitcnt vmcnt(0)" ::: "memory");
            if (F.tid == 0) { __builtin_amdgcn_fence(__ATOMIC_ACQUIRE, "agent"); asm volatile("s_waitcnt vmcnt(0)" ::: "memory"); }
            __syncthreads();
            { pg8::Gemm g{(const bf16*)(ws + (MERGE_REC_FIRST ? WS_ATT : WS_RECG)), WO + (MERGE_REC_FIRST ? 0 : (size_t)D * D), ML, D, D}; pg8::EpiMerge E{(const bf16*)(ws + WS_P), (bf16*)(ws + WS_T1), (bf16*)(ws + WS_MM), 1, MERGE_REC_FIRST ? OFF_GA : OFF_GR};
              pg8::gemm_phase<pg8::EpiMerge, pg8::StaticOrder, true, true>(ring, g, S, E); }
            if (!last) for (int tl = F.vcu; tl < 256; tl += F.G) {
                const int r0 = ML + 64 * (tl >> 5), c0 = 32 * (tl & 31);
                const int tt = F.tid >> 6; const size_t row = (size_t)(r0 + 16 * (tt >> 1) + (F.lane & 15)); const int col = c0 + 16 * (tt & 1) + 4 * (F.lane >> 4);
                const u32x2 ga = *(const u32x2*)((const bf16*)(ws + WS_P) + row * INC + OFF_GA + col), gr = *(const u32x2*)((const bf16*)(ws + WS_P) + row * INC + OFF_GR + col);
                const f32x4 s1 = ctx_tile<4>(F, (const bf16*)(ws + WS_ATT), WO, r0, c0);
                const f32x4 s2 = ctx_tile<4>(F, (const bf16*)(ws + WS_RECG), WO + (size_t)D * D, r0, c0);
                u32x2 o2; o2.x = pk2(bflo(ga.x) * s1[0] + bflo(gr.x) * s2[0], bfhi(ga.x) * s1[1] + bfhi(gr.x) * s2[1]); o2.y = pk2(bflo(ga.y) * s1[2] + bflo(gr.y) * s2[2], bfhi(ga.y) * s1[3] + bfhi(gr.y) * s2[3]);
                *(u32x2*)((bf16*)(ws + WS_MM) + row * D + col) = o2;
            }
            } SEAM(pb + 5);
        }
        if (SITE(7) && IN(pb + 6)) { REFRESH();
            const bf16* WOUT = (const bf16*)(ws + WS_WO) + (size_t)(l * 3 + 2) * D * D; const float* g1 = (const float*)(ws + WS_MOD) + (size_t)l * 18 * D + 2 * D;
            pg8::Gemm g{(const bf16*)(ws + WS_MM), WOUT, ML, D, D}; pg8::StaticOrder S; S.init(ML, D, F.G, F.bx);
            pg8::EpiResid E{(bf16*)(ws + WS_H), g1, (const bf16*)(ws + WS_H), l == 0 ? args.in[0] + F.zo : nullptr};
            pg8::gemm_phase<pg8::EpiResid, pg8::StaticOrder, true, true>(ring, g, S, E);
            if (!last) for (int tl = F.vcu; tl < 256; tl += F.G) {
                const int r0 = ML + 64 * (tl >> 5), c0 = 32 * (tl & 31);
                const int tt = F.tid >> 6; const size_t row = (size_t)(r0 + 16 * (tt >> 1) + (F.lane & 15)); const int col = c0 + 16 * (tt & 1) + 4 * (F.lane >> 4);
                bf16* hp = (bf16*)(ws + WS_H) + row * D + col; f32x4 bi;
                if (l == 0) bi = *(const f32x4*)(args.in[2] + F.zo + (row - ML) * D + col); else { const u32x2 hb = *(const u32x2*)hp; bi = (f32x4){bflo(hb.x), bfhi(hb.x), bflo(hb.y), bfhi(hb.y)}; }
                const f32x4 gv = *(const f32x4*)(g1 + 12 * D + col);
                const f32x4 s = ctx_tile<4>(F, (const bf16*)(ws + WS_MM), WOUT, r0, c0);
                const f32x4 ho = bi + gv * s; u32x2 hw; hw.x = pk2(ho[0], ho[1]); hw.y = pk2(ho[2], ho[3]); *(u32x2*)hp = hw;
            }
            SEAM(pb + 6);
        }
        if (SITE(8) && IN(pb + 7)) { REFRESH(); for (int rn_ = 0; rn_ < ((((DUP_MASK >> 20) & 1) && !moe) ? 2 : 1); ++rn_) ph_rows<1>(F, args, l, false); SEAM(pb + 7); }
        if (SITE(9) && IN(pb + 8) && moe) { REFRESH(); if (last) { conv_drain(F, args, 1 << 30); __syncthreads(); }
            ph_lists(F, l); SEAM(pb + 8); }
        if (SITE(10) && IN(pb + 9)) { REFRESH(); REPS(10) {
            if (!moe) {
                pg8::Gemm g{(const bf16*)(ws + WS_XN), (const bf16*)(ws + WS_FF + (l >> 1) * FF_STRIDE), Mrows, 2 * DFF, D}; pg8::ExpertOrder S; S.init(Mrows, 2 * DFF, F.G, F.bx, UP_REV); S.panel_e = (const int*)(ws + WS_PANELE); S.estride = 0; S.pub = nullptr; S.ready = nullptr; S.need = 0; S.tmo = nullptr; S.pend = -1;
                pg8::EpiSwiGLU E{(bf16*)(ws + WS_HID), DFF, 0};
                pg8::gemm_phase<pg8::EpiSwiGLU, pg8::ExpertOrder, true, true>(ring, g, S, E);
                { const int rem = (Mrows / 256 * 22) % F.G; if (DEFER_CONV == 1 && rem && F.bx >= rem) conv_drain(F, args, 3); }
            } else {
                const int np = __builtin_amdgcn_readfirstlane(((const int*)(ws + WS_PANELE))[256]);
                pg8::Gemm g{(const bf16*)(ws + WS_XN), (const bf16*)(ws + WS_EXP + (l >> 1) * EXP_STRIDE), np * 256, 2 * DFE, D}; pg8::GatherOrder S; S.arow = (const int*)(ws + WS_SLOTTOK);     S.init(np * 256, 2 * DFE, F.G, F.bx, UP_REV); S.wgm = MOE_UP_WGM;     S.panel_e = (const int*)(ws + WS_PANELE); S.estride = (size_t)2 * DFE * D * 2;
                S.pub = CHAIN_MOE ? F.ctl + CW_RDY + l * 16384 : nullptr; S.ready = nullptr; S.need = 0; S.tmo = nullptr; S.pend = -1;
                pg8::EpiSwiGLU E{(bf16*)(ws + WS_HID), DFE, CHAIN_MOE};
                pg8::gemm_phase<pg8::EpiSwiGLU, pg8::GatherOrder, true, true>(ring, g, S, E);
                S.flush();
                { const int rem = (np * 28) % F.G; if (DEFER_CONV == 1 && rem && F.bx >= rem) conv_drain(F, args, 3); }
            }
            } if (!moe || !CHAIN_MOE) SEAM(pb + 9);
        }
        if (SITE(11) && IN(pb + 10)) { REFRESH();
            if (!moe) {
                const bf16* WD = (const bf16*)(ws + WS_FF + (l >> 1) * FF_STRIDE) + (size_t)2 * DFF * D; const float* g2 = (const float*)(ws + WS_MOD) + (size_t)l * 18 * D + 5 * D;
                pg8::Gemm g{(const bf16*)(ws + WS_HID), WD, ML, D, DFF}; pg8::StaticOrder S; S.init(ML, D, F.G, F.bx, DOWN_LIFO ? 2 : 0);
                pg8::EpiResid E{(bf16*)(ws + WS_H), g2, (const bf16*)(ws + WS_H), nullptr};
                pg8::gemm_phase<pg8::EpiResid, pg8::StaticOrder, true, true>(ring, g, S, E);
                for (int tl = F.vcu; tl < 256; tl += F.G) {
                    const int r0 = ML + 64 * (tl >> 5), c0 = 32 * (tl & 31);
                    const int tt = F.tid >> 6; const size_t row = (size_t)(r0 + 16 * (tt >> 1) + (F.lane & 15)); const int col = c0 + 16 * (tt & 1) + 4 * (F.lane >> 4);
                    bf16* hp = (bf16*)(ws + WS_H) + row * D + col; const u32x2 hb = *(const u32x2*)hp; const f32x4 gv = *(const f32x4*)(g2 + 12 * D + col);
                    const f32x4 s = ctx_tile<11>(F, (const bf16*)(ws + WS_HID), WD, r0, c0);
                    const f32x4 ho = (f32x4){bflo(hb.x), bfhi(hb.x), bflo(hb.y), bfhi(hb.y)} + gv * s; u32x2 hw; hw.x = pk2(ho[0], ho[1]); hw.y = pk2(ho[2], ho[3]); *(u32x2*)hp = hw;
                }
            } else {
                const int np = __builtin_amdgcn_readfirstlane(((const int*)(ws + WS_PANELE))[256]);
                pg8::Gemm g{(const bf16*)(ws + WS_HID), (const bf16*)(ws + WS_EXP + (l >> 1) * EXP_STRIDE) + (size_t)NE * 2 * DFE * D, np * 256, D, DFE}; pg8::ExpertOrder S;
                const int Uup = CHAIN_MOE ? np * 28 : 0, i0 = Uup > F.bx ? (Uup - F.bx + F.G - 1) / F.G : 0;
                S.init(np * 256, D, F.G, F.bx + i0 * F.G - Uup, (DOWN_LIFO && !CHAIN_MOE) ? 2 : 0); S.panel_e = (const int*)(ws + WS_PANELE); S.estride = (size_t)D * DFE * 2;
                S.pub = nullptr; S.ready = CHAIN_MOE ? F.ctl + CW_RDY + l * 16384 : nullptr; S.need = 28u * 8u; S.tmo = F.ctl + CW_TMO; S.pend = -1;
                const int npm = CHAIN_MOE ? np : (np / (F.G / 4)) * (F.G / 4);
                S.nM = npm; S.nwg = npm * 4;
                pg8::EpiPlain E{(bf16*)(ws + WS_FS), D};
                pg8::gemm_phase<pg8::EpiPlain, pg8::ExpertOrder, true, true>(ring, g, S, E);
                for (int tl = F.vcu; tl < (np - npm) * 128; tl += F.G) {
                    const int pm = npm + (tl >> 7), r0 = 256 * pm + 64 * ((tl >> 5) & 3), c0 = 32 * (tl & 31);
                    const int e = __builtin_amdgcn_readfirstlane(((const int*)(ws + WS_PANELE))[pm]);
                    const f32x4 s = ctx_tile<14>(F, (const bf16*)(ws + WS_HID), (const bf16*)(ws + WS_EXP + (l >> 1) * EXP_STRIDE) + (size_t)NE * 2 * DFE * D + (size_t)e * D * DFE, r0, c0);
                    const int tt = F.tid >> 6; const size_t row = (size_t)(r0 + 16 * (tt >> 1) + (F.lane & 15)); const int col = c0 + 16 * (tt & 1) + 4 * (F.lane >> 4);
                    u32x2 o2; o2.x = pk2(s[0], s[1]); o2.y = pk2(s[2], s[3]);
                    *(u32x2*)((bf16*)(ws + WS_FS) + row * D + col) = o2;
                }
                if (!CHAIN_MOE && DEFER_CONV == 1) { const int rem = (np * 4) % F.G; if (rem && F.bx >= rem) conv_drain(F, args, 7); }
            }
            SEAM(pb + 10);
        }
    }
    if (SITE(12) && IN(45)) { REFRESH(); ph_rows<2>(F, args, DEPTH, (args.flags & 4) != 0); }
#undef IN
#undef SEAM
}

static int g_bar_idx = 0;
static void opt_launch(void* const* d_in, void* d_out, void* d_ws, hipStream_t stream, int ph_lo, int ph_hi, int flags) {
    static int grid = 0;
    if (grid == 0) {
        int dev = 0, cus = 0, per_cu = 0;
        if (hipGetDevice(&dev) != hipSuccess || hipDeviceGetAttribute(&cus, hipDeviceAttributeMultiprocessorCount, dev) != hipSuccess) { fprintf(stderr, "opt_launch: device query failed\n"); grid = -1; return; }
        if (hipFuncSetAttribute((const void*)mk_fwd, hipFuncAttributeMaxDynamicSharedMemorySize, LDS_BYTES) != hipSuccess) { fprintf(stderr, "opt_launch: hipFuncSetAttribute failed\n"); grid = -1; return; }
        if (hipOccupancyMaxActiveBlocksPerMultiprocessor(&per_cu, (const void*)mk_fwd, NWAVES * 64, LDS_BYTES) != hipSuccess || per_cu < 1) { fprintf(stderr, "opt_launch: occupancy query says %d blocks per CU\n", per_cu); }
        (void)hipGetLastError();
        grid = cus;
        if (grid % 8 != 0 || grid < 64) fprintf(stderr, "opt_launch: unexpected CU count %d\n", grid);
    }
    if (grid < 0) return;
    Args a{};
    for (int i = 0; i < 28; ++i) a.in[i] = (const float*)d_in[i];
    a.out = (float*)d_out; a.ws = (unsigned char*)d_ws; a.ph_lo = ph_lo; a.ph_hi = ph_hi; a.flags = flags; a.bar_idx = (ph_hi - ph_lo > 1) ? g_bar_idx++ : 0;
    hipLaunchKernelGGL(mk_fwd, dim3(grid), dim3(NWAVES * 64), LDS_BYTES, stream, a);
    const hipError_t le = hipPeekAtLastError();
    if (le != hipSuccess) fprintf(stderr, "opt_launch: launch [%d,%d) failed: %s\n", ph_lo, ph_hi, hipGetErrorName(le));
}


extern "C" void kernel_launch(void* const* d_in, const int* in_sizes, int n_in, void* d_out, int out_size, void* d_ws, size_t ws_size, hipStream_t stream) {
    if (n_in != 28 || ws_size < WS_END) { fprintf(stderr, "kernel_launch: unexpected n_in %d or ws_size %zu (need %zu)\n", n_in, ws_size, (size_t)WS_END); return; }
    const float* x = (const float*)d_in[0]; const float* c = (const float*)d_in[1]; const float* ctx = (const float*)d_in[2]; const float* c_ctx = (const float*)d_in[3];
    const float* w_mod = (const float*)d_in[4]; const float* b_mod = (const float*)d_in[5]; const float* norm1_g = (const float*)d_in[6]; const float* norm2_g = (const float*)d_in[7];
    const float* w_in = (const float*)d_in[8]; const float* attn_sink = (const float*)d_in[9]; const float* conv_w = (const float*)d_in[10]; const float* conv_b = (const float*)d_in[11];
    const float* gate_a_w = (const float*)d_in[12]; const float* gate_a_b = (const float*)d_in[13]; const float* gate_x_w = (const float*)d_in[14]; const float* gate_x_b = (const float*)d_in[15];
    const float* lru_lambda = (const float*)d_in[16]; const float* w_o_attn = (const float*)d_in[17]; const float* w_o_lru = (const float*)d_in[18]; const float* w_out = (const float*)d_in[19];
    const float* ff_w_gate = (const float*)d_in[20]; const float* ff_w_up = (const float*)d_in[21]; const float* ff_w_down = (const float*)d_in[22]; const float* router_w = (const float*)d_in[23];
    const float* exp_w_gate = (const float*)d_in[24]; const float* exp_w_up = (const float*)d_in[25]; const float* exp_w_down = (const float*)d_in[26]; const float* final_g = (const float*)d_in[27];
    char* ws = (char*)d_ws;
    float* MOD = (float*)(ws + WS_MOD);
    int* te = (int*)(ws + WS_TE); float* tw = (float*)(ws + WS_TW); int* slot_tok = (int*)(ws + WS_SLOTTOK); int* tok_slot = (int*)(ws + WS_TOKSLOT); int* tile_e = (int*)(ws + WS_PANELE);
    float* H = (float*)(ws + WS_H); bf16* XN = (bf16*)(ws + WS_XN); bf16* P = (bf16*)(ws + WS_P); bf16* ATT = (bf16*)(ws + WS_ATT); bf16* RECG = (bf16*)(ws + WS_RECG);
    bf16* MM = (bf16*)(ws + WS_MM); bf16* HID = (bf16*)(ws + WS_HID); bf16* FS = (bf16*)(ws + WS_FS);
    float* XC = (float*)(ws + NV_XC); float* RG = (float*)(ws + NV_RG); float* IG = (float*)(ws + NV_IG); float* REC = (float*)(ws + NV_REC); float* PF = (float*)(ws + NV_PF32);
    const int EB = (int)(((long)MT * D + 255) / 256);
    (void)out_size; (void)in_sizes;

    (void)hipMemsetAsync(ws + WS_CTL, 0, CTL_ZERO_BYTES, stream);
    g_bar_idx = 0;
    const int CF = OPT_STEP >= 6 ? 4 : 0;
#if OPT_STEP >= 8
    opt_launch(d_in, d_out, d_ws, stream, 0, 46, 4);
    return;
#endif
#if OPT_STEP >= 1
    opt_launch(d_in, d_out, d_ws, stream, 0, 1, 0);
#else
    (void)hipMemcpyAsync(H, x, (size_t)ML * D * 4, hipMemcpyDeviceToDevice, stream);
    (void)hipMemcpyAsync(H + (size_t)ML * D, ctx, (size_t)MC * D * 4, hipMemcpyDeviceToDevice, stream);
    hipLaunchKernelGGL(nv::k_mod, dim3(6 * D / 256, DEPTH), dim3(256), 0, stream, c, c_ctx, w_mod, b_mod, MOD);
#endif
    for (int l = 0; l < DEPTH; ++l) {
        const float* MODl = MOD + (size_t)l * 3 * 6 * D;
        const int pb = 1 + 11 * l;
#if OPT_STEP >= 1
        opt_launch(d_in, d_out, d_ws, stream, pb + 0, pb + 2, CF);
#else
        hipLaunchKernelGGL((nv::k_norm_mod<bf16>), dim3(MT / 4), dim3(256), 0, stream, H, norm1_g + l * D, MODl, 0, D, XN, MT);
        ngemm(stream, XN, D, nullptr, w_in + (size_t)l * D * INC, INC, PF, INC, MT, INC, D);
        hipLaunchKernelGGL(nv::k_rope, dim3((ML * 640 + 255) / 256), dim3(256), 0, stream, PF);
        hipLaunchKernelGGL(nv::k_pfmt, dim3((int)(((long)MT * INC + 255) / 256)), dim3(256), 0, stream, PF, P);
#endif
#if OPT_STEP >= 2
        opt_launch(d_in, d_out, d_ws, stream, pb + 2, pb + 3, 1);
#else
        hipLaunchKernelGGL(nv::k_attn, dim3(MT * NH / 4), dim3(256), 0, stream, P, attn_sink + l * NH, ATT);
#endif
#if OPT_STEP >= 3
        opt_launch(d_in, d_out, d_ws, stream, pb + 2, pb + 3, 2);
        opt_launch(d_in, d_out, d_ws, stream, pb + 3, pb + 5, 0);
#else
        hipLaunchKernelGGL(nv::k_conv, dim3(EB), dim3(256), 0, stream, P, conv_w + (size_t)l * 4 * D, conv_b + l * D, XC);
        for (int d = 0; d < 2; ++d) {
            const size_t go = ((size_t)l * 2 + d) * 8 * 128 * 128, vo = ((size_t)l * 2 + d) * D;
            ngemm(stream, XC, D, nullptr, gate_a_w + go, 128, RG, D, MT, 128, 128, 8, 128, 128 * 128, 128);
            ngemm(stream, XC, D, nullptr, gate_x_w + go, 128, IG, D, MT, 128, 128, 8, 128, 128 * 128, 128);
            hipLaunchKernelGGL(nv::k_scan, dim3(BATCH * D / 64), dim3(64), 0, stream, XC, RG, IG, gate_a_b + vo, gate_x_b + vo, lru_lambda + vo, d, REC);
        }
        hipLaunchKernelGGL(nv::k_recgate, dim3(EB), dim3(256), 0, stream, REC, P, RECG);
#endif
#if OPT_STEP >= 4
        opt_launch(d_in, d_out, d_ws, stream, pb + 5, pb + 7, 0);
#else
        ngemm(stream, ATT, D, nullptr, w_o_attn + (size_t)l * D * D, D, RG, D, MT, D, D);
        ngemm(stream, RECG, D, nullptr, w_o_lru + (size_t)l * D * D, D, IG, D, MT, D, D);
        hipLaunchKernelGGL(nv::k_merge, dim3(EB), dim3(256), 0, stream, RG, IG, P, MM);
        ngemm(stream, MM, D, nullptr, w_out + (size_t)l * D * D, D, XC, D, MT, D, D);
        hipLaunchKernelGGL(nv::k_resid, dim3(EB), dim3(256), 0, stream, H, XC, MODl, 2 * D);
#endif
        const int i = l / 2;
        if (l % 2 == 0) {
#if OPT_STEP >= 5
            opt_launch(d_in, d_out, d_ws, stream, pb + 7, pb + 11, 0);
#else
            hipLaunchKernelGGL((nv::k_norm_mod<bf16>), dim3(MT / 4), dim3(256), 0, stream, H, norm2_g + l * D, MODl, 3 * D, 4 * D, XN, MT);
            ngemm(stream, XN, D, nullptr, ff_w_gate + (size_t)i * D * DFF, DFF, HID, DFF, MT, DFF, D);
            ngemm(stream, XN, D, nullptr, ff_w_up + (size_t)i * D * DFF, DFF, HID, DFF, MT, DFF, D, 1, 0, 0, 0, nullptr, 0, 1);
            ngemm(stream, HID, DFF, nullptr, ff_w_down + (size_t)i * DFF * D, D, IG, D, MT, D, DFF);
            hipLaunchKernelGGL(nv::k_resid, dim3(EB), dim3(256), 0, stream, H, IG, MODl, 5 * D);
#endif
        } else {
#if OPT_STEP >= 6
            opt_launch(d_in, d_out, d_ws, stream, pb + 7, pb + 11, 0);
#if OPT_STEP == 6
            if (l == DEPTH - 1) hipLaunchKernelGGL(nv::k_moe_combine, dim3(EB), dim3(256), 0, stream, H, FS, tok_slot, tw, MODl, 5 * D);
#endif
#else
            hipLaunchKernelGGL((nv::k_norm_mod<bf16>), dim3(MT / 4), dim3(256), 0, stream, H, norm2_g + l * D, MODl, 3 * D, 4 * D, XN, MT);
            hipLaunchKernelGGL(nv::k_route, dim3(MT / 4), dim3(256), 0, stream, XN, router_w + (size_t)i * D * NE, te, tw);
            hipLaunchKernelGGL(nv::k_moe_lists, dim3(1), dim3(1024), 0, stream, te, slot_tok, tok_slot, tile_e);
            const size_t eo = (size_t)i * NE * D * DFE;
            ngemm(stream, XN, D, slot_tok, exp_w_gate + eo, DFE, HID, DFE, NSLOT, DFE, D, 1, 0, 0, 0, tile_e, (long)D * DFE, 0);
            ngemm(stream, XN, D, slot_tok, exp_w_up + eo, DFE, HID, DFE, NSLOT, DFE, D, 1, 0, 0, 0, tile_e, (long)D * DFE, 1);
            ngemm(stream, HID, DFE, nullptr, exp_w_down + eo, D, FS, D, NSLOT, D, DFE, 1, 0, 0, 0, tile_e, (long)DFE * D, 0);
            hipLaunchKernelGGL(nv::k_moe_combine, dim3(EB), dim3(256), 0, stream, H, FS, tok_slot, tw, MODl, 5 * D);
#endif
        }
    }
#if OPT_STEP >= 7
    opt_launch(d_in, d_out, d_ws, stream, 45, 46, CF);
#else
    hipLaunchKernelGGL(nv::k_final, dim3(ML / 4), dim3(256), 0, stream, H, final_g, (float*)d_out);
#endif
}
```
